# Optimizing an MI355X kernel written in HIP

```python
import math
import jax, jax.numpy as jnp
from jax import lax
import numpy as np

D_MODEL = 2048
BATCH = 4
SEQ = 2048
DEPTH = 4

HEAD_DIM = D_MODEL // 16
N_MEM = 256
MEM_HEADS = 4
DIL_GROUPS = ((128, 1), (512, 4), (2048, 16))
A_HEADS_PER_GROUP = D_MODEL // 256
A_BLOCK = 128
B_HEADS = 12
B_KV_GROUPS = 4
CMP_LEN = 32
CMP_STRIDE = 16
CMP_HIDDEN = 512
SLC_LEN = 64
SLC_TOPK = 16
SLC_Q_CHUNK = 16
SEL_FORCE = 1e4
WIN_LEN = 512
WIN_BLOCK = 128
D_FF = ((8 * D_MODEL // 3 + 255) // 256) * 256

kernel_name = "hybrid_dilated_nsa_yoco"


def rmsnorm(x, g, eps=1e-6):
    xf = x.astype(jnp.float32)
    y = xf * lax.rsqrt(jnp.mean(xf * xf, axis=-1, keepdims=True) + eps)
    return (y * g.astype(jnp.float32)).astype(x.dtype)


def alibi_slopes(n):
    return 2.0 ** (-8.0 * jnp.arange(1, n + 1, dtype=jnp.float32) / n)


def masked_softmax(s, valid):
    s = jnp.where(valid, s, -jnp.inf)
    m = jnp.max(s, axis=-1, keepdims=True)
    m = jnp.where(jnp.isfinite(m), m, 0.0)
    e = jnp.where(valid, jnp.exp(s - m), 0.0)
    den = jnp.maximum(jnp.sum(e, axis=-1, keepdims=True), 1e-30)
    return e / den, (m + jnp.log(den))[..., 0]


def banded_attention(q, k, v, slopes, max_dist, blk, pos_scale):
    B, L, H, D = q.shape
    G = k.shape[2]
    r = H // G
    nb = -(-L // blk)
    Lp = nb * blk
    n_prev = -(-max_dist // blk)
    qb = jnp.pad(q, ((0, 0), (0, Lp - L), (0, 0), (0, 0))).reshape(B, nb, blk, G, r, D)

    def band(t):
        t = jnp.pad(t, ((0, 0), (n_prev * blk, Lp - L), (0, 0), (0, 0)))
        t = t.reshape(B, nb + n_prev, blk, G, D)
        return jnp.concatenate([t[:, j:j + nb] for j in range(n_prev + 1)], axis=2)

    kb, vb = band(k), band(v)
    s = jnp.einsum('bnqgrd,bnkgd->bngrqk', qb, kb,
                   preferred_element_type=jnp.float32) / math.sqrt(D)
    qpos = jnp.arange(nb)[:, None] * blk + jnp.arange(blk)[None, :]
    kpos = jnp.arange(nb)[:, None] * blk + jnp.arange((n_prev + 1) * blk)[None, :] - n_prev * blk
    dist = qpos[:, :, None] - kpos[:, None, :]
    valid = (dist >= 0) & (dist <= max_dist) & (kpos[:, None, :] >= 0)
    bias = -slopes.reshape(1, G, r, 1, 1) * (dist * pos_scale).astype(jnp.float32)[:, None, None]
    p, lse = masked_softmax(s + bias, valid[:, None, None])
    o = jnp.einsum('bngrqk,bnkgd->bnqgrd', p.astype(v.dtype), vb).reshape(B, Lp, H, D)[:, :L]
    lse = lse.transpose(0, 1, 4, 2, 3).reshape(B, Lp, H)[:, :L]
    return o, lse


def dilated_attention(q, k, v):
    B, S, _, D = q.shape
    Hg = A_HEADS_PER_GROUP
    slopes = alibi_slopes(len(DIL_GROUPS) * Hg)
    outs, lses = [], []
    for gi, (w, d) in enumerate(DIL_GROUPS):
        sl = slice(gi * Hg, (gi + 1) * Hg)

        def to_cls(t):
            return t.reshape(B, S // d, d, Hg, D).transpose(0, 2, 1, 3, 4).reshape(B * d, S // d, Hg, D)

        o, lse = banded_attention(to_cls(q[:, :, sl]), to_cls(k[:, :, sl]), to_cls(v[:, :, sl]),
                                  slopes[sl], w // d, A_BLOCK, d)
        outs.append(o.reshape(B, d, S // d, Hg, D).transpose(0, 2, 1, 3, 4).reshape(B, S, Hg, D))
        lses.append(lse.reshape(B, d, S // d, Hg).transpose(0, 2, 1, 3).reshape(B, S, Hg))
    alpha = jax.nn.softmax(jnp.stack(lses, 0), axis=0)
    o = jnp.sum(alpha[..., None] * jnp.stack(outs, 0).astype(jnp.float32), axis=0)
    return o.astype(q.dtype)


def memory_attention(q, mem_n, w_kv):
    B, M, _ = mem_n.shape
    kv = (mem_n @ w_kv).reshape(B, M, 2, MEM_HEADS, HEAD_DIM)
    s = jnp.einsum('bshd,bmhd->bhsm', q, kv[:, :, 0],
                   preferred_element_type=jnp.float32) / math.sqrt(HEAD_DIM)
    p = jax.nn.softmax(s, axis=-1)
    return jnp.einsum('bhsm,bmhd->bshd', p.astype(q.dtype), kv[:, :, 1])


def compress_blocks(kr, pe, w1, w2):
    B, S, G, D = kr.shape
    n = (S - CMP_LEN) // CMP_STRIDE + 1
    idx = jnp.arange(n)[:, None] * CMP_STRIDE + jnp.arange(CMP_LEN)[None, :]
    blk = kr[:, idx] + pe[:, None, :].astype(kr.dtype)
    blk = blk.transpose(0, 1, 3, 2, 4).reshape(B, n, G, CMP_LEN * D)
    return jax.nn.gelu(blk @ w1) @ w2


def nsa_shared_kv(h, g, w, pe, wk1, wk2, wv1, wv2):
    B, S, _ = h.shape
    kv = (rmsnorm(h, g) @ w).reshape(B, S, 6, B_KV_GROUPS, HEAD_DIM)
    kc = compress_blocks(kv[:, :, 0], pe[0], wk1, wk2)
    vc = compress_blocks(kv[:, :, 1], pe[1], wv1, wv2)
    return kc, vc, kv[:, :, 2], kv[:, :, 3], kv[:, :, 4], kv[:, :, 5]


def selected_attention(qg, ks, vs, sel, slopes):
    B, S, G, r, D = qg.shape
    kk = sel.shape[-1]
    n_sel = S // SLC_LEN
    kb = ks.reshape(B, n_sel, SLC_LEN, G, D).transpose(0, 3, 1, 2, 4)
    vb = vs.reshape(B, n_sel, SLC_LEN, G, D).transpose(0, 3, 1, 2, 4)
    C = min(SLC_Q_CHUNK, S)
    nC = S // C
    q_ch = qg.reshape(B, nC, C, G, r, D).transpose(1, 0, 2, 3, 4, 5)
    s_ch = sel.reshape(B, nC, C, G, kk).transpose(1, 0, 2, 3, 4)
    t_ch = jnp.arange(S).reshape(nC, C)
    bi = jnp.arange(B)[:, None, None, None]
    gi = jnp.arange(G)[None, None, :, None]
    sl = slopes.reshape(G, r)

    def one(args):
        qc, sc, tc = args
        kg = kb[bi, gi, sc]
        vg = vb[bi, gi, sc]
        s = jnp.einsum('bcgrd,bcgkld->bcgrkl', qc, kg,
                       preferred_element_type=jnp.float32) / math.sqrt(D)
        kpos = sc[..., None] * SLC_LEN + jnp.arange(SLC_LEN)
        dist = tc[None, :, None, None, None] - kpos
        bias = -sl[None, None, :, :, None, None] * dist[:, :, :, None].astype(jnp.float32)
        p, _ = masked_softmax((s + bias).reshape(B, C, G, r, kk * SLC_LEN),
                              (dist >= 0).reshape(B, C, G, 1, kk * SLC_LEN))
        p = p.reshape(B, C, G, r, kk, SLC_LEN)
        return jnp.einsum('bcgrkl,bcgkld->bcgrd', p.astype(vg.dtype), vg)

    o = lax.map(one, (q_ch, s_ch, t_ch))
    return o.transpose(1, 0, 2, 3, 4, 5).reshape(B, S, G * r, D)


def nsa_attention(q, gates, shared):
    kc, vc, ks, vs, kw, vw = shared
    B, S, H, D = q.shape
    G = B_KV_GROUPS
    r = H // G
    slopes = alibi_slopes(H)
    sl = slopes.reshape(G, r)
    qg = q.reshape(B, S, G, r, D)
    t = jnp.arange(S)
    n_cmp = kc.shape[1]
    cend = jnp.arange(n_cmp) * CMP_STRIDE + CMP_LEN - 1
    dist_c = t[:, None] - cend[None, :]
    s = jnp.einsum('bsgrd,bngd->bsgrn', qg, kc,
                   preferred_element_type=jnp.float32) / math.sqrt(D)
    bias = -sl[None, :, :, None] * dist_c[:, None, None, :].astype(jnp.float32)
    p_c, _ = masked_softmax(s + bias, (dist_c >= 0)[:, None, None, :])
    o_cmp = jnp.einsum('bsgrn,bngd->bsgrd', p_c.astype(vc.dtype), vc).reshape(B, S, H, D)
    n_sel = S // SLC_LEN
    cs = jnp.arange(n_cmp) * CMP_STRIDE
    ss = jnp.arange(n_sel) * SLC_LEN
    ov = jnp.clip(jnp.minimum(cs[:, None] + CMP_LEN, ss[None, :] + SLC_LEN)
                  - jnp.maximum(cs[:, None], ss[None, :]), 0).astype(jnp.float32) / CMP_LEN
    imp = jnp.einsum('bsgrn,nj->bsgj', p_c, ov)
    jb = jnp.arange(n_sel)[None, :]
    cur = (t // SLC_LEN)[:, None]
    forced = (jb == 0) | (jb == cur) | (jb == cur - 1)
    imp = jnp.where(forced[:, None], SEL_FORCE, jnp.where((jb > cur)[:, None], -SEL_FORCE, imp))
    _, sel = lax.top_k(imp, min(SLC_TOPK, n_sel))
    o_slc = selected_attention(qg, ks, vs, sel, slopes)
    o_win, _ = banded_attention(q, kw, vw, slopes, WIN_LEN - 1, WIN_BLOCK, 1)
    o = (gates[..., 0:1] * o_cmp.astype(jnp.float32) + gates[..., 1:2] * o_slc.astype(jnp.float32)
         + gates[..., 2:3] * o_win.astype(jnp.float32))
    return o.astype(q.dtype)


def mixer_a(u, mem_n, w_in, w_mem_kv, w_out):
    B, S, _ = u.shape
    na = len(DIL_GROUPS) * A_HEADS_PER_GROUP
    proj = u @ w_in
    qkv = proj[..., :3 * na * HEAD_DIM].reshape(B, S, 3, na, HEAD_DIM)
    mq = proj[..., 3 * na * HEAD_DIM:].reshape(B, S, MEM_HEADS, HEAD_DIM)
    o_dil = dilated_attention(qkv[:, :, 0], qkv[:, :, 1], qkv[:, :, 2])
    o_mem = memory_attention(mq, mem_n, w_mem_kv)
    return jnp.concatenate([o_dil.reshape(B, S, -1), o_mem.reshape(B, S, -1)], axis=-1) @ w_out


def mixer_b(u, mem_n, shared, w_in, w_mem_kv, w_out):
    B, S, _ = u.shape
    qd = B_HEADS * HEAD_DIM
    proj = u @ w_in
    q = proj[..., :qd].reshape(B, S, B_HEADS, HEAD_DIM)
    gates = jax.nn.sigmoid(proj[..., qd:qd + 3 * B_HEADS].astype(jnp.float32)).reshape(B, S, B_HEADS, 3)
    mq = proj[..., qd + 3 * B_HEADS:].reshape(B, S, MEM_HEADS, HEAD_DIM)
    o_nsa = nsa_attention(q, gates, shared)
    o_mem = memory_attention(mq, mem_n, w_mem_kv)
    return jnp.concatenate([o_nsa.reshape(B, S, -1), o_mem.reshape(B, S, -1)], axis=-1) @ w_out


def swiglu(u, w_gu, w_down):
    gu = u @ w_gu
    return (jax.nn.silu(gu[..., :D_FF]) * gu[..., D_FF:]) @ w_down


def setup_inputs(seed: int = 0) -> dict:
    key = jax.random.key(seed)
    ks = jax.random.split(key, 17)
    n_a = DEPTH // 2
    n_b = DEPTH - n_a
    na = len(DIL_GROUPS) * A_HEADS_PER_GROUP
    a_cols = 3 * na * HEAD_DIM + MEM_HEADS * HEAD_DIM
    b_cols = B_HEADS * HEAD_DIM + 3 * B_HEADS + MEM_HEADS * HEAD_DIM
    a_out_in = A_HEADS_PER_GROUP * HEAD_DIM + MEM_HEADS * HEAD_DIM
    b_out_in = B_HEADS * HEAD_DIM + MEM_HEADS * HEAD_DIM
    f = jnp.float32

    def w(k, shape, fan_in):
        return jax.random.normal(k, shape, f) * fan_in ** -0.5

    return {
        "x": jax.random.normal(ks[0], (BATCH, SEQ, D_MODEL), f),
        "mem": jax.random.normal(ks[1], (BATCH, N_MEM, D_MODEL), f),
        "norm_g": 1.0 + 0.01 * jax.random.normal(ks[2], (DEPTH, 5, D_MODEL), f),
        "a_w_in": w(ks[3], (n_a, D_MODEL, a_cols), D_MODEL),
        "a_w_out": w(ks[4], (n_a, a_out_in, D_MODEL), a_out_in),
        "b_w_in": w(ks[5], (n_b, D_MODEL, b_cols), D_MODEL),
        "b_w_out": w(ks[6], (n_b, b_out_in, D_MODEL), b_out_in),
        "mem_w_kv": w(ks[7], (DEPTH, D_MODEL, 2 * MEM_HEADS * HEAD_DIM), D_MODEL),
        "ffn_w_gu": w(ks[8], (DEPTH, D_MODEL, 2 * D_FF), D_MODEL),
        "ffn_w_down": w(ks[9], (DEPTH, D_FF, D_MODEL), D_FF),
        "kv_norm_g": 1.0 + 0.01 * jax.random.normal(ks[10], (D_MODEL,), f),
        "kv_w": w(ks[11], (D_MODEL, 6 * B_KV_GROUPS * HEAD_DIM), D_MODEL),
        "cmp_pe": 0.02 * jax.random.normal(ks[12], (2, CMP_LEN, HEAD_DIM), f),
        "cmp_wk1": w(ks[13], (CMP_LEN * HEAD_DIM, CMP_HIDDEN), CMP_LEN * HEAD_DIM),
        "cmp_wk2": w(ks[14], (CMP_HIDDEN, HEAD_DIM), CMP_HIDDEN),
        "cmp_wv1": w(ks[15], (CMP_LEN * HEAD_DIM, CMP_HIDDEN), CMP_LEN * HEAD_DIM),
        "cmp_wv2": w(ks[16], (CMP_HIDDEN, HEAD_DIM), CMP_HIDDEN),
    }


def reference(x, mem, norm_g, a_w_in, a_w_out, b_w_in, b_w_out, mem_w_kv, ffn_w_gu,
              ffn_w_down, kv_norm_g, kv_w, cmp_pe, cmp_wk1, cmp_wk2, cmp_wv1, cmp_wv2):
    n_a = DEPTH // 2
    shared = None
    for l in range(DEPTH):
        g = norm_g[l]
        mem_n = rmsnorm(mem, g[4])
        u = rmsnorm(x, g[0])
        if l < n_a:
            o = mixer_a(u, mem_n, a_w_in[l], mem_w_kv[l], a_w_out[l])
        else:
            if l == n_a:
                shared = nsa_shared_kv(x, kv_norm_g, kv_w, cmp_pe, cmp_wk1, cmp_wk2, cmp_wv1, cmp_wv2)
            o = mixer_b(u, mem_n, shared, b_w_in[l - n_a], mem_w_kv[l], b_w_out[l - n_a])
        x = x + rmsnorm(o, g[1])
        x = x + rmsnorm(swiglu(rmsnorm(x, g[2]), ffn_w_gu[l], ffn_w_down[l]), g[3])
    return x
```

```cpp
#include <hip/hip_runtime.h>
#include <hip/hip_cooperative_groups.h>
#include <cstdio>
#include <cstring>
namespace cg = cooperative_groups;

#define LAS __attribute__((address_space(3)))
typedef unsigned short bf16_t;
typedef short bf16x8 __attribute__((ext_vector_type(8)));
typedef float f32x4 __attribute__((ext_vector_type(4)));
typedef float f32x2 __attribute__((ext_vector_type(2)));
typedef unsigned u32x4 __attribute__((ext_vector_type(4)));
typedef unsigned u32x2 __attribute__((ext_vector_type(2)));

constexpr int D_MODEL = 2048, NTOK = 8192, SEQ = 2048, NBATCH = 4, DFF = 5632, HD = 128;
constexpr int A_COLS = 9728, B_COLS_SRC = 2084, B_COLS = 2304, NCMP = 127;
constexpr int NWAVES = 8, NTHREADS = 512;
constexpr int LDS_BYTES = 131072;

constexpr size_t SZ_WAIN = (size_t)A_COLS * 2048 * 2, SZ_WAOUT = (size_t)2048 * 1536 * 2, SZ_WBIN = (size_t)B_COLS * 2048 * 2, SZ_WBOUT = (size_t)2048 * 2048 * 2;
constexpr size_t SZ_WGU = (size_t)11264 * 2048 * 2, SZ_WDOWN = (size_t)2048 * 5632 * 2, SZ_WC1 = (size_t)512 * 4096 * 2, SZ_WC2 = (size_t)256 * 512 * 2;
constexpr size_t WS_WAIN = 0;
constexpr size_t WS_WAOUT = WS_WAIN + 2 * SZ_WAIN;
constexpr size_t WS_WBIN = WS_WAOUT + 2 * SZ_WAOUT;
constexpr size_t WS_WBOUT = WS_WBIN + 2 * SZ_WBIN;
constexpr size_t WS_WMEM = WS_WBOUT + 2 * SZ_WBOUT;
constexpr size_t WS_WGU = WS_WMEM + (size_t)4096 * 2048 * 2;
constexpr size_t WS_WDOWN = WS_WGU + 4 * SZ_WGU;
constexpr size_t WS_WKV = WS_WDOWN + 4 * SZ_WDOWN;
constexpr size_t WS_WC1 = WS_WKV + (size_t)3072 * 2048 * 2;
constexpr size_t WS_WC2 = WS_WC1 + 2 * SZ_WC1;
constexpr size_t WS_PROJ = WS_WC2 + 2 * SZ_WC2;
constexpr size_t WS_OBUF = WS_PROJ + (size_t)NTOK * A_COLS * 2;
constexpr size_t WS_XH = WS_OBUF + (size_t)NTOK * 2048 * 4;
constexpr size_t WS_CAT = WS_XH + (size_t)NTOK * 2048 * 2;
constexpr size_t WS_KVS = WS_CAT + (size_t)NTOK * 2048 * 2;
constexpr size_t WS_MEMKV = WS_KVS + (size_t)NTOK * 3072 * 2;
constexpr size_t WS_MEMHAT = WS_MEMKV + (size_t)1024 * 4096 * 2;
constexpr size_t WS_HID = WS_MEMHAT + (size_t)1024 * 2048 * 2;
constexpr size_t WS_KCV = WS_HID + (size_t)2 * 2048 * 512 * 2;
constexpr size_t WS_END = WS_KCV + (size_t)2 * 2048 * 256 * 2;

#define LDS_WAIT() asm volatile("s_waitcnt lgkmcnt(0)" ::: "memory")
__device__ __forceinline__ unsigned f2bf(float f) { unsigned u = __builtin_bit_cast(unsigned, f); return (u + 0x7fffu + ((u >> 16) & 1u)) >> 16; }
__device__ __forceinline__ unsigned pk2(float lo, float hi) { return f2bf(lo) | (f2bf(hi) << 16); }
__device__ __forceinline__ float bflo(unsigned w) { return __builtin_bit_cast(float, w << 16); }
__device__ __forceinline__ float bfhi(unsigned w) { return __builtin_bit_cast(float, w & 0xffff0000u); }
__device__ __forceinline__ float wave_sum(float v) {
#pragma unroll
    for (int o = 1; o < 64; o <<= 1) v += __shfl_xor(v, o);
    return v;
}
__device__ __forceinline__ float wave_max(float v) {
#pragma unroll
    for (int o = 1; o < 64; o <<= 1) v = fmaxf(v, __shfl_xor(v, o));
    return v;
}

namespace pg8 {
constexpr int BM = 256, BK = 64, HALF = 128, HTB = HALF * BK * 2, STAGE_BYTES = 8 * HTB, NXCD = 8, WGM = 8;
__device__ __forceinline__ int lds_byte(int r, int c) { const int st = (r >> 4) * 2 + (c >> 5), rr = r & 15, cc = c & 31, ob = rr * 64 + cc * 2; return st * 1024 + (ob ^ (((ob >> 9) & 1) << 5)); }
__device__ __forceinline__ void stage_rc(int b, int& R, int& C) { const int st = b / 1024, sb = b % 1024, swz = sb ^ (((sb >> 9) & 1) << 5); R = (st >> 1) * 16 + swz / 64; C = (st & 1) * 32 + (swz % 64) / 2; }
__device__ __forceinline__ int perm32(int rho) { const int n = rho >> 4, i = rho & 15; return 8 * (i >> 2) + 4 * n + (i & 3); }
struct Unit { int pm, pn; };
struct Gemm { const bf16_t* A; const bf16_t* Bt; int M, N, K; };
struct StaticOrder {
    int nM, nN, nwg, G, c;
    __device__ void init(int M, int N, int G_, int c_) { nM = M / BM; nN = N / BM; nwg = nM * nN; G = G_; c = c_; }
    __device__ bool next(int i, Unit& u) const {
        const long L = (long)i * G + c; if (L >= nwg) return false;
        int wgid = (int)L; { const int q = nwg / NXCD, r = nwg % NXCD, xcd = wgid % NXCD, off = wgid / NXCD; wgid = (xcd < r ? xcd * (q + 1) : r * (q + 1) + (xcd - r) * q) + off; }
        const int nig = WGM * nN, gid = wgid / nig, fm = gid * WGM, gsz = (nM - fm) < WGM ? (nM - fm) : WGM;
        u.pm = fm + ((wgid % nig) % gsz); u.pn = (wgid % nig) / gsz; return true;
    }
    __device__ __forceinline__ void a_ready(const Unit&) const {}
    __device__ __forceinline__ void done(const Unit&) const {}
};
__device__ __forceinline__ unsigned cvt_pk_bf16(float lo, float hi) { unsigned r; asm volatile("v_cvt_pk_bf16_f32 %0, %1, %2" : "=v"(r) : "v"(lo), "v"(hi)); return r; }

struct EpiF32 {
    static constexpr bool PERM = false;
    float* C; int ldc;
    __device__ __forceinline__ void operator()(const f32x4 (&acc)[2][2][4][2], const Unit& u, int wr, int wc, int fr, int fq) const {
        const int row0 = u.pm * BM + wr * 64 + fr, col0 = u.pn * BM + wc * 32 + 4 * fq;
#pragma unroll
        for (int ai = 0; ai < 2; ++ai)
#pragma unroll
            for (int m = 0; m < 4; ++m) { float* rowp = C + (size_t)(row0 + ai * HALF + m * 16) * ldc + col0;
#pragma unroll
                for (int bj = 0; bj < 2; ++bj)
#pragma unroll
                    for (int n = 0; n < 2; ++n) *(f32x4*)(rowp + bj * HALF + n * 16) = acc[ai][bj][m][n]; }
    }
};
__device__ __forceinline__ float gelu_tanh(float x) { const float t = 1.5957691216f * (x + 0.044715f * x * x * x); return x / (1.0f + __expf(-t)); }
template <int ACT  > struct EpiBf16 {
    static constexpr bool PERM = true;
    bf16_t* O; int ldc;
    __device__ __forceinline__ void operator()(const f32x4 (&acc)[2][2][4][2], const Unit& u, int wr, int wc, int fr, int fq) const {
        const int row0 = u.pm * BM + wr * 64 + fr, col0 = u.pn * BM + wc * 32 + 8 * fq;
#pragma unroll
        for (int ai = 0; ai < 2; ++ai)
#pragma unroll
            for (int m = 0; m < 4; ++m) { bf16_t* rowp = O + (size_t)(row0 + ai * HALF + m * 16) * ldc + col0;
#pragma unroll
                for (int bj = 0; bj < 2; ++bj) { f32x4 v0 = acc[ai][bj][m][0], v1 = acc[ai][bj][m][1];
                    if (ACT == 1) {
#pragma unroll
                        for (int j = 0; j < 4; ++j) { v0[j] = gelu_tanh(v0[j]); v1[j] = gelu_tanh(v1[j]); } }
                    u32x4 w; w.x = cvt_pk_bf16(v0[0], v0[1]); w.y = cvt_pk_bf16(v0[2], v0[3]); w.z = cvt_pk_bf16(v1[0], v1[1]); w.w = cvt_pk_bf16(v1[2], v1[3]);
                    *(u32x4*)(rowp + bj * HALF) = w; } }
    }
};
struct EpiSwiGLU {
    static constexpr bool PERM = true;
    bf16_t* O; int ldc;
    __device__ __forceinline__ void operator()(const f32x4 (&acc)[2][2][4][2], const Unit& u, int wr, int wc, int fr, int fq) const {
        const int row0 = u.pm * BM + wr * 64 + fr, col0 = u.pn * HALF + wc * 32 + 8 * fq;
#pragma unroll
        for (int ai = 0; ai < 2; ++ai)
#pragma unroll
            for (int m = 0; m < 4; ++m) { bf16_t* rowp = O + (size_t)(row0 + ai * HALF + m * 16) * ldc + col0;
                f32x4 v0, v1;
#pragma unroll
                for (int j = 0; j < 4; ++j) { const float g0 = acc[ai][0][m][0][j], g1 = acc[ai][0][m][1][j];
                    v0[j] = g0 / (1.0f + __expf(-g0)) * acc[ai][1][m][0][j]; v1[j] = g1 / (1.0f + __expf(-g1)) * acc[ai][1][m][1][j]; }
                u32x4 w; w.x = cvt_pk_bf16(v0[0], v0[1]); w.y = cvt_pk_bf16(v0[2], v0[3]); w.z = cvt_pk_bf16(v1[0], v1[1]); w.w = cvt_pk_bf16(v1[2], v1[3]);
                *(u32x4*)rowp = w; }
    }
};

template <class Epi, class Sched>
__device__ __forceinline__ void gemm_phase(LAS unsigned char* lds, const Gemm g, const Sched& S, const Epi& E) {
    int tid_ = threadIdx.x; asm volatile("" : "+v"(tid_));
    const int tid = tid_, wid = __builtin_amdgcn_readfirstlane(tid >> 6), lane = tid & 63, wr = wid >> 2, wc = wid & 3, fr = lane & 15, fq = lane >> 4;
    const int K = g.K, nt = K / BK;
    unsigned voffA[2], voffB[2];
#pragma unroll
    for (int i = 0; i < 2; ++i) { int R, C; stage_rc(tid * 16 + i * 8192, R, C); const int Rb = Epi::PERM ? ((R & ~31) + perm32(R & 31)) : R;
        voffA[i] = (unsigned)(R * K + C) * 2u; voffB[i] = (unsigned)(Rb * K + C) * 2u; }
    const size_t kstep = (size_t)(BK * 2);
    const size_t hstep = (size_t)HALF * K * 2;
    const size_t tstep = 2 * hstep;
    const unsigned ldsw = (unsigned)wid * 1024u;
    const int aoff = lds_byte(wr * 64 + fr, fq * 8), boff = lds_byte(wc * 32 + fr, fq * 8);
#define PG8_SA(b, h) (((b) * 2 + (h)) * HTB)
#define PG8_SB(b, h) ((4 + (b) * 2 + (h)) * HTB)
#define PG8_STAGE(bufoff, gbase, voff) do { _Pragma("unroll") for (int _i = 0; _i < 2; ++_i) \
        __builtin_amdgcn_global_load_lds((const unsigned*)((const char*)(gbase) + (voff)[_i]), (LAS unsigned*)(lds + (bufoff) + ldsw + _i * 8192), 16, 0, 0); } while (0)
#define PG8_LDA(dst, b, h) do { _Pragma("unroll") for (int m = 0; m < 4; ++m) _Pragma("unroll") for (int k = 0; k < 2; ++k) dst[m][k] = *(const LAS bf16x8*)(lds + PG8_SA(b, h) + aoff + m * 2048 + k * 1024); } while (0)
#define PG8_LDB(dst, b, h) do { _Pragma("unroll") for (int n = 0; n < 2; ++n) _Pragma("unroll") for (int k = 0; k < 2; ++k) dst[n][k] = *(const LAS bf16x8*)(lds + PG8_SB(b, h) + boff + n * 2048 + k * 1024); } while (0)
#define PG8_MMA(ai, bj, At, Bt) do { __builtin_amdgcn_s_setprio(1); _Pragma("unroll") for (int m = 0; m < 4; ++m) _Pragma("unroll") for (int n = 0; n < 2; ++n) _Pragma("unroll") for (int k = 0; k < 2; ++k) \
        acc[ai][bj][m][n] = __builtin_amdgcn_mfma_f32_16x16x32_bf16(Bt[n][k], At[m][k], acc[ai][bj][m][n], 0, 0, 0); __builtin_amdgcn_s_setprio(0); } while (0)
#define PG8_WAIT_V(n) asm volatile("s_waitcnt vmcnt(" #n ")" ::: "memory")
#define PG8_WAIT_L(n) asm volatile("s_waitcnt lgkmcnt(" #n ")" ::: "memory")
#define PG8_BAR __builtin_amdgcn_s_barrier()
#define PG8_SCHED __builtin_amdgcn_sched_barrier(0)
    Unit cur, nxt; int ui = 0;
    if (!S.next(0, cur)) return;
    f32x4 acc[2][2][4][2];
#pragma unroll
    for (int a = 0; a < 2; ++a)
#pragma unroll
        for (int b = 0; b < 2; ++b)
#pragma unroll
            for (int m = 0; m < 4; ++m)
#pragma unroll
                for (int n = 0; n < 2; ++n) acc[a][b][m][n] = (f32x4){0.f, 0.f, 0.f, 0.f};
    bf16x8 At[4][2], B0[2][2], B1[2][2];
    const char* cA = (const char*)g.A + (size_t)cur.pm * tstep; const char* cB = (const char*)g.Bt + (size_t)cur.pn * tstep;
    S.a_ready(cur);
    PG8_STAGE(PG8_SB(0, 0), cB, voffB); PG8_STAGE(PG8_SA(0, 0), cA, voffA); PG8_STAGE(PG8_SB(0, 1), cB + hstep, voffB); PG8_STAGE(PG8_SA(0, 1), cA + hstep, voffA);
    if (wr == 1) PG8_BAR;
    PG8_WAIT_V(4); PG8_BAR;
    PG8_STAGE(PG8_SB(1, 0), cB + kstep, voffB); PG8_STAGE(PG8_SA(1, 0), cA + kstep, voffA); PG8_STAGE(PG8_SB(1, 1), cB + hstep + kstep, voffB);
    PG8_WAIT_V(6); PG8_BAR;
    for (;;) {
        const bool has_next = S.next(ui + 1, nxt);
        const char* nA = has_next ? (const char*)g.A + (size_t)nxt.pm * tstep : cA; const char* nB = has_next ? (const char*)g.Bt + (size_t)nxt.pn * tstep : cB;
        for (int t = 0; t < nt; t += 2) {
            const bool last = (t == nt - 2);
            const char* a1 = cA + (size_t)(t + 1) * kstep;
            const char* a2 = last ? nA : cA + (size_t)(t + 2) * kstep; const char* b2 = last ? nB : cB + (size_t)(t + 2) * kstep;
            const char* a3 = a2 + kstep; const char* b3 = b2 + kstep;
            if (last && has_next) S.a_ready(nxt);
            PG8_LDB(B0, 0, 0); PG8_SCHED; PG8_LDA(At, 0, 0); PG8_STAGE(PG8_SA(1, 1), a1 + hstep, voffA);
            PG8_WAIT_L(8); PG8_BAR; PG8_WAIT_L(0); PG8_MMA(0, 0, At, B0); PG8_BAR; PG8_SCHED;
            PG8_LDB(B1, 0, 1); PG8_STAGE(PG8_SB(0, 0), b2, voffB);
            PG8_BAR; PG8_WAIT_L(0); PG8_MMA(0, 1, At, B1); PG8_BAR;
            PG8_LDA(At, 0, 1); PG8_STAGE(PG8_SA(0, 0), a2, voffA);
            PG8_BAR; PG8_WAIT_L(0); PG8_MMA(1, 0, At, B0); PG8_BAR; PG8_SCHED;
            PG8_STAGE(PG8_SB(0, 1), b2 + hstep, voffB);
            PG8_WAIT_V(6); PG8_BAR; PG8_MMA(1, 1, At, B1); PG8_BAR;
            PG8_LDB(B0, 1, 0); PG8_SCHED; PG8_LDA(At, 1, 0); PG8_STAGE(PG8_SA(0, 1), a2 + hstep, voffA);
            PG8_WAIT_L(8); PG8_BAR; PG8_WAIT_L(0); PG8_MMA(0, 0, At, B0); PG8_BAR; PG8_SCHED;
            PG8_LDB(B1, 1, 1); PG8_STAGE(PG8_SB(1, 0), b3, voffB);
            PG8_BAR; PG8_WAIT_L(0); PG8_MMA(0, 1, At, B1); PG8_BAR;
            PG8_LDA(At, 1, 1); PG8_STAGE(PG8_SA(1, 0), a3, voffA);
            PG8_BAR; PG8_WAIT_L(0); PG8_MMA(1, 0, At, B0); PG8_BAR; PG8_SCHED;
            PG8_STAGE(PG8_SB(1, 1), b3 + hstep, voffB);
            PG8_WAIT_V(6); PG8_BAR; PG8_MMA(1, 1, At, B1); PG8_BAR;
        }
        E(acc, cur, wr, wc, fr, fq); S.done(cur);
        if (!has_next) break;
#pragma unroll
        for (int a = 0; a < 2; ++a)
#pragma unroll
            for (int b = 0; b < 2; ++b)
#pragma unroll
                for (int m = 0; m < 4; ++m)
#pragma unroll
                    for (int n = 0; n < 2; ++n) acc[a][b][m][n] = (f32x4){0.f, 0.f, 0.f, 0.f};
        cur = nxt; cA = nA; cB = nB; ++ui;
    }
    PG8_WAIT_V(0);
    if (wr == 0) PG8_BAR;
    PG8_BAR;
#undef PG8_SA
#undef PG8_SB
#undef PG8_STAGE
#undef PG8_LDA
#undef PG8_LDB
#undef PG8_MMA
#undef PG8_WAIT_V
#undef PG8_WAIT_L
#undef PG8_BAR
#undef PG8_SCHED
}
}

struct JobDesc { unsigned long long in_off, dst_off; int in_idx, gain_idx, gain_off, ldw, col0, ncols, K, nrows, mode, pad; };
constexpr int MAXJOBS = 32;
struct Params { const float* in[17]; float* out; unsigned char* ws; JobDesc jobs[MAXJOBS]; int njobs, pad; };
enum { I_X = 0, I_MEM, I_NORMG, I_AWIN, I_AWOUT, I_BWIN, I_BWOUT, I_MEMWKV, I_WGU, I_WDOWN, I_KVNG, I_KVW, I_PE, I_WK1, I_WK2, I_WV1, I_WV2 };

struct ConvJob { const float* W; const float* gain; bf16_t* dst; int ldw, col0, ncols, K, nrows, mode; };
__device__ __forceinline__ bool conv_get(const Params& p, int j, ConvJob& J) {
    if (j >= p.njobs) return false;
    const JobDesc& d = p.jobs[j];
    J.W = p.in[d.in_idx] + d.in_off; J.gain = d.gain_idx >= 0 ? p.in[d.gain_idx] + d.gain_off : nullptr; J.dst = (bf16_t*)(p.ws + d.dst_off);
    J.ldw = d.ldw; J.col0 = d.col0; J.ncols = d.ncols; J.K = d.K; J.nrows = d.nrows; J.mode = d.mode;
    return true;
}
__device__ __forceinline__ void conv_run(const ConvJob& J, LAS float* scr, int gw, int ngw, int lane) {
    const int nblk = J.nrows / 32, kblk = J.K / 64, items = nblk * kblk;
    for (int it = gw; it < items; it += ngw) {
        const int kb = it / nblk, nb = it % nblk, k0 = 64 * kb, n0 = 32 * nb;
        const int n = n0 + (lane & 31);
        const bool ok = n < J.ncols;
        const int sc = J.mode == 1 ? (((n >> 7) & 1) * 5632 + (n >> 8) * 128 + (n & 127)) : (J.col0 + n);
#pragma unroll 8
        for (int i = 0; i < 32; ++i) { const int kk = 2 * i + (lane >> 5);
            float v = 0.f; if (ok) { v = J.W[(size_t)(k0 + kk) * J.ldw + sc]; if (J.gain) v *= J.gain[k0 + kk]; }
            scr[kk * 33 + (lane & 31)] = v; }
        LDS_WAIT();
        const int c = lane & 7;
#pragma unroll
        for (int j = 0; j < 4; ++j) { const int nn = (lane >> 3) + 8 * j; const LAS float* s = scr + (8 * c) * 33 + nn;
            u32x4 o; o.x = pk2(s[0 * 33], s[1 * 33]); o.y = pk2(s[2 * 33], s[3 * 33]); o.z = pk2(s[4 * 33], s[5 * 33]); o.w = pk2(s[6 * 33], s[7 * 33]);
            *(u32x4*)(J.dst + (size_t)(n0 + nn) * J.K + k0 + 8 * c) = o; }
        LDS_WAIT();
    }
}

__device__ __forceinline__ void rms_row(const float* xrow, bf16_t* orow, float* copy, int lane) {
    const f32x4* xr = (const f32x4*)xrow + lane;
    f32x4 v[8]; float s = 0.f;
#pragma unroll
    for (int j = 0; j < 8; ++j) { v[j] = xr[64 * j]; s += (v[j].x * v[j].x + v[j].y * v[j].y) + (v[j].z * v[j].z + v[j].w * v[j].w); }
    const float rs = rsqrtf(wave_sum(s) * (1.f / 2048.f) + 1e-6f);
    u32x2* o8 = (u32x2*)orow + lane;
#pragma unroll
    for (int j = 0; j < 8; ++j) { u32x2 w; w.x = pk2(v[j].x * rs, v[j].y * rs); w.y = pk2(v[j].z * rs, v[j].w * rs); o8[64 * j] = w; }
    if (copy) { f32x4* c4 = (f32x4*)copy + lane;
#pragma unroll
        for (int j = 0; j < 8; ++j) c4[64 * j] = v[j]; }
}
__device__ __forceinline__ void rowop_row(float* xrow, const float* orow, const float* gain, bf16_t* hrow, int lane) {
    const f32x4* o4 = (const f32x4*)orow + lane; f32x4* x4 = (f32x4*)xrow + lane; const f32x4* g4 = (const f32x4*)gain + lane;
    f32x4 o[8]; float s = 0.f;
#pragma unroll
    for (int j = 0; j < 8; ++j) { o[j] = o4[64 * j]; s += (o[j].x * o[j].x + o[j].y * o[j].y) + (o[j].z * o[j].z + o[j].w * o[j].w); }
    const float rs = rsqrtf(wave_sum(s) * (1.f / 2048.f) + 1e-6f);
    float s2 = 0.f;
#pragma unroll
    for (int j = 0; j < 8; ++j) { const f32x4 g = g4[64 * j]; f32x4 x = x4[64 * j]; x = x + o[j] * rs * g; x4[64 * j] = x; o[j] = x; s2 += (x.x * x.x + x.y * x.y) + (x.z * x.z + x.w * x.w); }
    const float rs2 = rsqrtf(wave_sum(s2) * (1.f / 2048.f) + 1e-6f);
    u32x2* o8 = (u32x2*)hrow + lane;
#pragma unroll
    for (int j = 0; j < 8; ++j) { u32x2 w; w.x = pk2(o[j].x * rs2, o[j].y * rs2); w.y = pk2(o[j].z * rs2, o[j].w * rs2); o8[64 * j] = w; }
}

__device__ __forceinline__ float dot128(const bf16_t* kp, const LAS float* qs) {
    const u32x4* k4 = (const u32x4*)kp; float s = 0.f;
#pragma unroll 4
    for (int c = 0; c < 16; ++c) { const u32x4 w = k4[c]; const f32x4 a = *(const LAS f32x4*)(qs + 8 * c), b = *(const LAS f32x4*)(qs + 8 * c + 4);
        s += bflo(w.x) * a.x + bfhi(w.x) * a.y + bflo(w.y) * a.z + bfhi(w.y) * a.w + bflo(w.z) * b.x + bfhi(w.z) * b.y + bflo(w.w) * b.z + bfhi(w.w) * b.w; }
    return s;
}
__device__ __forceinline__ void load_q(const bf16_t* q, LAS float* qs, int lane) {
    const unsigned w = *(const unsigned*)(q + 2 * lane);
    LDS_WAIT();
    qs[2 * lane] = bflo(w) * 0.08838834764831845f; qs[2 * lane + 1] = bfhi(w) * 0.08838834764831845f;
    LDS_WAIT();
}
template <class KF>
__device__ __forceinline__ void attn_wave(const KF& kf, int nkeys, const LAS float* qs, LAS float* sc, int lane, float& o0, float& o1, float& mOut, float& denOut) {
    float m = -INFINITY;
    for (int base = 0; base < nkeys; base += 64) {
        const int i = base + lane; float s = -INFINITY;
        if (i < nkeys) { const bf16_t* kp; const bf16_t* vp; float bias; if (kf(i, kp, vp, bias)) s = dot128(kp, qs) + bias; sc[i] = s; }
        m = fmaxf(m, s);
    }
    m = wave_max(m); if (m == -INFINITY) m = 0.f;
    LDS_WAIT();
    float sum = 0.f;
    for (int i = lane; i < nkeys; i += 64) { const float s = sc[i]; const float e = (s == -INFINITY) ? 0.f : __expf(s - m); sc[i] = e; sum += e; }
    sum = wave_sum(sum); const float den = fmaxf(sum, 1e-30f);
    LDS_WAIT();
    float a0 = 0.f, a1 = 0.f;
#pragma unroll 4
    for (int i = 0; i < nkeys; ++i) { const float pr = sc[i]; const bf16_t* kp; const bf16_t* vp; float bias; kf(i, kp, vp, bias);
        const unsigned w = *(const unsigned*)(vp + 2 * lane); a0 += pr * bflo(w); a1 += pr * bfhi(w); }
    o0 = a0 / den; o1 = a1 / den; mOut = m; denOut = den;
}

__device__ __forceinline__ void mem_attn_item(const bf16_t* proj, int ldp, int mqoff, const bf16_t* memkv, int l, bf16_t* cat, int ldc, int memoff, int t, int h, LAS float* qs, LAS float* sc, int lane_) {
    int lane = lane_; asm volatile("" : "+v"(lane));
    const int b = t >> 11;
    load_q(proj + (size_t)t * ldp + mqoff + h * HD, qs, lane);
    const bf16_t* kb = memkv + (size_t)(b * 256) * 4096 + l * 1024 + h * HD;
    auto kf = [&](int i, const bf16_t*& kp, const bf16_t*& vp, float& bias) { kp = kb + (size_t)i * 4096; vp = kp + 512; bias = 0.f; return true; };
    float o0, o1, m, den; attn_wave(kf, 256, qs, sc, lane, o0, o1, m, den);
    *(unsigned*)(cat + (size_t)t * ldc + memoff + h * HD + 2 * lane) = pk2(o0, o1);
}
__device__ __forceinline__ void atta_item(const bf16_t* proj, bf16_t* cat, int t, int j, LAS float* qs, LAS float* sc, int lane_) {
    int lane = lane_; asm volatile("" : "+v"(lane));
    const int b = t >> 11, s = t & 2047;
    float og0[3], og1[3], lse[3];
#pragma unroll
    for (int gi = 0; gi < 3; ++gi) {
        const int d = gi == 0 ? 1 : (gi == 1 ? 4 : 16), hh = gi * 8 + j;
        const float slope = exp2f(-8.0f * (float)(hh + 1) / 24.0f);
        load_q(proj + (size_t)t * A_COLS + hh * HD, qs, lane);
        const bf16_t* kbase = proj + (size_t)(b * SEQ) * A_COLS + 3072 + hh * HD;
        auto kf = [&](int i, const bf16_t*& kp, const bf16_t*& vp, float& bias) { const int sp = s - i * d; const int spc = sp < 0 ? 0 : sp;
            kp = kbase + (size_t)spc * A_COLS; vp = kp + 3072; bias = -slope * (float)(i * d); return sp >= 0; };
        float m, den; attn_wave(kf, 129, qs, sc, lane, og0[gi], og1[gi], m, den);
        lse[gi] = m + __logf(den);
    }
    const float mx = fmaxf(lse[0], fmaxf(lse[1], lse[2]));
    const float e0 = __expf(lse[0] - mx), e1 = __expf(lse[1] - mx), e2 = __expf(lse[2] - mx), inv = 1.0f / (e0 + e1 + e2);
    const float r0 = (e0 * og0[0] + e1 * og0[1] + e2 * og0[2]) * inv, r1 = (e0 * og1[0] + e1 * og1[1] + e2 * og1[2]) * inv;
    *(unsigned*)(cat + (size_t)t * 1536 + j * HD + 2 * lane) = pk2(r0, r1);
}
__device__ __forceinline__ void attb_item(const bf16_t* proj, const bf16_t* kvs, const bf16_t* kc, const bf16_t* vc, bf16_t* cat, int t, int g, LAS float* qs, LAS float* sc, LAS float* pc, LAS int* blk, int lane_) {
    int lane = lane_; asm volatile("" : "+v"(lane));
    const int b = t >> 11, s = t & 2047, cur = s >> 6;
    float oc0[3], oc1[3];
#pragma unroll
    for (int r = 0; r < 3; ++r) {
        const int h = 3 * g + r; const float slope = exp2f(-8.0f * (float)(h + 1) / 12.0f);
        load_q(proj + (size_t)t * B_COLS + h * HD, qs, lane);
        auto kf = [&](int n, const bf16_t*& kp, const bf16_t*& vp, float& bias) { const int cend = 16 * n + 31; const size_t row = (size_t)((b * NCMP + n) * 4 + g);
            kp = kc + row * 256; vp = vc + row * 256; bias = -slope * (float)(s - cend); return s >= cend; };
        float m, den; attn_wave(kf, NCMP, qs, pc + r * 128, lane, oc0[r], oc1[r], m, den);
        const float inv = 1.0f / den;
        for (int i = lane; i < 128; i += 64) pc[r * 128 + i] = (i < NCMP) ? pc[r * 128 + i] * inv : 0.f;
        LDS_WAIT();
    }
    const int jb = lane & 31;
    float imp = 0.f;
#pragma unroll
    for (int r = 0; r < 3; ++r) { const LAS float* P = pc + r * 128; const int n0 = 4 * jb;
        imp += (n0 >= 1 ? 0.5f * P[n0 - 1] : 0.f) + P[n0] + P[n0 + 1] + P[n0 + 2] + 0.5f * P[n0 + 3]; }
    const bool forced = (jb == 0) || (jb == cur) || (jb == cur - 1);
    imp = forced ? 1e4f : (jb > cur ? -1e4f : imp);
    int rank = 0;
    for (int o = 0; o < 32; ++o) { const float v = __shfl(imp, o); rank += (v > imp || (v == imp && o < jb)) ? 1 : 0; }
    const bool sel = (rank < 16) && (jb <= cur);
    const unsigned mask = (unsigned)(__ballot(sel && lane < 32) & 0xffffffffull);
    const int nsel = __popc(mask);
    if (lane < 16) { int cnt = 0, bsel = 0; for (int jj = 0; jj < 32; ++jj) { if ((mask >> jj) & 1u) { if (cnt == lane) bsel = jj; ++cnt; } } blk[lane] = bsel; }
    LDS_WAIT();
#pragma unroll
    for (int r = 0; r < 3; ++r) {
        const int h = 3 * g + r; const float slope = exp2f(-8.0f * (float)(h + 1) / 12.0f);
        load_q(proj + (size_t)t * B_COLS + h * HD, qs, lane);
        const bf16_t* kvb = kvs + (size_t)(b * SEQ) * 3072 + g * HD;
        auto kfs = [&](int i, const bf16_t*& kp, const bf16_t*& vp, float& bias) { const int sp = 64 * blk[i >> 6] + (i & 63);
            kp = kvb + (size_t)sp * 3072 + 2 * 512; vp = kp + 512; bias = -slope * (float)(s - sp); return sp <= s; };
        float os0, os1, m, den; attn_wave(kfs, nsel * 64, qs, sc, lane, os0, os1, m, den);
        auto kfw = [&](int i, const bf16_t*& kp, const bf16_t*& vp, float& bias) { const int sp = s - i; const int spc = sp < 0 ? 0 : sp;
            kp = kvb + (size_t)spc * 3072 + 4 * 512; vp = kp + 512; bias = -slope * (float)i; return sp >= 0; };
        float ow0, ow1; attn_wave(kfw, 512, qs, sc, lane, ow0, ow1, m, den);
        const bf16_t* gp = proj + (size_t)t * B_COLS + 2048 + h * 3;
        const float g0 = 1.0f / (1.0f + __expf(-bflo((unsigned)gp[0]))), g1 = 1.0f / (1.0f + __expf(-bflo((unsigned)gp[1]))), g2 = 1.0f / (1.0f + __expf(-bflo((unsigned)gp[2])));
        const float r0 = g0 * oc0[r] + g1 * os0 + g2 * ow0, r1 = g0 * oc1[r] + g1 * os1 + g2 * ow1;
        *(unsigned*)(cat + (size_t)t * 2048 + h * HD + 2 * lane) = pk2(r0, r1);
    }
}

__global__ void __launch_bounds__(NTHREADS, 2) mega_fwd(Params p) {
    extern __shared__ __attribute__((aligned(16))) unsigned char lds_raw[];
    LAS unsigned char* lds = (LAS unsigned char*)lds_raw;
    cg::grid_group grid = cg::this_grid();
    const int tid = threadIdx.x, lane = tid & 63, wave = __builtin_amdgcn_readfirstlane(tid >> 6);
    const int G = gridDim.x, bid = blockIdx.x;
    const int gw = bid * NWAVES + wave, ngw = G * NWAVES;
    unsigned char* ws = p.ws;
    float* X = p.out;
    bf16_t* XH = (bf16_t*)(ws + WS_XH); bf16_t* PROJ = (bf16_t*)(ws + WS_PROJ); float* OBUF = (float*)(ws + WS_OBUF);
    bf16_t* CAT = (bf16_t*)(ws + WS_CAT); bf16_t* KVS = (bf16_t*)(ws + WS_KVS); bf16_t* MEMKV = (bf16_t*)(ws + WS_MEMKV); bf16_t* MEMHAT = (bf16_t*)(ws + WS_MEMHAT);
    bf16_t* HID = (bf16_t*)(ws + WS_HID); bf16_t* KCV = (bf16_t*)(ws + WS_KCV); bf16_t* BLK = (bf16_t*)(ws + WS_OBUF);
    LAS float* wscr = (LAS float*)(lds + wave * 16384);
    LAS float* qs = wscr; LAS float* sc = wscr + 128; LAS float* pc = wscr + 128 + 1024; LAS int* blk = (LAS int*)(wscr + 128 + 1024 + 384);

    {
        ConvJob J;
        for (int j = 0; conv_get(p, j, J); ++j) conv_run(J, wscr, gw, ngw, lane);
        for (int m = gw; m < 1024; m += ngw) rms_row(p.in[I_MEM] + (size_t)m * 2048, MEMHAT + (size_t)m * 2048, nullptr, lane);
        for (int m = gw; m < NTOK; m += ngw) rms_row(p.in[I_X] + (size_t)m * 2048, XH + (size_t)m * 2048, X + (size_t)m * 2048, lane);
    }
    grid.sync();

    for (int l = 0; l < 4; ++l) {
        const bool isA = l < 2;
        for (int jb = 0; jb < 3; ++jb) {
            pg8::Gemm g; bf16_t* O; int ldc; int c = bid;
            if (jb == 0) { g.A = XH; g.M = NTOK; g.K = 2048;
                if (isA) { g.Bt = (const bf16_t*)(ws + WS_WAIN + l * SZ_WAIN); g.N = A_COLS; O = PROJ; ldc = A_COLS; }
                else { g.Bt = (const bf16_t*)(ws + WS_WBIN + (l - 2) * SZ_WBIN); g.N = B_COLS; O = PROJ; ldc = B_COLS; } }
            else if (jb == 1) { if (l != 0) continue; g.A = MEMHAT; g.Bt = (const bf16_t*)(ws + WS_WMEM); g.M = 1024; g.N = 4096; g.K = 2048; O = MEMKV; ldc = 4096; c = (bid + 64) % G; }
            else { if (l != 2) continue; g.A = XH; g.Bt = (const bf16_t*)(ws + WS_WKV); g.M = NTOK; g.N = 3072; g.K = 2048; O = KVS; ldc = 3072; }
            pg8::StaticOrder S; S.init(g.M, g.N, G, c);
            pg8::EpiBf16<0> E{O, ldc};
            pg8::gemm_phase(lds, g, S, E);
        }
        grid.sync();
        if (l == 2) {
            for (int it = gw; it < 2 * 2048; it += ngw) {
                const int w = it >> 11, row = it & 2047; bf16_t* dst = BLK + ((size_t)w * 2048 + row) * 4096;
                if (row < NBATCH * NCMP * 4) { const int gg = row & 3, bn = row >> 2, bb = bn / NCMP, n = bn % NCMP;
                    const bf16_t* src = KVS + (size_t)(bb * SEQ + 16 * n) * 3072 + w * 512 + gg * HD; const float* pe = p.in[I_PE] + w * 32 * HD;
                    for (int ll = 0; ll < 32; ++ll) { const unsigned v = *(const unsigned*)(src + (size_t)ll * 3072 + 2 * lane); const f32x2 e = *(const f32x2*)(pe + ll * HD + 2 * lane);
                        *(unsigned*)(dst + ll * HD + 2 * lane) = pk2(bflo(v) + e.x, bfhi(v) + e.y); } }
                else { for (int ll = 0; ll < 32; ++ll) *(unsigned*)(dst + ll * HD + 2 * lane) = 0u; }
            }
            grid.sync();
            for (int w = 0; w < 2; ++w) { pg8::Gemm g{BLK + (size_t)w * 2048 * 4096, (const bf16_t*)(ws + WS_WC1 + w * SZ_WC1), 2048, 512, 4096};
                pg8::StaticOrder S; S.init(2048, 512, G, (bid + 128 * w) % G); pg8::EpiBf16<1> E{HID + (size_t)w * 2048 * 512, 512}; pg8::gemm_phase(lds, g, S, E); }
            grid.sync();
            for (int w = 0; w < 2; ++w) { pg8::Gemm g{HID + (size_t)w * 2048 * 512, (const bf16_t*)(ws + WS_WC2 + w * SZ_WC2), 2048, 256, 512};
                pg8::StaticOrder S; S.init(2048, 256, G, (bid + 128 * w) % G); pg8::EpiBf16<0> E{KCV + (size_t)w * 2048 * 256, 256}; pg8::gemm_phase(lds, g, S, E); }
            grid.sync();
        }
        if (isA) {
            for (int it = gw; it < NTOK * 12; it += ngw) { const int t = it / 12, j = it % 12;
                if (j < 8) atta_item(PROJ, CAT, t, j, qs, sc, lane);
                else mem_attn_item(PROJ, A_COLS, 9216, MEMKV, l, CAT, 1536, 1024, t, j - 8, qs, sc, lane); }
        } else {
            for (int it = gw; it < NTOK * 8; it += ngw) { const int t = it >> 3, j = it & 7;
                if (j < 4) attb_item(PROJ, KVS, KCV, KCV + (size_t)2048 * 256, CAT, t, j, qs, sc, pc, blk, lane);
                else mem_attn_item(PROJ, B_COLS, 1536, MEMKV, l, CAT, 2048, 1536, t, j - 4, qs, sc, lane); }
        }
        grid.sync();
        for (int hf = 0; hf < 2; ++hf) {
            if (hf == 1) { pg8::Gemm g{XH, (const bf16_t*)(ws + WS_WGU + l * SZ_WGU), NTOK, 11264, 2048}; pg8::StaticOrder S; S.init(NTOK, 11264, G, bid);
                pg8::EpiSwiGLU E{PROJ, DFF}; pg8::gemm_phase(lds, g, S, E); grid.sync(); }
            { pg8::Gemm g; g.M = NTOK; g.N = 2048;
              if (hf == 0) { g.A = CAT; g.K = isA ? 1536 : 2048; g.Bt = isA ? (const bf16_t*)(ws + WS_WAOUT + l * SZ_WAOUT) : (const bf16_t*)(ws + WS_WBOUT + (l - 2) * SZ_WBOUT); }
              else { g.A = PROJ; g.K = DFF; g.Bt = (const bf16_t*)(ws + WS_WDOWN + l * SZ_WDOWN); }
              pg8::StaticOrder S; S.init(NTOK, 2048, G, bid); pg8::EpiF32 E{OBUF, 2048}; pg8::gemm_phase(lds, g, S, E); }
            grid.sync();
            const float* gain = p.in[I_NORMG] + (l * 5 + (hf == 0 ? 1 : 3)) * 2048;
            for (int m = gw; m < NTOK; m += ngw) rowop_row(X + (size_t)m * 2048, OBUF + (size_t)m * 2048, gain, XH + (size_t)m * 2048, lane);
            grid.sync();
        }
    }
}

extern "C" void kernel_launch(void* const* d_in, const int* in_sizes, int n_in, void* d_out, int out_size, void* d_ws, size_t ws_size, hipStream_t stream) {
    static int grid_blocks = 0;
    if (grid_blocks == 0) {
        if (n_in != 17 || ws_size < WS_END) { fprintf(stderr, "kernel_launch: unexpected n_in %d or ws_size %zu (< %zu)\n", n_in, ws_size, (size_t)WS_END); grid_blocks = -1; return; }
        int dev = 0, cus = 0, per_cu = 0;
        hipGetDevice(&dev);
        hipDeviceGetAttribute(&cus, hipDeviceAttributeMultiprocessorCount, dev);
        hipFuncSetAttribute((const void*)mega_fwd, hipFuncAttributeMaxDynamicSharedMemorySize, LDS_BYTES);
        hipOccupancyMaxActiveBlocksPerMultiprocessor(&per_cu, (const void*)mega_fwd, NTHREADS, LDS_BYTES);
        if (per_cu < 1) per_cu = 1;
        if (per_cu > 1) per_cu = 1;
        grid_blocks = cus * per_cu;
        (void)hipGetLastError();
    }
    if (grid_blocks < 0) return;
    static Params p;
    memset(&p, 0, sizeof(p));
    for (int i = 0; i < 17; ++i) p.in[i] = (const float*)d_in[i];
    p.out = (float*)d_out; p.ws = (unsigned char*)d_ws;
    {
        int n = 0;
        auto add = [&](int in_idx, size_t in_off, int gain_idx, int gain_off, size_t dst_off, int ldw, int col0, int ncols, int K, int nrows, int mode) {
            JobDesc& d = p.jobs[n++]; d.in_idx = in_idx; d.in_off = in_off; d.gain_idx = gain_idx; d.gain_off = gain_off; d.dst_off = dst_off; d.ldw = ldw; d.col0 = col0; d.ncols = ncols; d.K = K; d.nrows = nrows; d.mode = mode; d.pad = 0; };
        for (int l = 0; l < 4; ++l) add(I_WGU, (size_t)l * 2048 * 11264, I_NORMG, (l * 5 + 2) * 2048, WS_WGU + l * SZ_WGU, 11264, 0, 11264, 2048, 11264, 1);
        for (int l = 0; l < 4; ++l) add(I_WDOWN, (size_t)l * 5632 * 2048, -1, 0, WS_WDOWN + l * SZ_WDOWN, 2048, 0, 2048, 5632, 2048, 0);
        for (int l = 0; l < 2; ++l) add(I_AWIN, (size_t)l * 2048 * A_COLS, I_NORMG, (l * 5 + 0) * 2048, WS_WAIN + l * SZ_WAIN, A_COLS, 0, A_COLS, 2048, A_COLS, 0);
        for (int l = 0; l < 2; ++l) add(I_AWOUT, (size_t)l * 1536 * 2048, -1, 0, WS_WAOUT + l * SZ_WAOUT, 2048, 0, 2048, 1536, 2048, 0);
        for (int lb = 0; lb < 2; ++lb) {
            const size_t src = (size_t)lb * 2048 * B_COLS_SRC, dst = WS_WBIN + lb * SZ_WBIN; const int go = ((2 + lb) * 5 + 0) * 2048;
            add(I_BWIN, src, I_NORMG, go, dst, B_COLS_SRC, 0, 1536, 2048, 1536, 0);
            add(I_BWIN, src, I_NORMG, go, dst + (size_t)1536 * 2048 * 2, B_COLS_SRC, 1572, 512, 2048, 512, 0);
            add(I_BWIN, src, I_NORMG, go, dst + (size_t)2048 * 2048 * 2, B_COLS_SRC, 1536, 36, 2048, 256, 0);
        }
        for (int lb = 0; lb < 2; ++lb) add(I_BWOUT, (size_t)lb * 2048 * 2048, -1, 0, WS_WBOUT + lb * SZ_WBOUT, 2048, 0, 2048, 2048, 2048, 0);
        for (int l = 0; l < 4; ++l) add(I_MEMWKV, (size_t)l * 2048 * 1024, I_NORMG, (l * 5 + 4) * 2048, WS_WMEM + (size_t)l * 1024 * 2048 * 2, 1024, 0, 1024, 2048, 1024, 0);
        add(I_KVW, 0, I_KVNG, 0, WS_WKV, 3072, 0, 3072, 2048, 3072, 0);
        add(I_WK1, 0, -1, 0, WS_WC1, 512, 0, 512, 4096, 512, 0);
        add(I_WV1, 0, -1, 0, WS_WC1 + SZ_WC1, 512, 0, 512, 4096, 512, 0);
        add(I_WK2, 0, -1, 0, WS_WC2, 128, 0, 128, 512, 256, 0);
        add(I_WV2, 0, -1, 0, WS_WC2 + SZ_WC2, 128, 0, 128, 512, 256, 0);
        p.njobs = n;
    }
    void* args[] = {&p};
    hipError_t e = hipLaunchCooperativeKernel((const void*)mega_fwd, dim3(grid_blocks), dim3(NTHREADS), args, LDS_BYTES, stream);
    if (e != hipSuccess) fprintf(stderr, "cooperative launch failed: %s (grid %d)\n", hipGetErrorString(e), grid_blocks);
}
```

```cpp
#include <hip/hip_runtime.h>
#include <hip/hip_cooperative_groups.h>
#include <cstdio>
#include <cstring>
namespace cg = cooperative_groups;

#define LAS __attribute__((address_space(3)))
typedef unsigned short bf16_t;
typedef short bf16x8 __attribute__((ext_vector_type(8)));
typedef float f32x4 __attribute__((ext_vector_type(4)));
typedef float f32x2 __attribute__((ext_vector_type(2)));
typedef unsigned u32x4 __attribute__((ext_vector_type(4)));
typedef unsigned u32x2 __attribute__((ext_vector_type(2)));
typedef __bf16 bf16x2_t __attribute__((ext_vector_type(2)));

constexpr int D_MODEL = 2048, NTOK = 8192, SEQ = 2048, NBATCH = 4, DFF = 5632, HD = 128;
constexpr int A_COLS = 9728, B_COLS_SRC = 2084, B_COLS = 2304, NCMP = 127;
constexpr int NWAVES = 8, NTHREADS = 512;
constexpr int LDS_BYTES = 131072;

constexpr size_t SZ_WAIN = (size_t)A_COLS * 2048 * 2, SZ_WAOUT = (size_t)2048 * 1536 * 2, SZ_WBIN = (size_t)B_COLS * 2048 * 2, SZ_WBOUT = (size_t)2048 * 2048 * 2;
constexpr size_t SZ_WGU = (size_t)11264 * 2048 * 2, SZ_WDOWN = (size_t)2048 * 5632 * 2, SZ_WC1 = (size_t)512 * 4096 * 2, SZ_WC2 = (size_t)256 * 512 * 2;
constexpr size_t WS_WAIN = 0;
constexpr size_t WS_WAOUT = WS_WAIN + 2 * SZ_WAIN;
constexpr size_t WS_WBIN = WS_WAOUT + 2 * SZ_WAOUT;
constexpr size_t WS_WBOUT = WS_WBIN + 2 * SZ_WBIN;
constexpr size_t WS_WMEM = WS_WBOUT + 2 * SZ_WBOUT;
constexpr size_t WS_WGU = WS_WMEM + (size_t)4096 * 2048 * 2;
constexpr size_t WS_WDOWN = WS_WGU + 4 * SZ_WGU;
constexpr size_t WS_WKV = WS_WDOWN + 4 * SZ_WDOWN;
constexpr size_t WS_WC1 = WS_WKV + (size_t)3072 * 2048 * 2;
constexpr size_t WS_WC2 = WS_WC1 + 2 * SZ_WC1;
constexpr size_t WS_PROJ = WS_WC2 + 2 * SZ_WC2;
constexpr size_t WS_OBUF = WS_PROJ + (size_t)NTOK * A_COLS * 2;
constexpr size_t WS_XH = WS_OBUF + (size_t)NTOK * 2048 * 4;
constexpr size_t WS_CAT = WS_XH + (size_t)NTOK * 2048 * 2;
constexpr size_t WS_KVS = WS_CAT + (size_t)NTOK * 2048 * 2;
constexpr size_t WS_MEMKV = WS_KVS + (size_t)NTOK * 3072 * 2;
constexpr size_t WS_MEMHAT = WS_MEMKV + (size_t)1024 * 4096 * 2;
constexpr size_t WS_HID = WS_MEMHAT + (size_t)1024 * 2048 * 2;
constexpr size_t WS_KCV = WS_HID + (size_t)2 * 2048 * 512 * 2;
constexpr size_t WS_SEL = WS_KCV + (size_t)2 * 2048 * 256 * 2;
constexpr size_t WS_END = WS_SEL + (size_t)NTOK * 4 * 4;

#define LDS_WAIT() asm volatile("s_waitcnt lgkmcnt(0)" ::: "memory")
__device__ __forceinline__ unsigned f2bf(float f) { unsigned u = __builtin_bit_cast(unsigned, f); return (u + 0x7fffu + ((u >> 16) & 1u)) >> 16; }
__device__ __forceinline__ unsigned pk2(float lo, float hi) { const f32x2 v = {lo, hi}; return __builtin_bit_cast(unsigned, __builtin_convertvector(v, bf16x2_t)); }
__device__ __forceinline__ float bflo(unsigned w) { return __builtin_bit_cast(float, w << 16); }
__device__ __forceinline__ float bfhi(unsigned w) { return __builtin_bit_cast(float, w & 0xffff0000u); }
__device__ __forceinline__ float wave_sum(float v) {
#pragma unroll
    for (int o = 1; o < 64; o <<= 1) v += __shfl_xor(v, o);
    return v;
}
__device__ __forceinline__ float wave_max(float v) {
#pragma unroll
    for (int o = 1; o < 64; o <<= 1) v = fmaxf(v, __shfl_xor(v, o));
    return v;
}

namespace pg8 {
constexpr int BM = 256, BK = 64, HALF = 128, HTB = HALF * BK * 2, STAGE_BYTES = 8 * HTB, NXCD = 8, WGM = 8;
__device__ __forceinline__ int lds_byte(int r, int c) { const int st = (r >> 4) * 2 + (c >> 5), rr = r & 15, cc = c & 31, ob = rr * 64 + cc * 2; return st * 1024 + (ob ^ (((ob >> 9) & 1) << 5)); }
__device__ __forceinline__ void stage_rc(int b, int& R, int& C) { const int st = b / 1024, sb = b % 1024, swz = sb ^ (((sb >> 9) & 1) << 5); R = (st >> 1) * 16 + swz / 64; C = (st & 1) * 32 + (swz % 64) / 2; }
__device__ __forceinline__ int perm32(int rho) { const int n = rho >> 4, i = rho & 15; return 8 * (i >> 2) + 4 * n + (i & 3); }
struct Unit { int pm, pn; };
struct Gemm { const bf16_t* A; const bf16_t* Bt; int M, N, K; };
struct StaticOrder {
    int nM, nN, nwg, G, c;
    __device__ void init(int M, int N, int G_, int c_) { nM = M / BM; nN = N / BM; nwg = nM * nN; G = G_; c = c_; }
    __device__ bool next(int i, Unit& u) const {
        const long L = (long)i * G + c; if (L >= nwg) return false;
        int wgid = (int)L; { const int q = nwg / NXCD, r = nwg % NXCD, xcd = wgid % NXCD, off = wgid / NXCD; wgid = (xcd < r ? xcd * (q + 1) : r * (q + 1) + (xcd - r) * q) + off; }
        const int nig = WGM * nN, gid = wgid / nig, fm = gid * WGM, gsz = (nM - fm) < WGM ? (nM - fm) : WGM;
        u.pm = fm + ((wgid % nig) % gsz); u.pn = (wgid % nig) / gsz; return true;
    }
    __device__ __forceinline__ void a_ready(const Unit&) const {}
    __device__ __forceinline__ void done(const Unit&) const {}
};
__device__ __forceinline__ unsigned cvt_pk_bf16(float lo, float hi) { const f32x2 v = {lo, hi}; return __builtin_bit_cast(unsigned, __builtin_convertvector(v, bf16x2_t)); }

struct EpiF32 {
    static constexpr bool PERM = false;
    float* C; int ldc;
    __device__ __forceinline__ void operator()(const f32x4 (&acc)[2][2][4][2], const Unit& u, int wr, int wc, int fr, int fq) const {
        const int row0 = u.pm * BM + wr * 64 + fr, col0 = u.pn * BM + wc * 32 + 4 * fq;
#pragma unroll
        for (int ai = 0; ai < 2; ++ai)
#pragma unroll
            for (int m = 0; m < 4; ++m) { float* rowp = C + (size_t)(row0 + ai * HALF + m * 16) * ldc + col0;
#pragma unroll
                for (int bj = 0; bj < 2; ++bj)
#pragma unroll
                    for (int n = 0; n < 2; ++n) *(f32x4*)(rowp + bj * HALF + n * 16) = acc[ai][bj][m][n]; }
    }
};
__device__ __forceinline__ float gelu_tanh(float x) { const float t = 1.5957691216f * (x + 0.044715f * x * x * x); return x / (1.0f + __expf(-t)); }
template <int ACT  > struct EpiBf16 {
    static constexpr bool PERM = true;
    bf16_t* O; int ldc;
    __device__ __forceinline__ void operator()(const f32x4 (&acc)[2][2][4][2], const Unit& u, int wr, int wc, int fr, int fq) const {
        const int row0 = u.pm * BM + wr * 64 + fr, col0 = u.pn * BM + wc * 32 + 8 * fq;
#pragma unroll
        for (int ai = 0; ai < 2; ++ai)
#pragma unroll
            for (int m = 0; m < 4; ++m) { bf16_t* rowp = O + (size_t)(row0 + ai * HALF + m * 16) * ldc + col0;
#pragma unroll
                for (int bj = 0; bj < 2; ++bj) { f32x4 v0 = acc[ai][bj][m][0], v1 = acc[ai][bj][m][1];
                    if (ACT == 1) {
#pragma unroll
                        for (int j = 0; j < 4; ++j) { v0[j] = gelu_tanh(v0[j]); v1[j] = gelu_tanh(v1[j]); } }
                    u32x4 w; w.x = cvt_pk_bf16(v0[0], v0[1]); w.y = cvt_pk_bf16(v0[2], v0[3]); w.z = cvt_pk_bf16(v1[0], v1[1]); w.w = cvt_pk_bf16(v1[2], v1[3]);
                    *(u32x4*)(rowp + bj * HALF) = w; } }
    }
};
struct EpiSwiGLU {
    static constexpr bool PERM = true;
    bf16_t* O; int ldc;
    __device__ __forceinline__ void operator()(const f32x4 (&acc)[2][2][4][2], const Unit& u, int wr, int wc, int fr, int fq) const {
        const int row0 = u.pm * BM + wr * 64 + fr, col0 = u.pn * HALF + wc * 32 + 8 * fq;
#pragma unroll
        for (int ai = 0; ai < 2; ++ai)
#pragma unroll
            for (int m = 0; m < 4; ++m) { bf16_t* rowp = O + (size_t)(row0 + ai * HALF + m * 16) * ldc + col0;
                f32x4 v0, v1;
#pragma unroll
                for (int j = 0; j < 4; ++j) { const float g0 = acc[ai][0][m][0][j], g1 = acc[ai][0][m][1][j];
                    v0[j] = g0 / (1.0f + __expf(-g0)) * acc[ai][1][m][0][j]; v1[j] = g1 / (1.0f + __expf(-g1)) * acc[ai][1][m][1][j]; }
                u32x4 w; w.x = cvt_pk_bf16(v0[0], v0[1]); w.y = cvt_pk_bf16(v0[2], v0[3]); w.z = cvt_pk_bf16(v1[0], v1[1]); w.w = cvt_pk_bf16(v1[2], v1[3]);
                *(u32x4*)rowp = w; }
    }
};

template <class Epi, class Sched>
__device__ __forceinline__ void gemm_phase(LAS unsigned char* lds, const Gemm g, const Sched& S, const Epi& E) {
    int tid_ = threadIdx.x; asm volatile("" : "+v"(tid_));
    const int tid = tid_, wid = __builtin_amdgcn_readfirstlane(tid >> 6), lane = tid & 63, wr = wid >> 2, wc = wid & 3, fr = lane & 15, fq = lane >> 4;
    const int K = g.K, nt = K / BK;
    unsigned voffA[2], voffB[2];
#pragma unroll
    for (int i = 0; i < 2; ++i) { int R, C; stage_rc(tid * 16 + i * 8192, R, C); const int Rb = Epi::PERM ? ((R & ~31) + perm32(R & 31)) : R;
        voffA[i] = (unsigned)(R * K + C) * 2u; voffB[i] = (unsigned)(Rb * K + C) * 2u; }
    const size_t kstep = (size_t)(BK * 2);
    const size_t hstep = (size_t)HALF * K * 2;
    const size_t tstep = 2 * hstep;
    const unsigned ldsw = (unsigned)wid * 1024u;
    const int aoff = lds_byte(wr * 64 + fr, fq * 8), boff = lds_byte(wc * 32 + fr, fq * 8);
#define PG8_SA(b, h) (((b) * 2 + (h)) * HTB)
#define PG8_SB(b, h) ((4 + (b) * 2 + (h)) * HTB)
#define PG8_STAGE(bufoff, gbase, voff) do { _Pragma("unroll") for (int _i = 0; _i < 2; ++_i) \
        __builtin_amdgcn_global_load_lds((const unsigned*)((const char*)(gbase) + (voff)[_i]), (LAS unsigned*)(lds + (bufoff) + ldsw + _i * 8192), 16, 0, 0); } while (0)
#define PG8_LDA(dst, b, h) do { _Pragma("unroll") for (int m = 0; m < 4; ++m) _Pragma("unroll") for (int k = 0; k < 2; ++k) dst[m][k] = *(const LAS bf16x8*)(lds + PG8_SA(b, h) + aoff + m * 2048 + k * 1024); } while (0)
#define PG8_LDB(dst, b, h) do { _Pragma("unroll") for (int n = 0; n < 2; ++n) _Pragma("unroll") for (int k = 0; k < 2; ++k) dst[n][k] = *(const LAS bf16x8*)(lds + PG8_SB(b, h) + boff + n * 2048 + k * 1024); } while (0)
#define PG8_MMA(ai, bj, At, Bt) do { __builtin_amdgcn_s_setprio(1); _Pragma("unroll") for (int m = 0; m < 4; ++m) _Pragma("unroll") for (int n = 0; n < 2; ++n) _Pragma("unroll") for (int k = 0; k < 2; ++k) \
        acc[ai][bj][m][n] = __builtin_amdgcn_mfma_f32_16x16x32_bf16(Bt[n][k], At[m][k], acc[ai][bj][m][n], 0, 0, 0); __builtin_amdgcn_s_setprio(0); } while (0)
#define PG8_WAIT_V(n) asm volatile("s_waitcnt vmcnt(" #n ")" ::: "memory")
#define PG8_WAIT_L(n) asm volatile("s_waitcnt lgkmcnt(" #n ")" ::: "memory")
#define PG8_BAR __builtin_amdgcn_s_barrier()
#define PG8_SCHED __builtin_amdgcn_sched_barrier(0)
    Unit cur, nxt; int ui = 0;
    if (!S.next(0, cur)) return;
    f32x4 acc[2][2][4][2];
#pragma unroll
    for (int a = 0; a < 2; ++a)
#pragma unroll
        for (int b = 0; b < 2; ++b)
#pragma unroll
            for (int m = 0; m < 4; ++m)
#pragma unroll
                for (int n = 0; n < 2; ++n) acc[a][b][m][n] = (f32x4){0.f, 0.f, 0.f, 0.f};
    bf16x8 At[4][2], B0[2][2], B1[2][2];
    const char* cA = (const char*)g.A + (size_t)cur.pm * tstep; const char* cB = (const char*)g.Bt + (size_t)cur.pn * tstep;
    S.a_ready(cur);
    PG8_STAGE(PG8_SB(0, 0), cB, voffB); PG8_STAGE(PG8_SA(0, 0), cA, voffA); PG8_STAGE(PG8_SB(0, 1), cB + hstep, voffB); PG8_STAGE(PG8_SA(0, 1), cA + hstep, voffA);
    if (wr == 1) PG8_BAR;
    PG8_WAIT_V(4); PG8_BAR;
    PG8_STAGE(PG8_SB(1, 0), cB + kstep, voffB); PG8_STAGE(PG8_SA(1, 0), cA + kstep, voffA); PG8_STAGE(PG8_SB(1, 1), cB + hstep + kstep, voffB);
    PG8_WAIT_V(6); PG8_BAR;
    for (;;) {
        const bool has_next = S.next(ui + 1, nxt);
        const char* nA = has_next ? (const char*)g.A + (size_t)nxt.pm * tstep : cA; const char* nB = has_next ? (const char*)g.Bt + (size_t)nxt.pn * tstep : cB;
        for (int t = 0; t < nt; t += 2) {
            const bool last = (t == nt - 2);
            const char* a1 = cA + (size_t)(t + 1) * kstep;
            const char* a2 = last ? nA : cA + (size_t)(t + 2) * kstep; const char* b2 = last ? nB : cB + (size_t)(t + 2) * kstep;
            const char* a3 = a2 + kstep; const char* b3 = b2 + kstep;
            if (last && has_next) S.a_ready(nxt);
            PG8_LDB(B0, 0, 0); PG8_SCHED; PG8_LDA(At, 0, 0); PG8_STAGE(PG8_SA(1, 1), a1 + hstep, voffA);
            PG8_WAIT_L(8); PG8_BAR; PG8_WAIT_L(0); PG8_MMA(0, 0, At, B0); PG8_BAR; PG8_SCHED;
            PG8_LDB(B1, 0, 1); PG8_STAGE(PG8_SB(0, 0), b2, voffB);
            PG8_BAR; PG8_WAIT_L(0); PG8_MMA(0, 1, At, B1); PG8_BAR;
            PG8_LDA(At, 0, 1); PG8_STAGE(PG8_SA(0, 0), a2, voffA);
            PG8_BAR; PG8_WAIT_L(0); PG8_MMA(1, 0, At, B0); PG8_BAR; PG8_SCHED;
            PG8_STAGE(PG8_SB(0, 1), b2 + hstep, voffB);
            PG8_WAIT_V(6); PG8_BAR; PG8_MMA(1, 1, At, B1); PG8_BAR;
            PG8_LDB(B0, 1, 0); PG8_SCHED; PG8_LDA(At, 1, 0); PG8_STAGE(PG8_SA(0, 1), a2 + hstep, voffA);
            PG8_WAIT_L(8); PG8_BAR; PG8_WAIT_L(0); PG8_MMA(0, 0, At, B0); PG8_BAR; PG8_SCHED;
            PG8_LDB(B1, 1, 1); PG8_STAGE(PG8_SB(1, 0), b3, voffB);
            PG8_BAR; PG8_WAIT_L(0); PG8_MMA(0, 1, At, B1); PG8_BAR;
            PG8_LDA(At, 1, 1); PG8_STAGE(PG8_SA(1, 0), a3, voffA);
            PG8_BAR; PG8_WAIT_L(0); PG8_MMA(1, 0, At, B0); PG8_BAR; PG8_SCHED;
            PG8_STAGE(PG8_SB(1, 1), b3 + hstep, voffB);
            PG8_WAIT_V(6); PG8_BAR; PG8_MMA(1, 1, At, B1); PG8_BAR;
        }
        E(acc, cur, wr, wc, fr, fq); S.done(cur);
        if (!has_next) break;
#pragma unroll
        for (int a = 0; a < 2; ++a)
#pragma unroll
            for (int b = 0; b < 2; ++b)
#pragma unroll
                for (int m = 0; m < 4; ++m)
#pragma unroll
                    for (int n = 0; n < 2; ++n) acc[a][b][m][n] = (f32x4){0.f, 0.f, 0.f, 0.f};
        cur = nxt; cA = nA; cB = nB; ++ui;
    }
    PG8_WAIT_V(0);
    if (wr == 0) PG8_BAR;
    PG8_BAR;
#undef PG8_SA
#undef PG8_SB
#undef PG8_STAGE
#undef PG8_LDA
#undef PG8_LDB
#undef PG8_MMA
#undef PG8_WAIT_V
#undef PG8_WAIT_L
#undef PG8_BAR
#undef PG8_SCHED
}
}

struct JobDesc { unsigned long long in_off, dst_off; int in_idx, gain_idx, gain_off, ldw, col0, ncols, K, nrows, mode, pad; };
constexpr int MAXJOBS = 32;
struct Params { const float* in[17]; float* out; unsigned char* ws; JobDesc jobs[MAXJOBS]; int njobs, pad; };
enum { I_X = 0, I_MEM, I_NORMG, I_AWIN, I_AWOUT, I_BWIN, I_BWOUT, I_MEMWKV, I_WGU, I_WDOWN, I_KVNG, I_KVW, I_PE, I_WK1, I_WK2, I_WV1, I_WV2 };

struct ConvJob { const float* W; const float* gain; bf16_t* dst; int ldw, col0, ncols, K, nrows, mode; };
__device__ __forceinline__ bool conv_get(const Params& p, int j, ConvJob& J) {
    if (j >= p.njobs) return false;
    const JobDesc& d = p.jobs[j];
    J.W = p.in[d.in_idx] + d.in_off; J.gain = d.gain_idx >= 0 ? p.in[d.gain_idx] + d.gain_off : nullptr; J.dst = (bf16_t*)(p.ws + d.dst_off);
    J.ldw = d.ldw; J.col0 = d.col0; J.ncols = d.ncols; J.K = d.K; J.nrows = d.nrows; J.mode = d.mode;
    return true;
}
__device__ __forceinline__ void conv_run(const ConvJob& J, LAS float* scr, int gw, int ngw, int lane) {
    const int nblk = J.nrows / 32, kblk = J.K / 64, items = nblk * kblk;
    for (int it = gw; it < items; it += ngw) {
        const int kb = it / nblk, nb = it % nblk, k0 = 64 * kb, n0 = 32 * nb;
        const int n = n0 + (lane & 31);
        const bool ok = n < J.ncols;
        const int sc = J.mode == 1 ? (((n >> 7) & 1) * 5632 + (n >> 8) * 128 + (n & 127)) : (J.col0 + n);
#pragma unroll 8
        for (int i = 0; i < 32; ++i) { const int kk = 2 * i + (lane >> 5);
            float v = 0.f; if (ok) { v = J.W[(size_t)(k0 + kk) * J.ldw + sc]; if (J.gain) v *= J.gain[k0 + kk]; }
            scr[kk * 33 + (lane & 31)] = v; }
        LDS_WAIT();
        const int c = lane & 7;
#pragma unroll
        for (int j = 0; j < 4; ++j) { const int nn = (lane >> 3) + 8 * j; const LAS float* s = scr + (8 * c) * 33 + nn;
            u32x4 o; o.x = pk2(s[0 * 33], s[1 * 33]); o.y = pk2(s[2 * 33], s[3 * 33]); o.z = pk2(s[4 * 33], s[5 * 33]); o.w = pk2(s[6 * 33], s[7 * 33]);
            *(u32x4*)(J.dst + (size_t)(n0 + nn) * J.K + k0 + 8 * c) = o; }
        LDS_WAIT();
    }
}

__device__ __forceinline__ void rms_row(const float* xrow, bf16_t* orow, float* copy, int lane) {
    const f32x4* xr = (const f32x4*)xrow + lane;
    f32x4 v[8]; float s = 0.f;
#pragma unroll
    for (int j = 0; j < 8; ++j) { v[j] = xr[64 * j]; s += (v[j].x * v[j].x + v[j].y * v[j].y) + (v[j].z * v[j].z + v[j].w * v[j].w); }
    const float rs = rsqrtf(wave_sum(s) * (1.f / 2048.f) + 1e-6f);
    u32x2* o8 = (u32x2*)orow + lane;
#pragma unroll
    for (int j = 0; j < 8; ++j) { u32x2 w; w.x = pk2(v[j].x * rs, v[j].y * rs); w.y = pk2(v[j].z * rs, v[j].w * rs); o8[64 * j] = w; }
    if (copy) { f32x4* c4 = (f32x4*)copy + lane;
#pragma unroll
        for (int j = 0; j < 8; ++j) c4[64 * j] = v[j]; }
}
__device__ __forceinline__ void rowop_row(float* xrow, const float* orow, const float* gain, bf16_t* hrow, int lane) {
    const f32x4* o4 = (const f32x4*)orow + lane; f32x4* x4 = (f32x4*)xrow + lane; const f32x4* g4 = (const f32x4*)gain + lane;
    f32x4 o[8]; float s = 0.f;
#pragma unroll
    for (int j = 0; j < 8; ++j) { o[j] = o4[64 * j]; s += (o[j].x * o[j].x + o[j].y * o[j].y) + (o[j].z * o[j].z + o[j].w * o[j].w); }
    const float rs = rsqrtf(wave_sum(s) * (1.f / 2048.f) + 1e-6f);
    float s2 = 0.f;
#pragma unroll
    for (int j = 0; j < 8; ++j) { const f32x4 g = g4[64 * j]; f32x4 x = x4[64 * j]; x = x + o[j] * rs * g; x4[64 * j] = x; o[j] = x; s2 += (x.x * x.x + x.y * x.y) + (x.z * x.z + x.w * x.w); }
    const float rs2 = rsqrtf(wave_sum(s2) * (1.f / 2048.f) + 1e-6f);
    u32x2* o8 = (u32x2*)hrow + lane;
#pragma unroll
    for (int j = 0; j < 8; ++j) { u32x2 w; w.x = pk2(o[j].x * rs2, o[j].y * rs2); w.y = pk2(o[j].z * rs2, o[j].w * rs2); o8[64 * j] = w; }
}

__device__ __forceinline__ float dot128(const bf16_t* kp, const LAS float* qs) {
    const u32x4* k4 = (const u32x4*)kp; float s = 0.f;
#pragma unroll 4
    for (int c = 0; c < 16; ++c) { const u32x4 w = k4[c]; const f32x4 a = *(const LAS f32x4*)(qs + 8 * c), b = *(const LAS f32x4*)(qs + 8 * c + 4);
        s += bflo(w.x) * a.x + bfhi(w.x) * a.y + bflo(w.y) * a.z + bfhi(w.y) * a.w + bflo(w.z) * b.x + bfhi(w.z) * b.y + bflo(w.w) * b.z + bfhi(w.w) * b.w; }
    return s;
}
__device__ __forceinline__ void load_q(const bf16_t* q, LAS float* qs, int lane) {
    const unsigned w = *(const unsigned*)(q + 2 * lane);
    LDS_WAIT();
    qs[2 * lane] = bflo(w) * 0.08838834764831845f; qs[2 * lane + 1] = bfhi(w) * 0.08838834764831845f;
    LDS_WAIT();
}
template <class KF>
__device__ __forceinline__ void attn_wave(const KF& kf, int nkeys, const LAS float* qs, LAS float* sc, int lane, float& o0, float& o1, float& mOut, float& denOut) {
    float m = -INFINITY;
    for (int base = 0; base < nkeys; base += 64) {
        const int i = base + lane; float s = -INFINITY;
        if (i < nkeys) { const bf16_t* kp; const bf16_t* vp; float bias; if (kf(i, kp, vp, bias)) s = dot128(kp, qs) + bias; sc[i] = s; }
        m = fmaxf(m, s);
    }
    m = wave_max(m); if (m == -INFINITY) m = 0.f;
    LDS_WAIT();
    float sum = 0.f;
    for (int i = lane; i < nkeys; i += 64) { const float s = sc[i]; const float e = (s == -INFINITY) ? 0.f : __expf(s - m); sc[i] = e; sum += e; }
    sum = wave_sum(sum); const float den = fmaxf(sum, 1e-30f);
    LDS_WAIT();
    float a0 = 0.f, a1 = 0.f;
#pragma unroll 4
    for (int i = 0; i < nkeys; ++i) { const float pr = sc[i]; const bf16_t* kp; const bf16_t* vp; float bias; kf(i, kp, vp, bias);
        const unsigned w = *(const unsigned*)(vp + 2 * lane); a0 += pr * bflo(w); a1 += pr * bfhi(w); }
    o0 = a0 / den; o1 = a1 / den; mOut = m; denOut = den;
}

__device__ __forceinline__ void mem_attn_item(const bf16_t* proj, int ldp, int mqoff, const bf16_t* memkv, int l, bf16_t* cat, int ldc, int memoff, int t, int h, LAS float* qs, LAS float* sc, int lane_) {
    int lane = lane_; asm volatile("" : "+v"(lane));
    const int b = t >> 11;
    load_q(proj + (size_t)t * ldp + mqoff + h * HD, qs, lane);
    const bf16_t* kb = memkv + (size_t)(b * 256) * 4096 + l * 1024 + h * HD;
    auto kf = [&](int i, const bf16_t*& kp, const bf16_t*& vp, float& bias) { kp = kb + (size_t)i * 4096; vp = kp + 512; bias = 0.f; return true; };
    float o0, o1, m, den; attn_wave(kf, 256, qs, sc, lane, o0, o1, m, den);
    *(unsigned*)(cat + (size_t)t * ldc + memoff + h * HD + 2 * lane) = pk2(o0, o1);
}
__device__ __forceinline__ void atta_item(const bf16_t* proj, bf16_t* cat, int t, int j, LAS float* qs, LAS float* sc, int lane_) {
    int lane = lane_; asm volatile("" : "+v"(lane));
    const int b = t >> 11, s = t & 2047;
    float og0[3], og1[3], lse[3];
#pragma unroll
    for (int gi = 0; gi < 3; ++gi) {
        const int d = gi == 0 ? 1 : (gi == 1 ? 4 : 16), hh = gi * 8 + j;
        const float slope = exp2f(-8.0f * (float)(hh + 1) / 24.0f);
        load_q(proj + (size_t)t * A_COLS + hh * HD, qs, lane);
        const bf16_t* kbase = proj + (size_t)(b * SEQ) * A_COLS + 3072 + hh * HD;
        auto kf = [&](int i, const bf16_t*& kp, const bf16_t*& vp, float& bias) { const int sp = s - i * d; const int spc = sp < 0 ? 0 : sp;
            kp = kbase + (size_t)spc * A_COLS; vp = kp + 3072; bias = -slope * (float)(i * d); return sp >= 0; };
        float m, den; attn_wave(kf, 129, qs, sc, lane, og0[gi], og1[gi], m, den);
        lse[gi] = m + __logf(den);
    }
    const float mx = fmaxf(lse[0], fmaxf(lse[1], lse[2]));
    const float e0 = __expf(lse[0] - mx), e1 = __expf(lse[1] - mx), e2 = __expf(lse[2] - mx), inv = 1.0f / (e0 + e1 + e2);
    const float r0 = (e0 * og0[0] + e1 * og0[1] + e2 * og0[2]) * inv, r1 = (e0 * og1[0] + e1 * og1[1] + e2 * og1[2]) * inv;
    *(unsigned*)(cat + (size_t)t * 1536 + j * HD + 2 * lane) = pk2(r0, r1);
}
__device__ __forceinline__ void attb_item(const bf16_t* proj, const bf16_t* kvs, const bf16_t* kc, const bf16_t* vc, bf16_t* cat, int t, int g, LAS float* qs, LAS float* sc, LAS float* pc, LAS int* blk, int lane_) {
    int lane = lane_; asm volatile("" : "+v"(lane));
    const int b = t >> 11, s = t & 2047, cur = s >> 6;
    float oc0[3], oc1[3];
#pragma unroll
    for (int r = 0; r < 3; ++r) {
        const int h = 3 * g + r; const float slope = exp2f(-8.0f * (float)(h + 1) / 12.0f);
        load_q(proj + (size_t)t * B_COLS + h * HD, qs, lane);
        auto kf = [&](int n, const bf16_t*& kp, const bf16_t*& vp, float& bias) { const int cend = 16 * n + 31; const size_t row = (size_t)((b * NCMP + n) * 4 + g);
            kp = kc + row * 256; vp = vc + row * 256; bias = -slope * (float)(s - cend); return s >= cend; };
        float m, den; attn_wave(kf, NCMP, qs, pc + r * 128, lane, oc0[r], oc1[r], m, den);
        const float inv = 1.0f / den;
        for (int i = lane; i < 128; i += 64) pc[r * 128 + i] = (i < NCMP) ? pc[r * 128 + i] * inv : 0.f;
        LDS_WAIT();
    }
    const int jb = lane & 31;
    float imp = 0.f;
#pragma unroll
    for (int r = 0; r < 3; ++r) { const LAS float* P = pc + r * 128; const int n0 = 4 * jb;
        imp += (n0 >= 1 ? 0.5f * P[n0 - 1] : 0.f) + P[n0] + P[n0 + 1] + P[n0 + 2] + 0.5f * P[n0 + 3]; }
    const bool forced = (jb == 0) || (jb == cur) || (jb == cur - 1);
    imp = forced ? 1e4f : (jb > cur ? -1e4f : imp);
    int rank = 0;
    for (int o = 0; o < 32; ++o) { const float v = __shfl(imp, o); rank += (v > imp || (v == imp && o < jb)) ? 1 : 0; }
    const bool sel = (rank < 16) && (jb <= cur);
    const unsigned mask = (unsigned)(__ballot(sel && lane < 32) & 0xffffffffull);
    const int nsel = __popc(mask);
    if (lane < 16) { int cnt = 0, bsel = 0; for (int jj = 0; jj < 32; ++jj) { if ((mask >> jj) & 1u) { if (cnt == lane) bsel = jj; ++cnt; } } blk[lane] = bsel; }
    LDS_WAIT();
#pragma unroll
    for (int r = 0; r < 3; ++r) {
        const int h = 3 * g + r; const float slope = exp2f(-8.0f * (float)(h + 1) / 12.0f);
        load_q(proj + (size_t)t * B_COLS + h * HD, qs, lane);
        const bf16_t* kvb = kvs + (size_t)(b * SEQ) * 3072 + g * HD;
        auto kfs = [&](int i, const bf16_t*& kp, const bf16_t*& vp, float& bias) { const int sp = 64 * blk[i >> 6] + (i & 63);
            kp = kvb + (size_t)sp * 3072 + 2 * 512; vp = kp + 512; bias = -slope * (float)(s - sp); return sp <= s; };
        float os0, os1, m, den; attn_wave(kfs, nsel * 64, qs, sc, lane, os0, os1, m, den);
        auto kfw = [&](int i, const bf16_t*& kp, const bf16_t*& vp, float& bias) { const int sp = s - i; const int spc = sp < 0 ? 0 : sp;
            kp = kvb + (size_t)spc * 3072 + 4 * 512; vp = kp + 512; bias = -slope * (float)i; return sp >= 0; };
        float ow0, ow1; attn_wave(kfw, 512, qs, sc, lane, ow0, ow1, m, den);
        const bf16_t* gp = proj + (size_t)t * B_COLS + 2048 + h * 3;
        const float g0 = 1.0f / (1.0f + __expf(-bflo((unsigned)gp[0]))), g1 = 1.0f / (1.0f + __expf(-bflo((unsigned)gp[1]))), g2 = 1.0f / (1.0f + __expf(-bflo((unsigned)gp[2])));
        const float r0 = g0 * oc0[r] + g1 * os0 + g2 * ow0, r1 = g0 * oc1[r] + g1 * os1 + g2 * ow1;
        *(unsigned*)(cat + (size_t)t * 2048 + h * HD + 2 * lane) = pk2(r0, r1);
    }
}


typedef short s16x4 __attribute__((ext_vector_type(4)));
constexpr int AT_ROWB = 272, AT_TILEB = 64 * AT_ROWB, AT_STAGEB = 2 * AT_TILEB;
constexpr int AT_AUX = 2 * AT_STAGEB;
constexpr float SCALE2 = 0.12751743f;
constexpr float LOG2E = 1.4426950408889634f, LN2 = 0.6931471805599453f;
struct AttnArgs {
    const bf16_t* q; size_t qstride;
    const bf16_t* k; const bf16_t* v; size_t kvstride;
    unsigned tilemask;
    int nkeys, qpos0, kmul, maxdist;
    float slope2;
};
__device__ __forceinline__ void at_gload(const AttnArgs& A, int kt, int tid, u32x4 (&kr)[2], u32x4 (&vr)[2]) {
#pragma unroll
    for (int i = 0; i < 2; ++i) { const int id = tid + 512 * i, row = id >> 4, c16 = id & 15; const size_t off = (size_t)(64 * kt + row) * A.kvstride + 8 * c16;
        kr[i] = *(const u32x4*)(A.k + off); vr[i] = *(const u32x4*)(A.v + off); }
}
__device__ __forceinline__ void at_lstore(LAS unsigned char* st, int tid, const u32x4 (&kr)[2], const u32x4 (&vr)[2]) {
#pragma unroll
    for (int i = 0; i < 2; ++i) { const int id = tid + 512 * i, row = id >> 4, c16 = id & 15;
        *(LAS u32x4*)(st + row * AT_ROWB + c16 * 16) = kr[i]; *(LAS u32x4*)(st + AT_TILEB + row * AT_ROWB + c16 * 16) = vr[i]; }
}
__device__ __forceinline__ bf16x8 pack8(const f32x4& a, const f32x4& b) {
    u32x4 w; w.x = pg8::cvt_pk_bf16(a[0], a[1]); w.y = pg8::cvt_pk_bf16(a[2], a[3]); w.z = pg8::cvt_pk_bf16(b[0], b[1]); w.w = pg8::cvt_pk_bf16(b[2], b[3]);
    return __builtin_bit_cast(bf16x8, w);
}
__device__ __forceinline__ bf16x8 tr_pair(const LAS unsigned char* p0, const LAS unsigned char* p1) {
    const s16x4 lo = __builtin_amdgcn_ds_read_tr16_b64_v4i16((LAS s16x4*)p0), hi = __builtin_amdgcn_ds_read_tr16_b64_v4i16((LAS s16x4*)p1);
    return __builtin_shufflevector(lo, hi, 0, 1, 2, 3, 4, 5, 6, 7);
}
template <bool USE_SEL>
__device__ __forceinline__ void attn_core(LAS unsigned char* lds, const AttnArgs& A, unsigned selmask, int tid, f32x4 (&o)[8], float& m, float& l) {
    const int lane = tid & 63, wave = tid >> 6, fr = lane & 15, fq = lane >> 4, row = wave * 16 + fr, qpos = A.qpos0 + row;
    bf16x8 qf[4];
    { const bf16_t* qp = A.q + (size_t)row * A.qstride + 8 * fq;
#pragma unroll
      for (int dc = 0; dc < 4; ++dc) qf[dc] = *(const bf16x8*)(qp + 32 * dc); }
    m = -INFINITY; l = 0.f;
#pragma unroll
    for (int db = 0; db < 8; ++db) o[db] = (f32x4){0.f, 0.f, 0.f, 0.f};
    unsigned tm = A.tilemask;
    if (tm == 0u) return;
    u32x4 kr[2], vr[2];
    int kt = __builtin_ctz(tm); tm &= tm - 1;
    at_gload(A, kt, tid, kr, vr); at_lstore(lds, tid, kr, vr); __syncthreads();
    int cur = 0;
    for (;;) {
        const bool has_next = tm != 0u; int ktn = 0;
        if (has_next) { ktn = __builtin_ctz(tm); tm &= tm - 1; at_gload(A, ktn, tid, kr, vr); }
        const LAS unsigned char* st = lds + cur * AT_STAGEB;
        f32x4 s[4];
        { const LAS unsigned char* kbase = st + fr * AT_ROWB + fq * 16;
#pragma unroll
          for (int kb = 0; kb < 4; ++kb) { s[kb] = (f32x4){0.f, 0.f, 0.f, 0.f};
#pragma unroll
              for (int dc = 0; dc < 4; ++dc) { const bf16x8 kf = *(const LAS bf16x8*)(kbase + kb * 16 * AT_ROWB + dc * 64); s[kb] = __builtin_amdgcn_mfma_f32_16x16x32_bf16(kf, qf[dc], s[kb], 0, 0, 0); } } }
        float tmax = -INFINITY;
        const bool tsel = USE_SEL ? (((selmask >> kt) & 1u) != 0u) : true;
#pragma unroll
        for (int kb = 0; kb < 4; ++kb)
#pragma unroll
            for (int e = 0; e < 4; ++e) { const int kidx = 64 * kt + 16 * kb + 4 * fq + e, dist = qpos - A.kmul * kidx;
                const bool valid = tsel && (dist >= 0) && (dist <= A.maxdist) && (kidx < A.nkeys);
                const float x = valid ? (s[kb][e] * SCALE2 - A.slope2 * (float)dist) : -INFINITY; s[kb][e] = x; tmax = fmaxf(tmax, x); }
        tmax = fmaxf(tmax, __shfl_xor(tmax, 16)); tmax = fmaxf(tmax, __shfl_xor(tmax, 32));
        const float mnew = fmaxf(m, tmax), muse = (mnew == -INFINITY) ? 0.f : mnew, alpha = __builtin_amdgcn_exp2f(m - muse);
        m = mnew; l *= alpha;
#pragma unroll
        for (int db = 0; db < 8; ++db) o[db] *= alpha;
#pragma unroll
        for (int kb = 0; kb < 4; ++kb)
#pragma unroll
            for (int e = 0; e < 4; ++e) { const float pv = __builtin_amdgcn_exp2f(s[kb][e] - muse); s[kb][e] = pv; l += pv; }
        { const LAS unsigned char* vbase = st + AT_TILEB + (4 * fq + (fr >> 2)) * AT_ROWB + 8 * (fr & 3);
#pragma unroll
          for (int c = 0; c < 2; ++c) { const bf16x8 pf = pack8(s[2 * c], s[2 * c + 1]);
#pragma unroll
              for (int db = 0; db < 8; ++db) { const bf16x8 vf = tr_pair(vbase + c * 32 * AT_ROWB + db * 32, vbase + c * 32 * AT_ROWB + 16 * AT_ROWB + db * 32);
                  o[db] = __builtin_amdgcn_mfma_f32_16x16x32_bf16(vf, pf, o[db], 0, 0, 0); } } }
        if (has_next) at_lstore(lds + (cur ^ 1) * AT_STAGEB, tid, kr, vr);
        __syncthreads();
        if (!has_next) break;
        kt = ktn; cur ^= 1;
    }
    l += __shfl_xor(l, 16); l += __shfl_xor(l, 32);
}
__device__ __forceinline__ void at_store_o(bf16_t* orow, const f32x4 (&o)[8], float inv, int fq) {
#pragma unroll
    for (int db = 0; db < 8; ++db) { u32x2 w; w.x = pg8::cvt_pk_bf16(o[db][0] * inv, o[db][1] * inv); w.y = pg8::cvt_pk_bf16(o[db][2] * inv, o[db][3] * inv); *(u32x2*)(orow + 16 * db + 4 * fq) = w; }
}
__device__ __forceinline__ void mem_attn_wg(LAS unsigned char* lds, const bf16_t* proj, int ldp, int mqoff, const bf16_t* memkv, int l, bf16_t* cat, int ldc, int memoff, int b, int h, int qb, int tid_) {
    int tid = tid_; asm volatile("" : "+v"(tid));
    const int t0 = b * SEQ + qb * 128;
    AttnArgs A; A.q = proj + (size_t)t0 * ldp + mqoff + h * HD; A.qstride = ldp; A.k = memkv + (size_t)(b * 256) * 4096 + l * 1024 + h * HD; A.v = A.k + 512; A.kvstride = 4096;
    A.tilemask = 0xFu; A.nkeys = 256; A.qpos0 = 1 << 20; A.kmul = 0; A.maxdist = 0x7fffffff; A.slope2 = 0.f;
    f32x4 o[8]; float m, lsum; attn_core<false>(lds, A, 0u, tid, o, m, lsum);
    const int lane = tid & 63, row = (tid >> 6) * 16 + (lane & 15);
    at_store_o(cat + (size_t)(t0 + row) * ldc + memoff + h * HD, o, 1.0f / fmaxf(lsum, 1e-30f), lane >> 4);
}
__device__ __forceinline__ void dil_attn_wg(LAS unsigned char* lds, const bf16_t* proj, bf16_t* og, float* lse, int b, int hh, int x, int tid_) {
    int tid = tid_; asm volatile("" : "+v"(tid));
    const int gi = hh >> 3, j = hh & 7, d = gi == 0 ? 1 : (gi == 1 ? 4 : 16), nqb = 16 / d, r = x / nqb, qb = x % nqb, c0 = qb * 128, L = SEQ / d;
    const float slope = exp2f(-8.0f * (float)(hh + 1) / 24.0f);
    AttnArgs A; A.q = proj + (size_t)(b * SEQ + c0 * d + r) * A_COLS + hh * HD; A.qstride = (size_t)d * A_COLS;
    A.k = proj + (size_t)(b * SEQ + r) * A_COLS + 3072 + hh * HD; A.v = A.k + 3072; A.kvstride = (size_t)d * A_COLS;
    const int ktc = c0 >> 6; A.tilemask = (ktc >= 2 ? (0xFu << (ktc - 2)) : 0x3u); A.nkeys = L; A.qpos0 = c0; A.kmul = 1; A.maxdist = 128; A.slope2 = slope * (float)d * LOG2E;
    f32x4 o[8]; float m, lsum; attn_core<false>(lds, A, 0u, tid, o, m, lsum);
    const int lane = tid & 63, fr = lane & 15, fq = lane >> 4, row = (tid >> 6) * 16 + fr;
    const size_t t = (size_t)b * SEQ + (size_t)(c0 + row) * d + r;
    at_store_o(og + ((size_t)gi * NTOK + t) * 1024 + j * HD, o, 1.0f / fmaxf(lsum, 1e-30f), fq);
    if (fq == 0) lse[((size_t)gi * NTOK + t) * 8 + j] = m * LN2 + __logf(fmaxf(lsum, 1e-30f));
}
__device__ __forceinline__ void cmp_sel_wg(LAS unsigned char* lds, const bf16_t* proj, const bf16_t* kc, const bf16_t* vc, bf16_t* cat, unsigned* sel, int b, int g, int qb, int tid_) {
    int tid = tid_; asm volatile("" : "+v"(tid));
    const int lane = tid & 63, wave = tid >> 6, fr = lane & 15, fq = lane >> 4, row = wave * 16 + fr, t0 = b * SEQ + qb * 128, spos_ = qb * 128 + row, cur = spos_ >> 6;
#pragma unroll
    for (int i = 0; i < 4; ++i) { const int id = tid + 512 * i, n = id >> 4, c16 = id & 15; const size_t off = ((size_t)(b * NCMP + n) * 4 + g) * 256 + 8 * c16;
        *(LAS u32x4*)(lds + n * AT_ROWB + c16 * 16) = *(const u32x4*)(kc + off); *(LAS u32x4*)(lds + 2 * AT_TILEB + n * AT_ROWB + c16 * 16) = *(const u32x4*)(vc + off); }
    __syncthreads();
    float imp[8];
#pragma unroll
    for (int kb = 0; kb < 8; ++kb) imp[kb] = 0.f;
    for (int r = 0; r < 3; ++r) {
        const int h = 3 * g + r; const float slope2 = exp2f(-8.0f * (float)(h + 1) / 12.0f) * LOG2E;
        int z = 0; asm volatile("" : "+v"(z));
        const int spos = spos_ + z;
        bf16x8 qf[4];
        { const bf16_t* qp = proj + (size_t)(t0 + row) * B_COLS + h * HD + 8 * fq;
#pragma unroll
          for (int dc = 0; dc < 4; ++dc) qf[dc] = *(const bf16x8*)(qp + 32 * dc); }
        f32x4 s[8];
        { const LAS unsigned char* kbase = lds + fr * AT_ROWB + fq * 16 + z;
#pragma unroll
          for (int kb = 0; kb < 8; ++kb) { s[kb] = (f32x4){0.f, 0.f, 0.f, 0.f};
#pragma unroll
              for (int dc = 0; dc < 4; ++dc) { const bf16x8 kf = *(const LAS bf16x8*)(kbase + kb * 16 * AT_ROWB + dc * 64); s[kb] = __builtin_amdgcn_mfma_f32_16x16x32_bf16(kf, qf[dc], s[kb], 0, 0, 0); } } }
        float tmax = -INFINITY;
#pragma unroll
        for (int kb = 0; kb < 8; ++kb)
#pragma unroll
            for (int e = 0; e < 4; ++e) { const int n = 16 * kb + 4 * fq + e, dist = spos - (16 * n + 31); const bool valid = (dist >= 0) && (n < NCMP);
                const float x = valid ? (s[kb][e] * SCALE2 - slope2 * (float)dist) : -INFINITY; s[kb][e] = x; tmax = fmaxf(tmax, x); }
        tmax = fmaxf(tmax, __shfl_xor(tmax, 16)); tmax = fmaxf(tmax, __shfl_xor(tmax, 32));
        const float muse = (tmax == -INFINITY) ? 0.f : tmax;
        float lsum = 0.f;
#pragma unroll
        for (int kb = 0; kb < 8; ++kb)
#pragma unroll
            for (int e = 0; e < 4; ++e) { const float pv = __builtin_amdgcn_exp2f(s[kb][e] - muse); s[kb][e] = pv; lsum += pv; }
        lsum += __shfl_xor(lsum, 16); lsum += __shfl_xor(lsum, 32);
        const float inv = 1.0f / fmaxf(lsum, 1e-30f);
#pragma unroll
        for (int kb = 0; kb < 8; ++kb) s[kb] *= inv;
#pragma unroll
        for (int kb = 0; kb < 8; ++kb) { const float t1 = __shfl(s[kb][3], (lane - 16) & 63); const float t0v = kb > 0 ? __shfl(s[kb > 0 ? kb - 1 : 0][3], (lane - 16) & 63) : 0.f;
            imp[kb] += s[kb][0] + s[kb][1] + s[kb][2] + 0.5f * s[kb][3] + 0.5f * (fq == 0 ? t0v : t1); }
        f32x4 o[8];
#pragma unroll
        for (int db = 0; db < 8; ++db) o[db] = (f32x4){0.f, 0.f, 0.f, 0.f};
        { const LAS unsigned char* vbase = lds + 2 * AT_TILEB + (4 * fq + (fr >> 2)) * AT_ROWB + 8 * (fr & 3);
#pragma unroll
          for (int c = 0; c < 4; ++c) { const bf16x8 pf = pack8(s[2 * c], s[2 * c + 1]);
#pragma unroll
              for (int db = 0; db < 8; ++db) { const bf16x8 vf = tr_pair(vbase + c * 32 * AT_ROWB + db * 32, vbase + c * 32 * AT_ROWB + 16 * AT_ROWB + db * 32);
                  o[db] = __builtin_amdgcn_mfma_f32_16x16x32_bf16(vf, pf, o[db], 0, 0, 0); } } }
        at_store_o(cat + (size_t)(t0 + row) * 2048 + h * HD, o, 1.0f, fq);
    }
    LAS float* rk = (LAS float*)(lds + AT_AUX + wave * 2048) + fr * 32;
    float mine[8];
#pragma unroll
    for (int kb = 0; kb < 8; ++kb) { const int j = 4 * kb + fq; const bool forced = (j == 0) || (j == cur) || (j == cur - 1);
        mine[kb] = forced ? 1e4f : (j > cur ? -1e4f : imp[kb]); rk[j] = mine[kb]; }
    LDS_WAIT();
    int rank[8];
#pragma unroll
    for (int kb = 0; kb < 8; ++kb) rank[kb] = 0;
#pragma unroll
    for (int j4 = 0; j4 < 8; ++j4) { const f32x4 v = *(const LAS f32x4*)(rk + 4 * j4);
#pragma unroll
        for (int e = 0; e < 4; ++e) { const int jj = 4 * j4 + e;
#pragma unroll
            for (int kb = 0; kb < 8; ++kb) { const int j = 4 * kb + fq; rank[kb] += (v[e] > mine[kb] || (v[e] == mine[kb] && jj < j)) ? 1 : 0; } } }
    unsigned bits = 0u;
#pragma unroll
    for (int kb = 0; kb < 8; ++kb) { const int j = 4 * kb + fq; if (rank[kb] < 16 && j <= cur) bits |= 1u << j; }
    bits |= __shfl_xor(bits, 16); bits |= __shfl_xor(bits, 32);
    if (fq == 0) sel[(size_t)(t0 + row) * 4 + g] = bits;
    __syncthreads();
}
__device__ __forceinline__ void nsa_attn_wg(LAS unsigned char* lds, const bf16_t* proj, const bf16_t* kvs, const unsigned* sel, bf16_t* cat, int b, int h, int qb, int tid_) {
    int tid = tid_; asm volatile("" : "+v"(tid));
    const int lane = tid & 63, wave = tid >> 6, fr = lane & 15, fq = lane >> 4, row = wave * 16 + fr, g = h / 3, t0 = b * SEQ + qb * 128;
    const float slope2 = exp2f(-8.0f * (float)(h + 1) / 12.0f) * LOG2E;
    const unsigned selmask = sel[(size_t)(t0 + row) * 4 + g];
    unsigned um = selmask;
#pragma unroll
    for (int o_ = 1; o_ < 64; o_ <<= 1) um |= __shfl_xor(um, o_);
    LAS unsigned* wgw = (LAS unsigned*)(lds + AT_AUX + 8 * 2048);
    if (lane == 0) wgw[wave] = um;
    __syncthreads();
    um = wgw[0] | wgw[1] | wgw[2] | wgw[3] | wgw[4] | wgw[5] | wgw[6] | wgw[7];
    um = __builtin_amdgcn_readfirstlane(um);
    AttnArgs A; A.q = proj + (size_t)t0 * B_COLS + h * HD; A.qstride = B_COLS; A.kvstride = 3072; A.nkeys = SEQ; A.qpos0 = qb * 128; A.kmul = 1; A.slope2 = slope2;
    const bf16_t* kvb = kvs + (size_t)(b * SEQ) * 3072 + g * HD;
    A.k = kvb + 2 * 512; A.v = kvb + 3 * 512; A.maxdist = 0x7fffffff; A.tilemask = um & (0xffffffffu >> (31 - (2 * qb + 1)));
    f32x4 os[8]; float m, lsum; attn_core<true>(lds, A, selmask, tid, os, m, lsum);
    { const float inv = 1.0f / fmaxf(lsum, 1e-30f);
#pragma unroll
      for (int db = 0; db < 8; ++db) os[db] *= inv; }
    A.k = kvb + 4 * 512; A.v = kvb + 5 * 512; A.maxdist = 511;
    { const int k0 = 2 * qb - 8 < 0 ? 0 : 2 * qb - 8, k1 = 2 * qb + 1; A.tilemask = (0xffffffffu >> (31 - k1)) & (0xffffffffu << k0); }
    f32x4 ow[8]; attn_core<false>(lds, A, 0u, tid, ow, m, lsum);
    const float invw = 1.0f / fmaxf(lsum, 1e-30f);
    const bf16_t* gp = proj + (size_t)(t0 + row) * B_COLS + 2048 + h * 3;
    const float g0 = 1.0f / (1.0f + __expf(-bflo((unsigned)gp[0]))), g1 = 1.0f / (1.0f + __expf(-bflo((unsigned)gp[1]))), g2 = invw / (1.0f + __expf(-bflo((unsigned)gp[2])));
    bf16_t* orow = cat + (size_t)(t0 + row) * 2048 + h * HD + 4 * fq;
#pragma unroll
    for (int db = 0; db < 8; ++db) { const u32x2 c = *(const u32x2*)(orow + 16 * db);
        const float r0 = g0 * bflo(c.x) + g1 * os[db][0] + g2 * ow[db][0], r1 = g0 * bfhi(c.x) + g1 * os[db][1] + g2 * ow[db][1];
        const float r2 = g0 * bflo(c.y) + g1 * os[db][2] + g2 * ow[db][2], r3 = g0 * bfhi(c.y) + g1 * os[db][3] + g2 * ow[db][3];
        u32x2 w; w.x = pg8::cvt_pk_bf16(r0, r1); w.y = pg8::cvt_pk_bf16(r2, r3); *(u32x2*)(orow + 16 * db) = w; }
}

__device__ __forceinline__ int opq_tid() { int t = threadIdx.x; asm volatile("" : "+v"(t)); return t; }
__global__ void __launch_bounds__(NTHREADS, 2) mega_fwd(Params p) {
    extern __shared__ __attribute__((aligned(16))) unsigned char lds_raw[];
    LAS unsigned char* lds = (LAS unsigned char*)lds_raw;
    cg::grid_group grid = cg::this_grid();
    const int tid = threadIdx.x, lane = tid & 63, wave = __builtin_amdgcn_readfirstlane(tid >> 6);
    const int G = gridDim.x, bid = blockIdx.x;
    const int gw = bid * NWAVES + wave, ngw = G * NWAVES;
    unsigned char* ws = p.ws;
    float* X = p.out;
    bf16_t* XH = (bf16_t*)(ws + WS_XH); bf16_t* PROJ = (bf16_t*)(ws + WS_PROJ); float* OBUF = (float*)(ws + WS_OBUF);
    bf16_t* CAT = (bf16_t*)(ws + WS_CAT); bf16_t* KVS = (bf16_t*)(ws + WS_KVS); bf16_t* MEMKV = (bf16_t*)(ws + WS_MEMKV); bf16_t* MEMHAT = (bf16_t*)(ws + WS_MEMHAT);
    bf16_t* OG = (bf16_t*)(ws + WS_KVS); float* LSE = (float*)(ws + WS_HID); unsigned* SEL = (unsigned*)(ws + WS_SEL);
    bf16_t* HID = (bf16_t*)(ws + WS_HID); bf16_t* KCV = (bf16_t*)(ws + WS_KCV); bf16_t* BLK = (bf16_t*)(ws + WS_OBUF);
    LAS float* wscr = (LAS float*)(lds + wave * 16384);
    LAS float* qs = wscr; LAS float* sc = wscr + 128; LAS float* pc = wscr + 128 + 1024; LAS int* blk = (LAS int*)(wscr + 128 + 1024 + 384);

    {
        ConvJob J;
        for (int j = 0; conv_get(p, j, J); ++j) conv_run(J, wscr, gw, ngw, lane);
        for (int m = gw; m < 1024; m += ngw) rms_row(p.in[I_MEM] + (size_t)m * 2048, MEMHAT + (size_t)m * 2048, nullptr, lane);
        for (int m = gw; m < NTOK; m += ngw) rms_row(p.in[I_X] + (size_t)m * 2048, XH + (size_t)m * 2048, X + (size_t)m * 2048, lane);
    }
    grid.sync();

    for (int l = 0; l < 4; ++l) {
        const bool isA = l < 2;
        for (int jb = 0; jb < 3; ++jb) {
            pg8::Gemm g; bf16_t* O; int ldc; int c = bid;
            if (jb == 0) { g.A = XH; g.M = NTOK; g.K = 2048;
                if (isA) { g.Bt = (const bf16_t*)(ws + WS_WAIN + l * SZ_WAIN); g.N = A_COLS; O = PROJ; ldc = A_COLS; }
                else { g.Bt = (const bf16_t*)(ws + WS_WBIN + (l - 2) * SZ_WBIN); g.N = B_COLS; O = PROJ; ldc = B_COLS; } }
            else if (jb == 1) { if (l != 0) continue; g.A = MEMHAT; g.Bt = (const bf16_t*)(ws + WS_WMEM); g.M = 1024; g.N = 4096; g.K = 2048; O = MEMKV; ldc = 4096; c = (bid + 64) % G; }
            else { if (l != 2) continue; g.A = XH; g.Bt = (const bf16_t*)(ws + WS_WKV); g.M = NTOK; g.N = 3072; g.K = 2048; O = KVS; ldc = 3072; }
            pg8::StaticOrder S; S.init(g.M, g.N, G, c);
            pg8::EpiBf16<0> E{O, ldc};
            pg8::gemm_phase(lds, g, S, E);
        }
        grid.sync();
        if (l == 2) {
            const int lane = opq_tid() & 63;
            for (int it = gw; it < 2 * 2048; it += ngw) {
                const int w = it >> 11, row = it & 2047; bf16_t* dst = BLK + ((size_t)w * 2048 + row) * 4096;
                if (row < NBATCH * NCMP * 4) { const int gg = row & 3, bn = row >> 2, bb = bn / NCMP, n = bn % NCMP;
                    const bf16_t* src = KVS + (size_t)(bb * SEQ + 16 * n) * 3072 + w * 512 + gg * HD; const float* pe = p.in[I_PE] + w * 32 * HD;
                    for (int ll = 0; ll < 32; ++ll) { const unsigned v = *(const unsigned*)(src + (size_t)ll * 3072 + 2 * lane); const f32x2 e = *(const f32x2*)(pe + ll * HD + 2 * lane);
                        *(unsigned*)(dst + ll * HD + 2 * lane) = pk2(bflo(v) + e.x, bfhi(v) + e.y); } }
                else { for (int ll = 0; ll < 32; ++ll) *(unsigned*)(dst + ll * HD + 2 * lane) = 0u; }
            }
            grid.sync();
            for (int w = 0; w < 2; ++w) { pg8::Gemm g{BLK + (size_t)w * 2048 * 4096, (const bf16_t*)(ws + WS_WC1 + w * SZ_WC1), 2048, 512, 4096};
                pg8::StaticOrder S; S.init(2048, 512, G, (bid + 128 * w) % G); pg8::EpiBf16<1> E{HID + (size_t)w * 2048 * 512, 512}; pg8::gemm_phase(lds, g, S, E); }
            grid.sync();
            for (int w = 0; w < 2; ++w) { pg8::Gemm g{HID + (size_t)w * 2048 * 512, (const bf16_t*)(ws + WS_WC2 + w * SZ_WC2), 2048, 256, 512};
                pg8::StaticOrder S; S.init(2048, 256, G, (bid + 128 * w) % G); pg8::EpiBf16<0> E{KCV + (size_t)w * 2048 * 256, 256}; pg8::gemm_phase(lds, g, S, E); }
            grid.sync();
        }
        if (isA) {
            for (int it = bid; it < 1792; it += G) {
                if (it < 1536) { const int x = it & 15, bh = it >> 4; dil_attn_wg(lds, PROJ, OG, LSE, bh / 24, bh % 24, x, opq_tid()); }
                else { const int u = it - 1536; mem_attn_wg(lds, PROJ, A_COLS, 9216, MEMKV, l, CAT, 1536, 1024, u >> 6, (u >> 4) & 3, u & 15, opq_tid()); }
            }
            grid.sync();
            for (int it = bid * NTHREADS + opq_tid(); it < NTOK * 8 * 16; it += G * NTHREADS) { const int c8 = it & 15, tj = it >> 4;
                const float l0 = LSE[tj], l1 = LSE[(size_t)NTOK * 8 + tj], l2 = LSE[(size_t)2 * NTOK * 8 + tj], mx = fmaxf(l0, fmaxf(l1, l2));
                float e0 = __expf(l0 - mx), e1 = __expf(l1 - mx), e2 = __expf(l2 - mx); const float inv = 1.0f / (e0 + e1 + e2); e0 *= inv; e1 *= inv; e2 *= inv;
                const u32x4 a = *(const u32x4*)(OG + (size_t)tj * 128 + 8 * c8), bq = *(const u32x4*)(OG + ((size_t)NTOK * 8 + tj) * 128 + 8 * c8), cq = *(const u32x4*)(OG + ((size_t)2 * NTOK * 8 + tj) * 128 + 8 * c8);
                u32x4 w;
                w.x = pk2(e0 * bflo(a.x) + e1 * bflo(bq.x) + e2 * bflo(cq.x), e0 * bfhi(a.x) + e1 * bfhi(bq.x) + e2 * bfhi(cq.x));
                w.y = pk2(e0 * bflo(a.y) + e1 * bflo(bq.y) + e2 * bflo(cq.y), e0 * bfhi(a.y) + e1 * bfhi(bq.y) + e2 * bfhi(cq.y));
                w.z = pk2(e0 * bflo(a.z) + e1 * bflo(bq.z) + e2 * bflo(cq.z), e0 * bfhi(a.z) + e1 * bfhi(bq.z) + e2 * bfhi(cq.z));
                w.w = pk2(e0 * bflo(a.w) + e1 * bflo(bq.w) + e2 * bflo(cq.w), e0 * bfhi(a.w) + e1 * bfhi(bq.w) + e2 * bfhi(cq.w));
                const int t = tj >> 3, j = tj & 7;
                *(u32x4*)(CAT + (size_t)t * 1536 + j * HD + 8 * c8) = w; }
        } else {
            for (int it = bid; it < 256; it += G) cmp_sel_wg(lds, PROJ, KCV, KCV + (size_t)2048 * 256, CAT, SEL, it >> 6, (it >> 4) & 3, it & 15, opq_tid());
            grid.sync();
            for (int kq = bid; kq < 1024; kq += G) {
                const int rnd = kq >> 8, pos = kq & 255, it = rnd * 256 + ((rnd & 1) ? (255 - pos) : pos);
                if (it < 768) { const int qb = 15 - it / 48, bh = it % 48; nsa_attn_wg(lds, PROJ, KVS, SEL, CAT, bh / 12, bh % 12, qb, opq_tid()); }
                else { const int u = it - 768; mem_attn_wg(lds, PROJ, B_COLS, 1536, MEMKV, l, CAT, 2048, 1536, u >> 6, (u >> 4) & 3, u & 15, opq_tid()); }
            }
        }
        grid.sync();
        for (int hf = 0; hf < 2; ++hf) {
            if (hf == 1) { pg8::Gemm g{XH, (const bf16_t*)(ws + WS_WGU + l * SZ_WGU), NTOK, 11264, 2048}; pg8::StaticOrder S; S.init(NTOK, 11264, G, bid);
                pg8::EpiSwiGLU E{PROJ, DFF}; pg8::gemm_phase(lds, g, S, E); grid.sync(); }
            { pg8::Gemm g; g.M = NTOK; g.N = 2048;
              if (hf == 0) { g.A = CAT; g.K = isA ? 1536 : 2048; g.Bt = isA ? (const bf16_t*)(ws + WS_WAOUT + l * SZ_WAOUT) : (const bf16_t*)(ws + WS_WBOUT + (l - 2) * SZ_WBOUT); }
              else { g.A = PROJ; g.K = DFF; g.Bt = (const bf16_t*)(ws + WS_WDOWN + l * SZ_WDOWN); }
              pg8::StaticOrder S; S.init(NTOK, 2048, G, bid); pg8::EpiF32 E{OBUF, 2048}; pg8::gemm_phase(lds, g, S, E); }
            grid.sync();
            const float* gain = p.in[I_NORMG] + (l * 5 + (hf == 0 ? 1 : 3)) * 2048;
            for (int m = gw; m < NTOK; m += ngw) rowop_row(X + (size_t)m * 2048, OBUF + (size_t)m * 2048, gain, XH + (size_t)m * 2048, opq_tid() & 63);
            grid.sync();
        }
    }
}

extern "C" void kernel_launch(void* const* d_in, const int* in_sizes, int n_in, void* d_out, int out_size, void* d_ws, size_t ws_size, hipStream_t stream) {
    static int grid_blocks = 0;
    if (grid_blocks == 0) {
        if (n_in != 17 || ws_size < WS_END) { fprintf(stderr, "kernel_launch: unexpected n_in %d or ws_size %zu (< %zu)\n", n_in, ws_size, (size_t)WS_END); grid_blocks = -1; return; }
        int dev = 0, cus = 0, per_cu = 0;
        hipGetDevice(&dev);
        hipDeviceGetAttribute(&cus, hipDeviceAttributeMultiprocessorCount, dev);
        hipFuncSetAttribute((const void*)mega_fwd, hipFuncAttributeMaxDynamicSharedMemorySize, LDS_BYTES);
        hipOccupancyMaxActiveBlocksPerMultiprocessor(&per_cu, (const void*)mega_fwd, NTHREADS, LDS_BYTES);
        if (per_cu < 1) per_cu = 1;
        if (per_cu > 1) per_cu = 1;
        grid_blocks = cus * per_cu;
        (void)hipGetLastError();
    }
    if (grid_blocks < 0) return;
    static Params p;
    memset(&p, 0, sizeof(p));
    for (int i = 0; i < 17; ++i) p.in[i] = (const float*)d_in[i];
    p.out = (float*)d_out; p.ws = (unsigned char*)d_ws;
    {
        int n = 0;
        auto add = [&](int in_idx, size_t in_off, int gain_idx, int gain_off, size_t dst_off, int ldw, int col0, int ncols, int K, int nrows, int mode) {
            JobDesc& d = p.jobs[n++]; d.in_idx = in_idx; d.in_off = in_off; d.gain_idx = gain_idx; d.gain_off = gain_off; d.dst_off = dst_off; d.ldw = ldw; d.col0 = col0; d.ncols = ncols; d.K = K; d.nrows = nrows; d.mode = mode; d.pad = 0; };
        for (int l = 0; l < 4; ++l) add(I_WGU, (size_t)l * 2048 * 11264, I_NORMG, (l * 5 + 2) * 2048, WS_WGU + l * SZ_WGU, 11264, 0, 11264, 2048, 11264, 1);
        for (int l = 0; l < 4; ++l) add(I_WDOWN, (size_t)l * 5632 * 2048, -1, 0, WS_WDOWN + l * SZ_WDOWN, 2048, 0, 2048, 5632, 2048, 0);
        for (int l = 0; l < 2; ++l) add(I_AWIN, (size_t)l * 2048 * A_COLS, I_NORMG, (l * 5 + 0) * 2048, WS_WAIN + l * SZ_WAIN, A_COLS, 0, A_COLS, 2048, A_COLS, 0);
        for (int l = 0; l < 2; ++l) add(I_AWOUT, (size_t)l * 1536 * 2048, -1, 0, WS_WAOUT + l * SZ_WAOUT, 2048, 0, 2048, 1536, 2048, 0);
        for (int lb = 0; lb < 2; ++lb) {
            const size_t src = (size_t)lb * 2048 * B_COLS_SRC, dst = WS_WBIN + lb * SZ_WBIN; const int go = ((2 + lb) * 5 + 0) * 2048;
            add(I_BWIN, src, I_NORMG, go, dst, B_COLS_SRC, 0, 1536, 2048, 1536, 0);
            add(I_BWIN, src, I_NORMG, go, dst + (size_t)1536 * 2048 * 2, B_COLS_SRC, 1572, 512, 2048, 512, 0);
            add(I_BWIN, src, I_NORMG, go, dst + (size_t)2048 * 2048 * 2, B_COLS_SRC, 1536, 36, 2048, 256, 0);
        }
        for (int lb = 0; lb < 2; ++lb) add(I_BWOUT, (size_t)lb * 2048 * 2048, -1, 0, WS_WBOUT + lb * SZ_WBOUT, 2048, 0, 2048, 2048, 2048, 0);
        for (int l = 0; l < 4; ++l) add(I_MEMWKV, (size_t)l * 2048 * 1024, I_NORMG, (l * 5 + 4) * 2048, WS_WMEM + (size_t)l * 1024 * 2048 * 2, 1024, 0, 1024, 2048, 1024, 0);
        add(I_KVW, 0, I_KVNG, 0, WS_WKV, 3072, 0, 3072, 2048, 3072, 0);
        add(I_WK1, 0, -1, 0, WS_WC1, 512, 0, 512, 4096, 512, 0);
        add(I_WV1, 0, -1, 0, WS_WC1 + SZ_WC1, 512, 0, 512, 4096, 512, 0);
        add(I_WK2, 0, -1, 0, WS_WC2, 128, 0, 128, 512, 256, 0);
        add(I_WV2, 0, -1, 0, WS_WC2 + SZ_WC2, 128, 0, 128, 512, 256, 0);
        p.njobs = n;
    }
    void* args[] = {&p};
    hipError_t e = hipLaunchCooperativeKernel((const void*)mega_fwd, dim3(grid_blocks), dim3(NTHREADS), args, LDS_BYTES, stream);
    if (e != hipSuccess) fprintf(stderr, "cooperative launch failed: %s (grid %d)\n", hipGetErrorString(e), grid_blocks);
}
```

```cpp
#include <hip/hip_runtime.h>
#include <hip/hip_cooperative_groups.h>
#include <cstdio>
#include <cstring>
namespace cg = cooperative_groups;
#define REP_P0 1
#define REP_GEMM 1
#define REP_ATT 1
#define REP_SYNC 1

#define LAS __attribute__((address_space(3)))
typedef unsigned short bf16_t;
typedef short bf16x8 __attribute__((ext_vector_type(8)));
typedef float f32x4 __attribute__((ext_vector_type(4)));
typedef float f32x2 __attribute__((ext_vector_type(2)));
typedef unsigned u32x4 __attribute__((ext_vector_type(4)));
typedef unsigned u32x2 __attribute__((ext_vector_type(2)));
typedef __bf16 bf16x2_t __attribute__((ext_vector_type(2)));

constexpr int D_MODEL = 2048, NTOK = 8192, SEQ = 2048, NBATCH = 4, DFF = 5632, HD = 128;
constexpr int A_COLS = 9728, B_COLS_SRC = 2084, B_COLS = 2304, NCMP = 127;
constexpr int NWAVES = 8, NTHREADS = 512;
constexpr int LDS_MAIN = 131072; constexpr int LDS_BYTES = LDS_MAIN + 64;

constexpr size_t SZ_WAIN = (size_t)A_COLS * 2048 * 2, SZ_WAOUT = (size_t)2048 * 1536 * 2, SZ_WBIN = (size_t)B_COLS * 2048 * 2, SZ_WBOUT = (size_t)2048 * 2048 * 2;
constexpr size_t SZ_WGU = (size_t)11264 * 2048 * 2, SZ_WDOWN = (size_t)2048 * 5632 * 2, SZ_WC1 = (size_t)512 * 4096 * 2, SZ_WC2 = (size_t)256 * 512 * 2;
constexpr size_t WS_WAIN = 0;
constexpr size_t WS_WAOUT = WS_WAIN + 2 * SZ_WAIN;
constexpr size_t WS_WBIN = WS_WAOUT + 2 * SZ_WAOUT;
constexpr size_t WS_WBOUT = WS_WBIN + 2 * SZ_WBIN;
constexpr size_t WS_WMEM = WS_WBOUT + 2 * SZ_WBOUT;
constexpr size_t WS_WGU = WS_WMEM + (size_t)4096 * 2048 * 2;
constexpr size_t WS_WDOWN = WS_WGU + 4 * SZ_WGU;
constexpr size_t WS_WKV = WS_WDOWN + 4 * SZ_WDOWN;
constexpr size_t WS_WC1 = WS_WKV + (size_t)3072 * 2048 * 2;
constexpr size_t WS_WC2 = WS_WC1 + 2 * SZ_WC1;
constexpr size_t WS_PROJ = WS_WC2 + 2 * SZ_WC2;
constexpr size_t WS_OBUF = WS_PROJ + (size_t)NTOK * A_COLS * 2;
constexpr size_t WS_XH = WS_OBUF + (size_t)NTOK * 2048 * 4;
constexpr size_t WS_CAT = WS_XH + (size_t)NTOK * 2048 * 2;
constexpr size_t WS_KVS = WS_CAT + (size_t)NTOK * 2048 * 2;
constexpr size_t WS_MEMKV = WS_KVS + (size_t)NTOK * 3072 * 2;
constexpr size_t WS_MEMHAT = WS_MEMKV + (size_t)1024 * 4096 * 2;
constexpr size_t WS_HID = WS_MEMHAT + (size_t)1024 * 2048 * 2;
constexpr size_t WS_KCV = WS_HID + (size_t)2 * 2048 * 512 * 2;
constexpr size_t WS_SEL = WS_KCV + (size_t)2 * 2048 * 256 * 2;
constexpr size_t WS_BAR = WS_SEL + (size_t)NTOK * 4 * 4;
constexpr size_t WS_BAR_BYTES = 16384;
constexpr size_t WS_END = WS_BAR + WS_BAR_BYTES;

#define LDS_WAIT() asm volatile("s_waitcnt lgkmcnt(0)" ::: "memory")
__device__ __forceinline__ unsigned f2bf(float f) { unsigned u = __builtin_bit_cast(unsigned, f); return (u + 0x7fffu + ((u >> 16) & 1u)) >> 16; }
__device__ __forceinline__ unsigned pk2(float lo, float hi) { const f32x2 v = {lo, hi}; return __builtin_bit_cast(unsigned, __builtin_convertvector(v, bf16x2_t)); }
__device__ __forceinline__ float bflo(unsigned w) { return __builtin_bit_cast(float, w << 16); }
__device__ __forceinline__ float bfhi(unsigned w) { return __builtin_bit_cast(float, w & 0xffff0000u); }
__device__ __forceinline__ float wave_sum(float v) {
#pragma unroll
    for (int o = 1; o < 64; o <<= 1) v += __shfl_xor(v, o);
    return v;
}
__device__ __forceinline__ float wave_max(float v) {
#pragma unroll
    for (int o = 1; o < 64; o <<= 1) v = fmaxf(v, __shfl_xor(v, o));
    return v;
}


#define XB_TMO      128
#define XB_XCNT(j)  (256  + 64 * (j))
#define XB_XSUB(j)  (1280 + 64 * (j))
#define XB_XGEN(j)  (2304 + 64 * (j))
#define XB_TOP      3328
#define XB_TOPGEN   3392
#define XCD_BAR_WORDS 3456
#define XB_SPIN_CAP (1u << 18)
__device__ __forceinline__ unsigned xb_ld(unsigned* p)              { return __hip_atomic_load(p, __ATOMIC_RELAXED, __HIP_MEMORY_SCOPE_AGENT); }
__device__ __forceinline__ unsigned xb_add(unsigned* p, unsigned v) { return __hip_atomic_fetch_add(p, v, __ATOMIC_RELAXED, __HIP_MEMORY_SCOPE_AGENT); }
__device__ __forceinline__ unsigned xb_xcc_id() { return (unsigned)__builtin_amdgcn_s_getreg((3 << 11) | 20) & 0xFu; }
#define XB_SPIN(cond, bar) do { unsigned _sp = 0; while (cond) { __builtin_amdgcn_s_sleep(1); \
    if ((++_sp & 255u) == 0u) { if (xb_ld(&(bar)[XB_TMO])) break; if (_sp > XB_SPIN_CAP) { atomicAdd(&(bar)[XB_TMO], 1u); break; } } } } while (0)
struct XcdBarrier { unsigned* bar; unsigned x; volatile LAS unsigned* st; };
__device__ __forceinline__ XcdBarrier xcd_barrier_post(unsigned* bar, volatile LAS unsigned* st) {
    XcdBarrier b; b.bar = bar; b.x = xb_xcc_id(); b.st = st;
    if (threadIdx.x == 0) (void)xb_add(&bar[XB_XCNT(b.x)], 1u);
    return b;
}
__device__ __forceinline__ void xcd_barrier_complete(unsigned* bar, unsigned x, unsigned& nloc, unsigned& nx) {
    const unsigned G = gridDim.x * gridDim.y * gridDim.z;
    unsigned sum, cnt, mine, sp = 0u;
    for (;;) {
        sum = 0u; cnt = 0u; mine = 0u;
#pragma unroll
        for (unsigned j = 0; j < 16; ++j) { const unsigned c = xb_ld(&bar[XB_XCNT(j)]); sum += c; cnt += (c > 0u) ? 1u : 0u; mine = (j == x) ? c : mine; }
        if (sum == G) break;
        __builtin_amdgcn_s_sleep(1);
        if ((++sp & 255u) == 0u) { if (xb_ld(&bar[XB_TMO])) break; if (sp > XB_SPIN_CAP) { atomicAdd(&bar[XB_TMO], 1u); break; } }
    }
    nloc = mine > 0u ? mine : 1u; nx = cnt > 0u ? cnt : 1u;
}
__device__ __forceinline__ void xcd_barrier(const XcdBarrier& b) {
    asm volatile("s_waitcnt vmcnt(0)" ::: "memory");
    __syncthreads();
    if (threadIdx.x == 0) {
        unsigned* bar = b.bar;
        __builtin_amdgcn_s_waitcnt(0);
        unsigned nloc = b.st[0], nx = b.st[1];
        if (nloc == 0u) { xcd_barrier_complete(bar, b.x, nloc, nx); b.st[0] = nloc; b.st[1] = nx; }
        const unsigned old = xb_add(&bar[XB_XSUB(b.x)], 1u);
        const unsigned gen = old / nloc;
        if (old + 1u == (gen + 1u) * nloc) {
            __builtin_amdgcn_fence(__ATOMIC_RELEASE, "agent");
            asm volatile("s_waitcnt vmcnt(0)" ::: "memory");
            const unsigned og = xb_add(&bar[XB_TOP], 1u);
            const unsigned tg = og / nx;
            if (og + 1u == (tg + 1u) * nx) xb_add(&bar[XB_TOPGEN], 1u);
            else XB_SPIN(xb_ld(&bar[XB_TOPGEN]) == tg, bar);
            __builtin_amdgcn_fence(__ATOMIC_ACQUIRE, "agent");
            xb_add(&bar[XB_XGEN(b.x)], 1u);
            asm volatile("s_waitcnt vmcnt(0)" ::: "memory");
        } else {
            XB_SPIN(xb_ld(&bar[XB_XGEN(b.x)]) == gen, bar);
            __builtin_amdgcn_fence(__ATOMIC_ACQUIRE, "agent");
            asm volatile("s_waitcnt vmcnt(0)" ::: "memory");
        }
    }
    __syncthreads();
}

namespace pg8 {
constexpr int BM = 256, BK = 64, HALF = 128, HTB = HALF * BK * 2, STAGE_BYTES = 8 * HTB, NXCD = 8, WGM = 8;
__device__ __forceinline__ int lds_byte(int r, int c) { const int st = (r >> 4) * 2 + (c >> 5), rr = r & 15, cc = c & 31, ob = rr * 64 + cc * 2; return st * 1024 + (ob ^ (((ob >> 9) & 1) << 5)); }
__device__ __forceinline__ void stage_rc(int b, int& R, int& C) { const int st = b / 1024, sb = b % 1024, swz = sb ^ (((sb >> 9) & 1) << 5); R = (st >> 1) * 16 + swz / 64; C = (st & 1) * 32 + (swz % 64) / 2; }
__device__ __forceinline__ int perm32(int rho) { const int n = rho >> 4, i = rho & 15; return 8 * (i >> 2) + 4 * n + (i & 3); }
struct Unit { int pm, pn; };
struct Gemm { const bf16_t* A; const bf16_t* Bt; int M, N, K; };
struct StaticOrder {
    int nM, nN, nwg, G, c;
    __device__ void init(int M, int N, int G_, int c_) { nM = M / BM; nN = N / BM; nwg = nM * nN; G = G_; c = c_; }
    __device__ bool next(int i, Unit& u) const {
        const long L = (long)i * G + c; if (L >= nwg) return false;
        int wgid = (int)L; { const int q = nwg / NXCD, r = nwg % NXCD, xcd = wgid % NXCD, off = wgid / NXCD; wgid = (xcd < r ? xcd * (q + 1) : r * (q + 1) + (xcd - r) * q) + off; }
        const int nig = WGM * nN, gid = wgid / nig, fm = gid * WGM, gsz = (nM - fm) < WGM ? (nM - fm) : WGM;
        u.pm = fm + ((wgid % nig) % gsz); u.pn = (wgid % nig) / gsz; return true;
    }
    __device__ __forceinline__ void a_ready(const Unit&) const {}
    __device__ __forceinline__ void done(const Unit&) const {}
};
__device__ __forceinline__ unsigned cvt_pk_bf16(float lo, float hi) { const f32x2 v = {lo, hi}; return __builtin_bit_cast(unsigned, __builtin_convertvector(v, bf16x2_t)); }

struct EpiF32 {
    static constexpr bool PERM = false;
    float* C; int ldc;
    __device__ __forceinline__ void operator()(const f32x4 (&acc)[2][2][4][2], const Unit& u, int wr, int wc, int fr, int fq) const {
        const int row0 = u.pm * BM + wr * 64 + fr, col0 = u.pn * BM + wc * 32 + 4 * fq;
#pragma unroll
        for (int ai = 0; ai < 2; ++ai)
#pragma unroll
            for (int m = 0; m < 4; ++m) { float* rowp = C + (size_t)(row0 + ai * HALF + m * 16) * ldc + col0;
#pragma unroll
                for (int bj = 0; bj < 2; ++bj)
#pragma unroll
                    for (int n = 0; n < 2; ++n) *(f32x4*)(rowp + bj * HALF + n * 16) = acc[ai][bj][m][n]; }
    }
};
__device__ __forceinline__ float gelu_tanh(float x) { const float t = 1.5957691216f * (x + 0.044715f * x * x * x); return x / (1.0f + __expf(-t)); }
template <int ACT  > struct EpiBf16 {
    static constexpr bool PERM = true;
    bf16_t* O; int ldc;
    __device__ __forceinline__ void operator()(const f32x4 (&acc)[2][2][4][2], const Unit& u, int wr, int wc, int fr, int fq) const {
        const int row0 = u.pm * BM + wr * 64 + fr, col0 = u.pn * BM + wc * 32 + 8 * fq;
#pragma unroll
        for (int ai = 0; ai < 2; ++ai)
#pragma unroll
            for (int m = 0; m < 4; ++m) { bf16_t* rowp = O + (size_t)(row0 + ai * HALF + m * 16) * ldc + col0;
#pragma unroll
                for (int bj = 0; bj < 2; ++bj) { f32x4 v0 = acc[ai][bj][m][0], v1 = acc[ai][bj][m][1];
                    if (ACT == 1) {
#pragma unroll
                        for (int j = 0; j < 4; ++j) { v0[j] = gelu_tanh(v0[j]); v1[j] = gelu_tanh(v1[j]); } }
                    u32x4 w; w.x = cvt_pk_bf16(v0[0], v0[1]); w.y = cvt_pk_bf16(v0[2], v0[3]); w.z = cvt_pk_bf16(v1[0], v1[1]); w.w = cvt_pk_bf16(v1[2], v1[3]);
                    *(u32x4*)(rowp + bj * HALF) = w; } }
    }
};
struct EpiSwiGLU {
    static constexpr bool PERM = true;
    bf16_t* O; int ldc;
    __device__ __forceinline__ void operator()(const f32x4 (&acc)[2][2][4][2], const Unit& u, int wr, int wc, int fr, int fq) const {
        const int row0 = u.pm * BM + wr * 64 + fr, col0 = u.pn * HALF + wc * 32 + 8 * fq;
#pragma unroll
        for (int ai = 0; ai < 2; ++ai)
#pragma unroll
            for (int m = 0; m < 4; ++m) { bf16_t* rowp = O + (size_t)(row0 + ai * HALF + m * 16) * ldc + col0;
                f32x4 v0, v1;
#pragma unroll
                for (int j = 0; j < 4; ++j) { const float g0 = acc[ai][0][m][0][j], g1 = acc[ai][0][m][1][j];
                    v0[j] = g0 / (1.0f + __expf(-g0)) * acc[ai][1][m][0][j]; v1[j] = g1 / (1.0f + __expf(-g1)) * acc[ai][1][m][1][j]; }
                u32x4 w; w.x = cvt_pk_bf16(v0[0], v0[1]); w.y = cvt_pk_bf16(v0[2], v0[3]); w.z = cvt_pk_bf16(v1[0], v1[1]); w.w = cvt_pk_bf16(v1[2], v1[3]);
                *(u32x4*)rowp = w; }
    }
};

template <class Epi, class Sched>
__device__ __forceinline__ void gemm_phase(LAS unsigned char* lds, const Gemm g, const Sched& S, const Epi& E) {
    int tid_ = threadIdx.x; asm volatile("" : "+v"(tid_));
    const int tid = tid_, wid = __builtin_amdgcn_readfirstlane(tid >> 6), lane = tid & 63, wr = wid >> 2, wc = wid & 3, fr = lane & 15, fq = lane >> 4;
    const int K = g.K, nt = K / BK;
    unsigned voffA[2], voffB[2];
#pragma unroll
    for (int i = 0; i < 2; ++i) { int R, C; stage_rc(tid * 16 + i * 8192, R, C); const int Rb = Epi::PERM ? ((R & ~31) + perm32(R & 31)) : R;
        voffA[i] = (unsigned)(R * K + C) * 2u; voffB[i] = (unsigned)(Rb * K + C) * 2u; }
    const size_t kstep = (size_t)(BK * 2);
    const size_t hstep = (size_t)HALF * K * 2;
    const size_t tstep = 2 * hstep;
    const unsigned ldsw = (unsigned)wid * 1024u;
    const int aoff = lds_byte(wr * 64 + fr, fq * 8), boff = lds_byte(wc * 32 + fr, fq * 8);
#define PG8_SA(b, h) (((b) * 2 + (h)) * HTB)
#define PG8_SB(b, h) ((4 + (b) * 2 + (h)) * HTB)
#define PG8_STAGE(bufoff, gbase, voff) do { _Pragma("unroll") for (int _i = 0; _i < 2; ++_i) \
        __builtin_amdgcn_global_load_lds((const unsigned*)((const char*)(gbase) + (voff)[_i]), (LAS unsigned*)(lds + (bufoff) + ldsw + _i * 8192), 16, 0, 0); } while (0)
#define PG8_LDA(dst, b, h) do { _Pragma("unroll") for (int m = 0; m < 4; ++m) _Pragma("unroll") for (int k = 0; k < 2; ++k) dst[m][k] = *(const LAS bf16x8*)(lds + PG8_SA(b, h) + aoff + m * 2048 + k * 1024); } while (0)
#define PG8_LDB(dst, b, h) do { _Pragma("unroll") for (int n = 0; n < 2; ++n) _Pragma("unroll") for (int k = 0; k < 2; ++k) dst[n][k] = *(const LAS bf16x8*)(lds + PG8_SB(b, h) + boff + n * 2048 + k * 1024); } while (0)
#define PG8_MMA(ai, bj, At, Bt) do { __builtin_amdgcn_s_setprio(1); _Pragma("unroll") for (int m = 0; m < 4; ++m) _Pragma("unroll") for (int n = 0; n < 2; ++n) _Pragma("unroll") for (int k = 0; k < 2; ++k) \
        acc[ai][bj][m][n] = __builtin_amdgcn_mfma_f32_16x16x32_bf16(Bt[n][k], At[m][k], acc[ai][bj][m][n], 0, 0, 0); __builtin_amdgcn_s_setprio(0); } while (0)
#define PG8_WAIT_V(n) asm volatile("s_waitcnt vmcnt(" #n ")" ::: "memory")
#define PG8_WAIT_L(n) asm volatile("s_waitcnt lgkmcnt(" #n ")" ::: "memory")
#define PG8_BAR __builtin_amdgcn_s_barrier()
#define PG8_SCHED __builtin_amdgcn_sched_barrier(0)
    Unit cur, nxt; int ui = 0;
    if (!S.next(0, cur)) return;
    f32x4 acc[2][2][4][2];
#pragma unroll
    for (int a = 0; a < 2; ++a)
#pragma unroll
        for (int b = 0; b < 2; ++b)
#pragma unroll
            for (int m = 0; m < 4; ++m)
#pragma unroll
                for (int n = 0; n < 2; ++n) acc[a][b][m][n] = (f32x4){0.f, 0.f, 0.f, 0.f};
    bf16x8 At[4][2], B0[2][2], B1[2][2];
    const char* cA = (const char*)g.A + (size_t)cur.pm * tstep; const char* cB = (const char*)g.Bt + (size_t)cur.pn * tstep;
    S.a_ready(cur);
    PG8_STAGE(PG8_SB(0, 0), cB, voffB); PG8_STAGE(PG8_SA(0, 0), cA, voffA); PG8_STAGE(PG8_SB(0, 1), cB + hstep, voffB); PG8_STAGE(PG8_SA(0, 1), cA + hstep, voffA);
    if (wr == 1) PG8_BAR;
    PG8_WAIT_V(4); PG8_BAR;
    PG8_STAGE(PG8_SB(1, 0), cB + kstep, voffB); PG8_STAGE(PG8_SA(1, 0), cA + kstep, voffA); PG8_STAGE(PG8_SB(1, 1), cB + hstep + kstep, voffB);
    PG8_WAIT_V(6); PG8_BAR;
    for (;;) {
        const bool has_next = S.next(ui + 1, nxt);
        const char* nA = has_next ? (const char*)g.A + (size_t)nxt.pm * tstep : cA; const char* nB = has_next ? (const char*)g.Bt + (size_t)nxt.pn * tstep : cB;
        for (int t = 0; t < nt; t += 2) {
            const bool last = (t == nt - 2);
            const char* a1 = cA + (size_t)(t + 1) * kstep;
            const char* a2 = last ? nA : cA + (size_t)(t + 2) * kstep; const char* b2 = last ? nB : cB + (size_t)(t + 2) * kstep;
            const char* a3 = a2 + kstep; const char* b3 = b2 + kstep;
            if (last && has_next) S.a_ready(nxt);
            PG8_LDB(B0, 0, 0); PG8_SCHED; PG8_LDA(At, 0, 0); PG8_STAGE(PG8_SA(1, 1), a1 + hstep, voffA);
            PG8_WAIT_L(8); PG8_BAR; PG8_WAIT_L(0); PG8_MMA(0, 0, At, B0); PG8_BAR; PG8_SCHED;
            PG8_LDB(B1, 0, 1); PG8_STAGE(PG8_SB(0, 0), b2, voffB);
            PG8_BAR; PG8_WAIT_L(0); PG8_MMA(0, 1, At, B1); PG8_BAR;
            PG8_LDA(At, 0, 1); PG8_STAGE(PG8_SA(0, 0), a2, voffA);
            PG8_BAR; PG8_WAIT_L(0); PG8_MMA(1, 0, At, B0); PG8_BAR; PG8_SCHED;
            PG8_STAGE(PG8_SB(0, 1), b2 + hstep, voffB);
            PG8_WAIT_V(6); PG8_BAR; PG8_MMA(1, 1, At, B1); PG8_BAR;
            PG8_LDB(B0, 1, 0); PG8_SCHED; PG8_LDA(At, 1, 0); PG8_STAGE(PG8_SA(0, 1), a2 + hstep, voffA);
            PG8_WAIT_L(8); PG8_BAR; PG8_WAIT_L(0); PG8_MMA(0, 0, At, B0); PG8_BAR; PG8_SCHED;
            PG8_LDB(B1, 1, 1); PG8_STAGE(PG8_SB(1, 0), b3, voffB);
            PG8_BAR; PG8_WAIT_L(0); PG8_MMA(0, 1, At, B1); PG8_BAR;
            PG8_LDA(At, 1, 1); PG8_STAGE(PG8_SA(1, 0), a3, voffA);
            PG8_BAR; PG8_WAIT_L(0); PG8_MMA(1, 0, At, B0); PG8_BAR; PG8_SCHED;
            PG8_STAGE(PG8_SB(1, 1), b3 + hstep, voffB);
            PG8_WAIT_V(6); PG8_BAR; PG8_MMA(1, 1, At, B1); PG8_BAR;
        }
        E(acc, cur, wr, wc, fr, fq); S.done(cur);
        if (!has_next) break;
#pragma unroll
        for (int a = 0; a < 2; ++a)
#pragma unroll
            for (int b = 0; b < 2; ++b)
#pragma unroll
                for (int m = 0; m < 4; ++m)
#pragma unroll
                    for (int n = 0; n < 2; ++n) acc[a][b][m][n] = (f32x4){0.f, 0.f, 0.f, 0.f};
        cur = nxt; cA = nA; cB = nB; ++ui;
    }
    PG8_WAIT_V(0);
    if (wr == 0) PG8_BAR;
    PG8_BAR;
#undef PG8_SA
#undef PG8_SB
#undef PG8_STAGE
#undef PG8_LDA
#undef PG8_LDB
#undef PG8_MMA
#undef PG8_WAIT_V
#undef PG8_WAIT_L
#undef PG8_BAR
#undef PG8_SCHED
}
}

struct JobDesc { unsigned long long in_off, dst_off; int in_idx, gain_idx, gain_off, ldw, col0, ncols, K, nrows, mode, pad; };
constexpr int MAXJOBS = 32;
struct Params { const float* in[17]; float* out; unsigned char* ws; JobDesc jobs[MAXJOBS]; int njobs, pad; };
enum { I_X = 0, I_MEM, I_NORMG, I_AWIN, I_AWOUT, I_BWIN, I_BWOUT, I_MEMWKV, I_WGU, I_WDOWN, I_KVNG, I_KVW, I_PE, I_WK1, I_WK2, I_WV1, I_WV2 };

struct ConvJob { const float* W; const float* gain; bf16_t* dst; int ldw, col0, ncols, K, nrows, mode; };
__device__ __forceinline__ bool conv_get(const Params& p, int j, ConvJob& J) {
    if (j >= p.njobs) return false;
    const JobDesc& d = p.jobs[j];
    J.W = p.in[d.in_idx] + d.in_off; J.gain = d.gain_idx >= 0 ? p.in[d.gain_idx] + d.gain_off : nullptr; J.dst = (bf16_t*)(p.ws + d.dst_off);
    J.ldw = d.ldw; J.col0 = d.col0; J.ncols = d.ncols; J.K = d.K; J.nrows = d.nrows; J.mode = d.mode;
    return true;
}
__device__ __forceinline__ void conv_load(const ConvJob& J, int it, int nblk, int lane, f32x4 (&v)[8], float (&gv)[8]) {
    const int kb = it / nblk, nb = it - kb * nblk, k0 = 64 * kb, n = 32 * nb + 4 * (lane & 7), kr = lane >> 3;
    const bool ok = n < J.ncols;
    const int sc = J.mode == 1 ? (((n >> 7) & 1) * 5632 + (n >> 8) * 128 + (n & 127)) : (J.col0 + n);
    const float* src = J.W + (size_t)(k0 + kr) * J.ldw + sc;
#pragma unroll
    for (int i = 0; i < 8; ++i) { v[i] = ok ? *(const f32x4*)(src + (size_t)(8 * i) * J.ldw) : (f32x4){0.f, 0.f, 0.f, 0.f}; gv[i] = J.gain ? J.gain[k0 + kr + 8 * i] : 1.0f; }
}
__device__ __forceinline__ void conv_run(const ConvJob& J, LAS float* scr, int gw, int ngw, int lane) {
    const int nblk = J.nrows / 32, kblk = J.K / 64, items = nblk * kblk;
    const int c4 = lane & 7, kr = lane >> 3, rn = lane & 31, half = lane >> 5;
    f32x4 cur[8], nxt[8]; float gc[8], gn[8];
    int it = gw;
    if (it < items) conv_load(J, it, nblk, lane, cur, gc);
    for (; it < items; it += ngw) {
        const bool more = it + ngw < items;
        if (more) conv_load(J, it + ngw, nblk, lane, nxt, gn);
        const int kb = it / nblk, nb = it - kb * nblk, k0 = 64 * kb, n0 = 32 * nb;
#pragma unroll
        for (int i = 0; i < 8; ++i) *(LAS f32x4*)(scr + (kr + 8 * i) * 36 + 4 * c4) = cur[i] * gc[i];
        LDS_WAIT();
#pragma unroll
        for (int i = 0; i < 4; ++i) { const int c = 2 * i + half; const LAS float* t = scr + (8 * c) * 36 + rn;
            u32x4 o; o.x = pk2(t[0 * 36], t[1 * 36]); o.y = pk2(t[2 * 36], t[3 * 36]); o.z = pk2(t[4 * 36], t[5 * 36]); o.w = pk2(t[6 * 36], t[7 * 36]);
            *(u32x4*)(J.dst + (size_t)(n0 + rn) * J.K + k0 + 8 * c) = o; }
        LDS_WAIT();
        if (more) {
#pragma unroll
            for (int i = 0; i < 8; ++i) { cur[i] = nxt[i]; gc[i] = gn[i]; } }
    }
}

__device__ __forceinline__ void rms_row(const float* xrow, bf16_t* orow, float* copy, int lane) {
    const f32x4* xr = (const f32x4*)xrow + lane;
    f32x4 v[8]; float s = 0.f;
#pragma unroll
    for (int j = 0; j < 8; ++j) { v[j] = xr[64 * j]; s += (v[j].x * v[j].x + v[j].y * v[j].y) + (v[j].z * v[j].z + v[j].w * v[j].w); }
    const float rs = rsqrtf(wave_sum(s) * (1.f / 2048.f) + 1e-6f);
    u32x2* o8 = (u32x2*)orow + lane;
#pragma unroll
    for (int j = 0; j < 8; ++j) { u32x2 w; w.x = pk2(v[j].x * rs, v[j].y * rs); w.y = pk2(v[j].z * rs, v[j].w * rs); o8[64 * j] = w; }
    if (copy) { f32x4* c4 = (f32x4*)copy + lane;
#pragma unroll
        for (int j = 0; j < 8; ++j) c4[64 * j] = v[j]; }
}
__device__ __forceinline__ void rowop_row(float* xrow, const float* orow, const float* gain, bf16_t* hrow, int lane) {
    const f32x4* o4 = (const f32x4*)orow + lane; f32x4* x4 = (f32x4*)xrow + lane; const f32x4* g4 = (const f32x4*)gain + lane;
    f32x4 o[8]; float s = 0.f;
#pragma unroll
    for (int j = 0; j < 8; ++j) { o[j] = o4[64 * j]; s += (o[j].x * o[j].x + o[j].y * o[j].y) + (o[j].z * o[j].z + o[j].w * o[j].w); }
    const float rs = rsqrtf(wave_sum(s) * (1.f / 2048.f) + 1e-6f);
    float s2 = 0.f;
#pragma unroll
    for (int j = 0; j < 8; ++j) { const f32x4 g = g4[64 * j]; f32x4 x = x4[64 * j]; x = x + o[j] * rs * g; x4[64 * j] = x; o[j] = x; s2 += (x.x * x.x + x.y * x.y) + (x.z * x.z + x.w * x.w); }
    const float rs2 = rsqrtf(wave_sum(s2) * (1.f / 2048.f) + 1e-6f);
    u32x2* o8 = (u32x2*)hrow + lane;
#pragma unroll
    for (int j = 0; j < 8; ++j) { u32x2 w; w.x = pk2(o[j].x * rs2, o[j].y * rs2); w.y = pk2(o[j].z * rs2, o[j].w * rs2); o8[64 * j] = w; }
}

__device__ __forceinline__ float dot128(const bf16_t* kp, const LAS float* qs) {
    const u32x4* k4 = (const u32x4*)kp; float s = 0.f;
#pragma unroll 4
    for (int c = 0; c < 16; ++c) { const u32x4 w = k4[c]; const f32x4 a = *(const LAS f32x4*)(qs + 8 * c), b = *(const LAS f32x4*)(qs + 8 * c + 4);
        s += bflo(w.x) * a.x + bfhi(w.x) * a.y + bflo(w.y) * a.z + bfhi(w.y) * a.w + bflo(w.z) * b.x + bfhi(w.z) * b.y + bflo(w.w) * b.z + bfhi(w.w) * b.w; }
    return s;
}
__device__ __forceinline__ void load_q(const bf16_t* q, LAS float* qs, int lane) {
    const unsigned w = *(const unsigned*)(q + 2 * lane);
    LDS_WAIT();
    qs[2 * lane] = bflo(w) * 0.08838834764831845f; qs[2 * lane + 1] = bfhi(w) * 0.08838834764831845f;
    LDS_WAIT();
}
template <class KF>
__device__ __forceinline__ void attn_wave(const KF& kf, int nkeys, const LAS float* qs, LAS float* sc, int lane, float& o0, float& o1, float& mOut, float& denOut) {
    float m = -INFINITY;
    for (int base = 0; base < nkeys; base += 64) {
        const int i = base + lane; float s = -INFINITY;
        if (i < nkeys) { const bf16_t* kp; const bf16_t* vp; float bias; if (kf(i, kp, vp, bias)) s = dot128(kp, qs) + bias; sc[i] = s; }
        m = fmaxf(m, s);
    }
    m = wave_max(m); if (m == -INFINITY) m = 0.f;
    LDS_WAIT();
    float sum = 0.f;
    for (int i = lane; i < nkeys; i += 64) { const float s = sc[i]; const float e = (s == -INFINITY) ? 0.f : __expf(s - m); sc[i] = e; sum += e; }
    sum = wave_sum(sum); const float den = fmaxf(sum, 1e-30f);
    LDS_WAIT();
    float a0 = 0.f, a1 = 0.f;
#pragma unroll 4
    for (int i = 0; i < nkeys; ++i) { const float pr = sc[i]; const bf16_t* kp; const bf16_t* vp; float bias; kf(i, kp, vp, bias);
        const unsigned w = *(const unsigned*)(vp + 2 * lane); a0 += pr * bflo(w); a1 += pr * bfhi(w); }
    o0 = a0 / den; o1 = a1 / den; mOut = m; denOut = den;
}

__device__ __forceinline__ void mem_attn_item(const bf16_t* proj, int ldp, int mqoff, const bf16_t* memkv, int l, bf16_t* cat, int ldc, int memoff, int t, int h, LAS float* qs, LAS float* sc, int lane_) {
    int lane = lane_; asm volatile("" : "+v"(lane));
    const int b = t >> 11;
    load_q(proj + (size_t)t * ldp + mqoff + h * HD, qs, lane);
    const bf16_t* kb = memkv + (size_t)(b * 256) * 4096 + l * 1024 + h * HD;
    auto kf = [&](int i, const bf16_t*& kp, const bf16_t*& vp, float& bias) { kp = kb + (size_t)i * 4096; vp = kp + 512; bias = 0.f; return true; };
    float o0, o1, m, den; attn_wave(kf, 256, qs, sc, lane, o0, o1, m, den);
    *(unsigned*)(cat + (size_t)t * ldc + memoff + h * HD + 2 * lane) = pk2(o0, o1);
}
__device__ __forceinline__ void atta_item(const bf16_t* proj, bf16_t* cat, int t, int j, LAS float* qs, LAS float* sc, int lane_) {
    int lane = lane_; asm volatile("" : "+v"(lane));
    const int b = t >> 11, s = t & 2047;
    float og0[3], og1[3], lse[3];
#pragma unroll
    for (int gi = 0; gi < 3; ++gi) {
        const int d = gi == 0 ? 1 : (gi == 1 ? 4 : 16), hh = gi * 8 + j;
        const float slope = exp2f(-8.0f * (float)(hh + 1) / 24.0f);
        load_q(proj + (size_t)t * A_COLS + hh * HD, qs, lane);
        const bf16_t* kbase = proj + (size_t)(b * SEQ) * A_COLS + 3072 + hh * HD;
        auto kf = [&](int i, const bf16_t*& kp, const bf16_t*& vp, float& bias) { const int sp = s - i * d; const int spc = sp < 0 ? 0 : sp;
            kp = kbase + (size_t)spc * A_COLS; vp = kp + 3072; bias = -slope * (float)(i * d); return sp >= 0; };
        float m, den; attn_wave(kf, 129, qs, sc, lane, og0[gi], og1[gi], m, den);
        lse[gi] = m + __logf(den);
    }
    const float mx = fmaxf(lse[0], fmaxf(lse[1], lse[2]));
    const float e0 = __expf(lse[0] - mx), e1 = __expf(lse[1] - mx), e2 = __expf(lse[2] - mx), inv = 1.0f / (e0 + e1 + e2);
    const float r0 = (e0 * og0[0] + e1 * og0[1] + e2 * og0[2]) * inv, r1 = (e0 * og1[0] + e1 * og1[1] + e2 * og1[2]) * inv;
    *(unsigned*)(cat + (size_t)t * 1536 + j * HD + 2 * lane) = pk2(r0, r1);
}
__device__ __forceinline__ void attb_item(const bf16_t* proj, const bf16_t* kvs, const bf16_t* kc, const bf16_t* vc, bf16_t* cat, int t, int g, LAS float* qs, LAS float* sc, LAS float* pc, LAS int* blk, int lane_) {
    int lane = lane_; asm volatile("" : "+v"(lane));
    const int b = t >> 11, s = t & 2047, cur = s >> 6;
    float oc0[3], oc1[3];
#pragma unroll
    for (int r = 0; r < 3; ++r) {
        const int h = 3 * g + r; const float slope = exp2f(-8.0f * (float)(h + 1) / 12.0f);
        load_q(proj + (size_t)t * B_COLS + h * HD, qs, lane);
        auto kf = [&](int n, const bf16_t*& kp, const bf16_t*& vp, float& bias) { const int cend = 16 * n + 31; const size_t row = (size_t)((b * NCMP + n) * 4 + g);
            kp = kc + row * 256; vp = vc + row * 256; bias = -slope * (float)(s - cend); return s >= cend; };
        float m, den; attn_wave(kf, NCMP, qs, pc + r * 128, lane, oc0[r], oc1[r], m, den);
        const float inv = 1.0f / den;
        for (int i = lane; i < 128; i += 64) pc[r * 128 + i] = (i < NCMP) ? pc[r * 128 + i] * inv : 0.f;
        LDS_WAIT();
    }
    const int jb = lane & 31;
    float imp = 0.f;
#pragma unroll
    for (int r = 0; r < 3; ++r) { const LAS float* P = pc + r * 128; const int n0 = 4 * jb;
        imp += (n0 >= 1 ? 0.5f * P[n0 - 1] : 0.f) + P[n0] + P[n0 + 1] + P[n0 + 2] + 0.5f * P[n0 + 3]; }
    const bool forced = (jb == 0) || (jb == cur) || (jb == cur - 1);
    imp = forced ? 1e4f : (jb > cur ? -1e4f : imp);
    int rank = 0;
    for (int o = 0; o < 32; ++o) { const float v = __shfl(imp, o); rank += (v > imp || (v == imp && o < jb)) ? 1 : 0; }
    const bool sel = (rank < 16) && (jb <= cur);
    const unsigned mask = (unsigned)(__ballot(sel && lane < 32) & 0xffffffffull);
    const int nsel = __popc(mask);
    if (lane < 16) { int cnt = 0, bsel = 0; for (int jj = 0; jj < 32; ++jj) { if ((mask >> jj) & 1u) { if (cnt == lane) bsel = jj; ++cnt; } } blk[lane] = bsel; }
    LDS_WAIT();
#pragma unroll
    for (int r = 0; r < 3; ++r) {
        const int h = 3 * g + r; const float slope = exp2f(-8.0f * (float)(h + 1) / 12.0f);
        load_q(proj + (size_t)t * B_COLS + h * HD, qs, lane);
        const bf16_t* kvb = kvs + (size_t)(b * SEQ) * 3072 + g * HD;
        auto kfs = [&](int i, const bf16_t*& kp, const bf16_t*& vp, float& bias) { const int sp = 64 * blk[i >> 6] + (i & 63);
            kp = kvb + (size_t)sp * 3072 + 2 * 512; vp = kp + 512; bias = -slope * (float)(s - sp); return sp <= s; };
        float os0, os1, m, den; attn_wave(kfs, nsel * 64, qs, sc, lane, os0, os1, m, den);
        auto kfw = [&](int i, const bf16_t*& kp, const bf16_t*& vp, float& bias) { const int sp = s - i; const int spc = sp < 0 ? 0 : sp;
            kp = kvb + (size_t)spc * 3072 + 4 * 512; vp = kp + 512; bias = -slope * (float)i; return sp >= 0; };
        float ow0, ow1; attn_wave(kfw, 512, qs, sc, lane, ow0, ow1, m, den);
        const bf16_t* gp = proj + (size_t)t * B_COLS + 2048 + h * 3;
        const float g0 = 1.0f / (1.0f + __expf(-bflo((unsigned)gp[0]))), g1 = 1.0f / (1.0f + __expf(-bflo((unsigned)gp[1]))), g2 = 1.0f / (1.0f + __expf(-bflo((unsigned)gp[2])));
        const float r0 = g0 * oc0[r] + g1 * os0 + g2 * ow0, r1 = g0 * oc1[r] + g1 * os1 + g2 * ow1;
        *(unsigned*)(cat + (size_t)t * 2048 + h * HD + 2 * lane) = pk2(r0, r1);
    }
}


typedef short s16x4 __attribute__((ext_vector_type(4)));
constexpr int AT_ROWB = 272, AT_TILEB = 64 * AT_ROWB, AT_STAGEB = 2 * AT_TILEB;
constexpr int AT_AUX = 2 * AT_STAGEB;
constexpr float SCALE2 = 0.12751743f;
constexpr float LOG2E = 1.4426950408889634f, LN2 = 0.6931471805599453f;
struct AttnArgs {
    const bf16_t* q; size_t qstride;
    const bf16_t* k; const bf16_t* v; size_t kvstride;
    unsigned tilemask;
    int nkeys, qpos0, kmul, maxdist;
    float slope2;
};
__device__ __forceinline__ void at_gload(const AttnArgs& A, int kt, int tid, u32x4 (&kr)[2], u32x4 (&vr)[2]) {
#pragma unroll
    for (int i = 0; i < 2; ++i) { const int id = tid + 512 * i, row = id >> 4, c16 = id & 15; const size_t off = (size_t)(64 * kt + row) * A.kvstride + 8 * c16;
        kr[i] = *(const u32x4*)(A.k + off); vr[i] = *(const u32x4*)(A.v + off); }
}
__device__ __forceinline__ void at_lstore(LAS unsigned char* st, int tid, const u32x4 (&kr)[2], const u32x4 (&vr)[2]) {
#pragma unroll
    for (int i = 0; i < 2; ++i) { const int id = tid + 512 * i, row = id >> 4, c16 = id & 15;
        *(LAS u32x4*)(st + row * AT_ROWB + c16 * 16) = kr[i]; *(LAS u32x4*)(st + AT_TILEB + row * AT_ROWB + c16 * 16) = vr[i]; }
}
__device__ __forceinline__ bf16x8 pack8(const f32x4& a, const f32x4& b) {
    u32x4 w; w.x = pg8::cvt_pk_bf16(a[0], a[1]); w.y = pg8::cvt_pk_bf16(a[2], a[3]); w.z = pg8::cvt_pk_bf16(b[0], b[1]); w.w = pg8::cvt_pk_bf16(b[2], b[3]);
    return __builtin_bit_cast(bf16x8, w);
}
__device__ __forceinline__ bf16x8 tr_pair(const LAS unsigned char* p0, const LAS unsigned char* p1) {
    const s16x4 lo = __builtin_amdgcn_ds_read_tr16_b64_v4i16((LAS s16x4*)p0), hi = __builtin_amdgcn_ds_read_tr16_b64_v4i16((LAS s16x4*)p1);
    return __builtin_shufflevector(lo, hi, 0, 1, 2, 3, 4, 5, 6, 7);
}
template <bool USE_SEL>
__device__ __forceinline__ void attn_core(LAS unsigned char* lds, const AttnArgs& A, unsigned selmask, int tid, f32x4 (&o)[8], float& m, float& l) {
    const int lane = tid & 63, wave = tid >> 6, fr = lane & 15, fq = lane >> 4, row = wave * 16 + fr, qpos = A.qpos0 + row;
    bf16x8 qf[4];
    { const bf16_t* qp = A.q + (size_t)row * A.qstride + 8 * fq;
#pragma unroll
      for (int dc = 0; dc < 4; ++dc) qf[dc] = *(const bf16x8*)(qp + 32 * dc); }
    m = -INFINITY; l = 0.f;
#pragma unroll
    for (int db = 0; db < 8; ++db) o[db] = (f32x4){0.f, 0.f, 0.f, 0.f};
    unsigned tm = A.tilemask;
    if (tm == 0u) return;
    u32x4 kr[2], vr[2];
    int kt = __builtin_ctz(tm); tm &= tm - 1;
    at_gload(A, kt, tid, kr, vr); at_lstore(lds, tid, kr, vr); __syncthreads();
    int cur = 0;
    for (;;) {
        const bool has_next = tm != 0u; int ktn = 0;
        if (has_next) { ktn = __builtin_ctz(tm); tm &= tm - 1; at_gload(A, ktn, tid, kr, vr); }
        const LAS unsigned char* st = lds + cur * AT_STAGEB;
        f32x4 s[4];
        { const LAS unsigned char* kbase = st + fr * AT_ROWB + fq * 16;
#pragma unroll
          for (int kb = 0; kb < 4; ++kb) { s[kb] = (f32x4){0.f, 0.f, 0.f, 0.f};
#pragma unroll
              for (int dc = 0; dc < 4; ++dc) { const bf16x8 kf = *(const LAS bf16x8*)(kbase + kb * 16 * AT_ROWB + dc * 64); s[kb] = __builtin_amdgcn_mfma_f32_16x16x32_bf16(kf, qf[dc], s[kb], 0, 0, 0); } } }
        float tmax = -INFINITY;
        const bool tsel = USE_SEL ? (((selmask >> kt) & 1u) != 0u) : true;
#pragma unroll
        for (int kb = 0; kb < 4; ++kb)
#pragma unroll
            for (int e = 0; e < 4; ++e) { const int kidx = 64 * kt + 16 * kb + 4 * fq + e, dist = qpos - A.kmul * kidx;
                const bool valid = tsel && (dist >= 0) && (dist <= A.maxdist) && (kidx < A.nkeys);
                const float x = valid ? (s[kb][e] * SCALE2 - A.slope2 * (float)dist) : -INFINITY; s[kb][e] = x; tmax = fmaxf(tmax, x); }
        tmax = fmaxf(tmax, __shfl_xor(tmax, 16)); tmax = fmaxf(tmax, __shfl_xor(tmax, 32));
        const float mnew = fmaxf(m, tmax), muse = (mnew == -INFINITY) ? 0.f : mnew, alpha = __builtin_amdgcn_exp2f(m - muse);
        m = mnew; l *= alpha;
#pragma unroll
        for (int db = 0; db < 8; ++db) o[db] *= alpha;
#pragma unroll
        for (int kb = 0; kb < 4; ++kb)
#pragma unroll
            for (int e = 0; e < 4; ++e) { const float pv = __builtin_amdgcn_exp2f(s[kb][e] - muse); s[kb][e] = pv; l += pv; }
        { const LAS unsigned char* vbase = st + AT_TILEB + (4 * fq + (fr >> 2)) * AT_ROWB + 8 * (fr & 3);
#pragma unroll
          for (int c = 0; c < 2; ++c) { const bf16x8 pf = pack8(s[2 * c], s[2 * c + 1]);
#pragma unroll
              for (int db = 0; db < 8; ++db) { const bf16x8 vf = tr_pair(vbase + c * 32 * AT_ROWB + db * 32, vbase + c * 32 * AT_ROWB + 16 * AT_ROWB + db * 32);
                  o[db] = __builtin_amdgcn_mfma_f32_16x16x32_bf16(vf, pf, o[db], 0, 0, 0); } } }
        if (has_next) at_lstore(lds + (cur ^ 1) * AT_STAGEB, tid, kr, vr);
        __syncthreads();
        if (!has_next) break;
        kt = ktn; cur ^= 1;
    }
    l += __shfl_xor(l, 16); l += __shfl_xor(l, 32);
}
__device__ __forceinline__ void at_store_o(bf16_t* orow, const f32x4 (&o)[8], float inv, int fq) {
#pragma unroll
    for (int db = 0; db < 8; ++db) { u32x2 w; w.x = pg8::cvt_pk_bf16(o[db][0] * inv, o[db][1] * inv); w.y = pg8::cvt_pk_bf16(o[db][2] * inv, o[db][3] * inv); *(u32x2*)(orow + 16 * db + 4 * fq) = w; }
}
__device__ __forceinline__ void mem_attn_wg(LAS unsigned char* lds, const bf16_t* proj, int ldp, int mqoff, const bf16_t* memkv, int l, bf16_t* cat, int ldc, int memoff, int b, int h, int qb, int tid_) {
    int tid = tid_; asm volatile("" : "+v"(tid));
    const int t0 = b * SEQ + qb * 128;
    AttnArgs A; A.q = proj + (size_t)t0 * ldp + mqoff + h * HD; A.qstride = ldp; A.k = memkv + (size_t)(b * 256) * 4096 + l * 1024 + h * HD; A.v = A.k + 512; A.kvstride = 4096;
    A.tilemask = 0xFu; A.nkeys = 256; A.qpos0 = 1 << 20; A.kmul = 0; A.maxdist = 0x7fffffff; A.slope2 = 0.f;
    f32x4 o[8]; float m, lsum; attn_core<false>(lds, A, 0u, tid, o, m, lsum);
    const int lane = tid & 63, row = (tid >> 6) * 16 + (lane & 15);
    at_store_o(cat + (size_t)(t0 + row) * ldc + memoff + h * HD, o, 1.0f / fmaxf(lsum, 1e-30f), lane >> 4);
}
__device__ __forceinline__ void dil_attn_wg(LAS unsigned char* lds, const bf16_t* proj, bf16_t* og, float* lse, int b, int hh, int x, int tid_) {
    int tid = tid_; asm volatile("" : "+v"(tid));
    const int gi = hh >> 3, j = hh & 7, d = gi == 0 ? 1 : (gi == 1 ? 4 : 16), nqb = 16 / d, r = x / nqb, qb = x % nqb, c0 = qb * 128, L = SEQ / d;
    const float slope = exp2f(-8.0f * (float)(hh + 1) / 24.0f);
    AttnArgs A; A.q = proj + (size_t)(b * SEQ + c0 * d + r) * A_COLS + hh * HD; A.qstride = (size_t)d * A_COLS;
    A.k = proj + (size_t)(b * SEQ + r) * A_COLS + 3072 + hh * HD; A.v = A.k + 3072; A.kvstride = (size_t)d * A_COLS;
    const int ktc = c0 >> 6; A.tilemask = (ktc >= 2 ? (0xFu << (ktc - 2)) : 0x3u); A.nkeys = L; A.qpos0 = c0; A.kmul = 1; A.maxdist = 128; A.slope2 = slope * (float)d * LOG2E;
    f32x4 o[8]; float m, lsum; attn_core<false>(lds, A, 0u, tid, o, m, lsum);
    const int lane = tid & 63, fr = lane & 15, fq = lane >> 4, row = (tid >> 6) * 16 + fr;
    const size_t t = (size_t)b * SEQ + (size_t)(c0 + row) * d + r;
    at_store_o(og + ((size_t)gi * NTOK + t) * 1024 + j * HD, o, 1.0f / fmaxf(lsum, 1e-30f), fq);
    if (fq == 0) lse[((size_t)gi * NTOK + t) * 8 + j] = m * LN2 + __logf(fmaxf(lsum, 1e-30f));
}
__device__ __forceinline__ void cmp_sel_wg(LAS unsigned char* lds, const bf16_t* proj, const bf16_t* kc, const bf16_t* vc, bf16_t* ocmp, unsigned* sel, int b, int g, int qb, int tid_) {
    int tid = tid_; asm volatile("" : "+v"(tid));
    const int lane = tid & 63, wave = tid >> 6, fr = lane & 15, fq = lane >> 4, row = wave * 16 + fr, t0 = b * SEQ + qb * 128, spos_ = qb * 128 + row, cur = spos_ >> 6;
#pragma unroll
    for (int i = 0; i < 4; ++i) { const int id = tid + 512 * i, n = id >> 4, c16 = id & 15; const size_t off = ((size_t)(b * NCMP + n) * 4 + g) * 256 + 8 * c16;
        *(LAS u32x4*)(lds + n * AT_ROWB + c16 * 16) = *(const u32x4*)(kc + off); *(LAS u32x4*)(lds + 2 * AT_TILEB + n * AT_ROWB + c16 * 16) = *(const u32x4*)(vc + off); }
    __syncthreads();
    float imp[8];
#pragma unroll
    for (int kb = 0; kb < 8; ++kb) imp[kb] = 0.f;
    for (int r = 0; r < 3; ++r) {
        const int h = 3 * g + r; const float slope2 = exp2f(-8.0f * (float)(h + 1) / 12.0f) * LOG2E;
        int z = 0; asm volatile("" : "+v"(z));
        const int spos = spos_ + z;
        bf16x8 qf[4];
        { const bf16_t* qp = proj + (size_t)(t0 + row) * B_COLS + h * HD + 8 * fq;
#pragma unroll
          for (int dc = 0; dc < 4; ++dc) qf[dc] = *(const bf16x8*)(qp + 32 * dc); }
        f32x4 s[8];
        { const LAS unsigned char* kbase = lds + fr * AT_ROWB + fq * 16 + z;
#pragma unroll
          for (int kb = 0; kb < 8; ++kb) { s[kb] = (f32x4){0.f, 0.f, 0.f, 0.f};
#pragma unroll
              for (int dc = 0; dc < 4; ++dc) { const bf16x8 kf = *(const LAS bf16x8*)(kbase + kb * 16 * AT_ROWB + dc * 64); s[kb] = __builtin_amdgcn_mfma_f32_16x16x32_bf16(kf, qf[dc], s[kb], 0, 0, 0); } } }
        float tmax = -INFINITY;
#pragma unroll
        for (int kb = 0; kb < 8; ++kb)
#pragma unroll
            for (int e = 0; e < 4; ++e) { const int n = 16 * kb + 4 * fq + e, dist = spos - (16 * n + 31); const bool valid = (dist >= 0) && (n < NCMP);
                const float x = valid ? (s[kb][e] * SCALE2 - slope2 * (float)dist) : -INFINITY; s[kb][e] = x; tmax = fmaxf(tmax, x); }
        tmax = fmaxf(tmax, __shfl_xor(tmax, 16)); tmax = fmaxf(tmax, __shfl_xor(tmax, 32));
        const float muse = (tmax == -INFINITY) ? 0.f : tmax;
        float lsum = 0.f;
#pragma unroll
        for (int kb = 0; kb < 8; ++kb)
#pragma unroll
            for (int e = 0; e < 4; ++e) { const float pv = __builtin_amdgcn_exp2f(s[kb][e] - muse); s[kb][e] = pv; lsum += pv; }
        lsum += __shfl_xor(lsum, 16); lsum += __shfl_xor(lsum, 32);
        const float inv = 1.0f / fmaxf(lsum, 1e-30f);
#pragma unroll
        for (int kb = 0; kb < 8; ++kb) s[kb] *= inv;
#pragma unroll
        for (int kb = 0; kb < 8; ++kb) { const float t1 = __shfl(s[kb][3], (lane - 16) & 63); const float t0v = kb > 0 ? __shfl(s[kb > 0 ? kb - 1 : 0][3], (lane - 16) & 63) : 0.f;
            imp[kb] += s[kb][0] + s[kb][1] + s[kb][2] + 0.5f * s[kb][3] + 0.5f * (fq == 0 ? t0v : t1); }
        f32x4 o[8];
#pragma unroll
        for (int db = 0; db < 8; ++db) o[db] = (f32x4){0.f, 0.f, 0.f, 0.f};
        { const LAS unsigned char* vbase = lds + 2 * AT_TILEB + (4 * fq + (fr >> 2)) * AT_ROWB + 8 * (fr & 3);
#pragma unroll
          for (int c = 0; c < 4; ++c) { const bf16x8 pf = pack8(s[2 * c], s[2 * c + 1]);
#pragma unroll
              for (int db = 0; db < 8; ++db) { const bf16x8 vf = tr_pair(vbase + c * 32 * AT_ROWB + db * 32, vbase + c * 32 * AT_ROWB + 16 * AT_ROWB + db * 32);
                  o[db] = __builtin_amdgcn_mfma_f32_16x16x32_bf16(vf, pf, o[db], 0, 0, 0); } } }
        at_store_o(ocmp + (size_t)(t0 + row) * 1536 + h * HD, o, 1.0f, fq);
    }
    LAS float* rk = (LAS float*)(lds + AT_AUX + wave * 2048) + fr * 32;
    float mine[8];
#pragma unroll
    for (int kb = 0; kb < 8; ++kb) { const int j = 4 * kb + fq; const bool forced = (j == 0) || (j == cur) || (j == cur - 1);
        mine[kb] = forced ? 1e4f : (j > cur ? -1e4f : imp[kb]); rk[j] = mine[kb]; }
    LDS_WAIT();
    int rank[8];
#pragma unroll
    for (int kb = 0; kb < 8; ++kb) rank[kb] = 0;
#pragma unroll
    for (int j4 = 0; j4 < 8; ++j4) { const f32x4 v = *(const LAS f32x4*)(rk + 4 * j4);
#pragma unroll
        for (int e = 0; e < 4; ++e) { const int jj = 4 * j4 + e;
#pragma unroll
            for (int kb = 0; kb < 8; ++kb) { const int j = 4 * kb + fq; rank[kb] += (v[e] > mine[kb] || (v[e] == mine[kb] && jj < j)) ? 1 : 0; } } }
    unsigned bits = 0u;
#pragma unroll
    for (int kb = 0; kb < 8; ++kb) { const int j = 4 * kb + fq; if (rank[kb] < 16 && j <= cur) bits |= 1u << j; }
    bits |= __shfl_xor(bits, 16); bits |= __shfl_xor(bits, 32);
    if (fq == 0) sel[(size_t)(t0 + row) * 4 + g] = bits;
    __syncthreads();
}
__device__ __forceinline__ void nsa_attn_wg(LAS unsigned char* lds, const bf16_t* proj, const bf16_t* kvs, const unsigned* sel, const bf16_t* ocmp, bf16_t* cat, int b, int h, int qb, int tid_) {
    int tid = tid_; asm volatile("" : "+v"(tid));
    const int lane = tid & 63, wave = tid >> 6, fr = lane & 15, fq = lane >> 4, row = wave * 16 + fr, g = h / 3, t0 = b * SEQ + qb * 128;
    const float slope2 = exp2f(-8.0f * (float)(h + 1) / 12.0f) * LOG2E;
    const unsigned selmask = sel[(size_t)(t0 + row) * 4 + g];
    unsigned um = selmask;
#pragma unroll
    for (int o_ = 1; o_ < 64; o_ <<= 1) um |= __shfl_xor(um, o_);
    LAS unsigned* wgw = (LAS unsigned*)(lds + AT_AUX + 8 * 2048);
    if (lane == 0) wgw[wave] = um;
    __syncthreads();
    um = wgw[0] | wgw[1] | wgw[2] | wgw[3] | wgw[4] | wgw[5] | wgw[6] | wgw[7];
    um = __builtin_amdgcn_readfirstlane(um);
    AttnArgs A; A.q = proj + (size_t)t0 * B_COLS + h * HD; A.qstride = B_COLS; A.kvstride = 3072; A.nkeys = SEQ; A.qpos0 = qb * 128; A.kmul = 1; A.slope2 = slope2;
    const bf16_t* kvb = kvs + (size_t)(b * SEQ) * 3072 + g * HD;
    A.k = kvb + 2 * 512; A.v = kvb + 3 * 512; A.maxdist = 0x7fffffff; A.tilemask = um & (0xffffffffu >> (31 - (2 * qb + 1)));
    f32x4 os[8]; float m, lsum; attn_core<true>(lds, A, selmask, tid, os, m, lsum);
    { const float inv = 1.0f / fmaxf(lsum, 1e-30f);
#pragma unroll
      for (int db = 0; db < 8; ++db) os[db] *= inv; }
    A.k = kvb + 4 * 512; A.v = kvb + 5 * 512; A.maxdist = 511;
    { const int k0 = 2 * qb - 8 < 0 ? 0 : 2 * qb - 8, k1 = 2 * qb + 1; A.tilemask = (0xffffffffu >> (31 - k1)) & (0xffffffffu << k0); }
    f32x4 ow[8]; attn_core<false>(lds, A, 0u, tid, ow, m, lsum);
    const float invw = 1.0f / fmaxf(lsum, 1e-30f);
    const bf16_t* gp = proj + (size_t)(t0 + row) * B_COLS + 2048 + h * 3;
    const float g0 = 1.0f / (1.0f + __expf(-bflo((unsigned)gp[0]))), g1 = 1.0f / (1.0f + __expf(-bflo((unsigned)gp[1]))), g2 = invw / (1.0f + __expf(-bflo((unsigned)gp[2])));
    bf16_t* orow = cat + (size_t)(t0 + row) * 2048 + h * HD + 4 * fq; const bf16_t* crow = ocmp + (size_t)(t0 + row) * 1536 + h * HD + 4 * fq;
#pragma unroll
    for (int db = 0; db < 8; ++db) { const u32x2 c = *(const u32x2*)(crow + 16 * db);
        const float r0 = g0 * bflo(c.x) + g1 * os[db][0] + g2 * ow[db][0], r1 = g0 * bfhi(c.x) + g1 * os[db][1] + g2 * ow[db][1];
        const float r2 = g0 * bflo(c.y) + g1 * os[db][2] + g2 * ow[db][2], r3 = g0 * bfhi(c.y) + g1 * os[db][3] + g2 * ow[db][3];
        u32x2 w; w.x = pg8::cvt_pk_bf16(r0, r1); w.y = pg8::cvt_pk_bf16(r2, r3); *(u32x2*)(orow + 16 * db) = w; }
}

__device__ __forceinline__ int opq_tid() { int t = threadIdx.x; asm volatile("" : "+v"(t)); return t; }
__global__ void __launch_bounds__(NTHREADS, 2) mega_fwd(Params p) {
    extern __shared__ __attribute__((aligned(16))) unsigned char lds_raw[];
    LAS unsigned char* lds = (LAS unsigned char*)lds_raw;
    cg::grid_group grid = cg::this_grid();
    const int tid = threadIdx.x, lane = tid & 63, wave = __builtin_amdgcn_readfirstlane(tid >> 6);
    const int G = gridDim.x, bid = blockIdx.x;
    volatile LAS unsigned* bst = (volatile LAS unsigned*)(lds + LDS_MAIN);
    if (tid < 2) bst[tid] = 0u;
    __syncthreads();
    const XcdBarrier gbar = xcd_barrier_post((unsigned*)(p.ws + WS_BAR), bst);
    const int gw = bid * NWAVES + wave, ngw = G * NWAVES;
    unsigned char* ws = p.ws;
    float* X = p.out;
    bf16_t* XH = (bf16_t*)(ws + WS_XH); bf16_t* PROJ = (bf16_t*)(ws + WS_PROJ); float* OBUF = (float*)(ws + WS_OBUF);
    bf16_t* CAT = (bf16_t*)(ws + WS_CAT); bf16_t* KVS = (bf16_t*)(ws + WS_KVS); bf16_t* MEMKV = (bf16_t*)(ws + WS_MEMKV); bf16_t* MEMHAT = (bf16_t*)(ws + WS_MEMHAT);
    bf16_t* OG = (bf16_t*)(ws + WS_KVS); float* LSE = (float*)(ws + WS_HID); unsigned* SEL = (unsigned*)(ws + WS_SEL);
    bf16_t* OCMP = (bf16_t*)(ws + WS_OBUF);
    bf16_t* HID = (bf16_t*)(ws + WS_HID); bf16_t* KCV = (bf16_t*)(ws + WS_KCV); bf16_t* BLK = (bf16_t*)(ws + WS_OBUF);
    LAS float* wscr = (LAS float*)(lds + wave * 16384);
    LAS float* qs = wscr; LAS float* sc = wscr + 128; LAS float* pc = wscr + 128 + 1024; LAS int* blk = (LAS int*)(wscr + 128 + 1024 + 384);

    for (int rep_ = 0; rep_ < REP_P0; ++rep_) {
        ConvJob J;
        for (int j = 0; conv_get(p, j, J); ++j) conv_run(J, wscr, gw, ngw, lane);
        for (int m = gw; m < 1024; m += ngw) rms_row(p.in[I_MEM] + (size_t)m * 2048, MEMHAT + (size_t)m * 2048, nullptr, lane);
        for (int m = gw; m < NTOK; m += ngw) rms_row(p.in[I_X] + (size_t)m * 2048, XH + (size_t)m * 2048, X + (size_t)m * 2048, lane);
    }
    for (int rs_ = 0; rs_ < REP_SYNC; ++rs_) grid.sync();

    for (int l = 0; l < 4; ++l) {
        const bool isA = l < 2;
        for (int jb = 0; jb < 3; ++jb) {
            pg8::Gemm g; bf16_t* O; int ldc; int c = bid;
            if (jb == 0) { g.A = XH; g.M = NTOK; g.K = 2048;
                if (isA) { g.Bt = (const bf16_t*)(ws + WS_WAIN + l * SZ_WAIN); g.N = A_COLS; O = PROJ; ldc = A_COLS; }
                else { g.Bt = (const bf16_t*)(ws + WS_WBIN + (l - 2) * SZ_WBIN); g.N = B_COLS; O = PROJ; ldc = B_COLS; } }
            else if (jb == 1) { if (l != 0) continue; g.A = MEMHAT; g.Bt = (const bf16_t*)(ws + WS_WMEM); g.M = 1024; g.N = 4096; g.K = 2048; O = MEMKV; ldc = 4096; c = (bid + 64) % G; }
            else { if (l != 2) continue; g.A = XH; g.Bt = (const bf16_t*)(ws + WS_WKV); g.M = NTOK; g.N = 3072; g.K = 2048; O = KVS; ldc = 3072; }
            pg8::StaticOrder S; S.init(g.M, g.N, G, c);
            pg8::EpiBf16<0> E{O, ldc};
            for (int rep_ = 0; rep_ < REP_GEMM; ++rep_) pg8::gemm_phase(lds, g, S, E);
        }
        for (int rs_ = 0; rs_ < REP_SYNC; ++rs_) xcd_barrier(gbar);
        if (l == 2) {
            const int lane = opq_tid() & 63;
            for (int it = gw; it < 2 * 2048; it += ngw) {
                const int w = it >> 11, row = it & 2047; bf16_t* dst = BLK + ((size_t)w * 2048 + row) * 4096;
                if (row < NBATCH * NCMP * 4) { const int gg = row & 3, bn = row >> 2, bb = bn / NCMP, n = bn % NCMP;
                    const bf16_t* src = KVS + (size_t)(bb * SEQ + 16 * n) * 3072 + w * 512 + gg * HD; const float* pe = p.in[I_PE] + w * 32 * HD;
                    for (int ll = 0; ll < 32; ++ll) { const unsigned v = *(const unsigned*)(src + (size_t)ll * 3072 + 2 * lane); const f32x2 e = *(const f32x2*)(pe + ll * HD + 2 * lane);
                        *(unsigned*)(dst + ll * HD + 2 * lane) = pk2(bflo(v) + e.x, bfhi(v) + e.y); } }
                else { for (int ll = 0; ll < 32; ++ll) *(unsigned*)(dst + ll * HD + 2 * lane) = 0u; }
            }
            for (int rs_ = 0; rs_ < REP_SYNC; ++rs_) xcd_barrier(gbar);
            for (int w = 0; w < 2; ++w) { pg8::Gemm g{BLK + (size_t)w * 2048 * 4096, (const bf16_t*)(ws + WS_WC1 + w * SZ_WC1), 2048, 512, 4096};
                pg8::StaticOrder S; S.init(2048, 512, G, (bid + 128 * w) % G); pg8::EpiBf16<1> E{HID + (size_t)w * 2048 * 512, 512}; for (int rep_ = 0; rep_ < REP_GEMM; ++rep_) pg8::gemm_phase(lds, g, S, E); }
            for (int rs_ = 0; rs_ < REP_SYNC; ++rs_) xcd_barrier(gbar);
            for (int w = 0; w < 2; ++w) { pg8::Gemm g{HID + (size_t)w * 2048 * 512, (const bf16_t*)(ws + WS_WC2 + w * SZ_WC2), 2048, 256, 512};
                pg8::StaticOrder S; S.init(2048, 256, G, (bid + 128 * w) % G); pg8::EpiBf16<0> E{KCV + (size_t)w * 2048 * 256, 256}; for (int rep_ = 0; rep_ < REP_GEMM; ++rep_) pg8::gemm_phase(lds, g, S, E); }
            for (int rs_ = 0; rs_ < REP_SYNC; ++rs_) xcd_barrier(gbar);
        }
        if (isA) {
            for (int rep_ = 0; rep_ < REP_ATT; ++rep_)
            for (int it = bid; it < 1792; it += G) {
                if (it < 1536) { const int x = it & 15, bh = it >> 4; dil_attn_wg(lds, PROJ, OG, LSE, bh / 24, bh % 24, x, opq_tid()); }
                else { const int u = it - 1536; mem_attn_wg(lds, PROJ, A_COLS, 9216, MEMKV, l, CAT, 1536, 1024, u >> 6, (u >> 4) & 3, u & 15, opq_tid()); }
            }
            for (int rs_ = 0; rs_ < REP_SYNC; ++rs_) xcd_barrier(gbar);
            for (int rep_ = 0; rep_ < REP_ATT; ++rep_)
            for (int it = bid * NTHREADS + opq_tid(); it < NTOK * 8 * 16; it += G * NTHREADS) { const int c8 = it & 15, tj = it >> 4;
                const float l0 = LSE[tj], l1 = LSE[(size_t)NTOK * 8 + tj], l2 = LSE[(size_t)2 * NTOK * 8 + tj], mx = fmaxf(l0, fmaxf(l1, l2));
                float e0 = __expf(l0 - mx), e1 = __expf(l1 - mx), e2 = __expf(l2 - mx); const float inv = 1.0f / (e0 + e1 + e2); e0 *= inv; e1 *= inv; e2 *= inv;
                const u32x4 a = *(const u32x4*)(OG + (size_t)tj * 128 + 8 * c8), bq = *(const u32x4*)(OG + ((size_t)NTOK * 8 + tj) * 128 + 8 * c8), cq = *(const u32x4*)(OG + ((size_t)2 * NTOK * 8 + tj) * 128 + 8 * c8);
                u32x4 w;
                w.x = pk2(e0 * bflo(a.x) + e1 * bflo(bq.x) + e2 * bflo(cq.x), e0 * bfhi(a.x) + e1 * bfhi(bq.x) + e2 * bfhi(cq.x));
                w.y = pk2(e0 * bflo(a.y) + e1 * bflo(bq.y) + e2 * bflo(cq.y), e0 * bfhi(a.y) + e1 * bfhi(bq.y) + e2 * bfhi(cq.y));
                w.z = pk2(e0 * bflo(a.z) + e1 * bflo(bq.z) + e2 * bflo(cq.z), e0 * bfhi(a.z) + e1 * bfhi(bq.z) + e2 * bfhi(cq.z));
                w.w = pk2(e0 * bflo(a.w) + e1 * bflo(bq.w) + e2 * bflo(cq.w), e0 * bfhi(a.w) + e1 * bfhi(bq.w) + e2 * bfhi(cq.w));
                const int t = tj >> 3, j = tj & 7;
                *(u32x4*)(CAT + (size_t)t * 1536 + j * HD + 8 * c8) = w; }
        } else {
            for (int rep_ = 0; rep_ < REP_ATT; ++rep_)
            for (int it = bid; it < 256; it += G) cmp_sel_wg(lds, PROJ, KCV, KCV + (size_t)2048 * 256, OCMP, SEL, it >> 6, (it >> 4) & 3, it & 15, opq_tid());
            for (int rs_ = 0; rs_ < REP_SYNC; ++rs_) xcd_barrier(gbar);
            for (int rep_ = 0; rep_ < REP_ATT; ++rep_)
            for (int kq = bid; kq < 1024; kq += G) {
                const int rnd = kq >> 8, pos = kq & 255, it = rnd * 256 + ((rnd & 1) ? (255 - pos) : pos);
                if (it < 768) { const int qb = 15 - it / 48, bh = it % 48; nsa_attn_wg(lds, PROJ, KVS, SEL, OCMP, CAT, bh / 12, bh % 12, qb, opq_tid()); }
                else { const int u = it - 768; mem_attn_wg(lds, PROJ, B_COLS, 1536, MEMKV, l, CAT, 2048, 1536, u >> 6, (u >> 4) & 3, u & 15, opq_tid()); }
            }
        }
        for (int rs_ = 0; rs_ < REP_SYNC; ++rs_) xcd_barrier(gbar);
        for (int hf = 0; hf < 2; ++hf) {
            if (hf == 1) { pg8::Gemm g{XH, (const bf16_t*)(ws + WS_WGU + l * SZ_WGU), NTOK, 11264, 2048}; pg8::StaticOrder S; S.init(NTOK, 11264, G, bid);
                pg8::EpiSwiGLU E{PROJ, DFF}; for (int rep_ = 0; rep_ < REP_GEMM; ++rep_) pg8::gemm_phase(lds, g, S, E); for (int rs_ = 0; rs_ < REP_SYNC; ++rs_) xcd_barrier(gbar); }
            { pg8::Gemm g; g.M = NTOK; g.N = 2048;
              if (hf == 0) { g.A = CAT; g.K = isA ? 1536 : 2048; g.Bt = isA ? (const bf16_t*)(ws + WS_WAOUT + l * SZ_WAOUT) : (const bf16_t*)(ws + WS_WBOUT + (l - 2) * SZ_WBOUT); }
              else { g.A = PROJ; g.K = DFF; g.Bt = (const bf16_t*)(ws + WS_WDOWN + l * SZ_WDOWN); }
              pg8::StaticOrder S; S.init(NTOK, 2048, G, bid); pg8::EpiF32 E{OBUF, 2048}; for (int rep_ = 0; rep_ < REP_GEMM; ++rep_) pg8::gemm_phase(lds, g, S, E); }
            for (int rs_ = 0; rs_ < REP_SYNC; ++rs_) xcd_barrier(gbar);
            const float* gain = p.in[I_NORMG] + (l * 5 + (hf == 0 ? 1 : 3)) * 2048;
            for (int m = gw; m < NTOK; m += ngw) rowop_row(X + (size_t)m * 2048, OBUF + (size_t)m * 2048, gain, XH + (size_t)m * 2048, opq_tid() & 63);
            for (int rs_ = 0; rs_ < REP_SYNC; ++rs_) xcd_barrier(gbar);
        }
    }
}

extern "C" void kernel_launch(void* const* d_in, const int* in_sizes, int n_in, void* d_out, int out_size, void* d_ws, size_t ws_size, hipStream_t stream) {
    static int grid_blocks = 0;
    if (grid_blocks == 0) {
        if (n_in != 17 || ws_size < WS_END) { fprintf(stderr, "kernel_launch: unexpected n_in %d or ws_size %zu (< %zu)\n", n_in, ws_size, (size_t)WS_END); grid_blocks = -1; return; }
        int dev = 0, cus = 0, per_cu = 0;
        hipGetDevice(&dev);
        hipDeviceGetAttribute(&cus, hipDeviceAttributeMultiprocessorCount, dev);
        hipFuncSetAttribute((const void*)mega_fwd, hipFuncAttributeMaxDynamicSharedMemorySize, LDS_BYTES);
        hipOccupancyMaxActiveBlocksPerMultiprocessor(&per_cu, (const void*)mega_fwd, NTHREADS, LDS_BYTES);
        if (per_cu < 1) per_cu = 1;
        if (per_cu > 1) per_cu = 1;
        grid_blocks = cus * per_cu;
        (void)hipGetLastError();
    }
    if (grid_blocks < 0) return;
    static Params p;
    memset(&p, 0, sizeof(p));
    for (int i = 0; i < 17; ++i) p.in[i] = (const float*)d_in[i];
    p.out = (float*)d_out; p.ws = (unsigned char*)d_ws;
    {
        int n = 0;
        auto add = [&](int in_idx, size_t in_off, int gain_idx, int gain_off, size_t dst_off, int ldw, int col0, int ncols, int K, int nrows, int mode) {
            JobDesc& d = p.jobs[n++]; d.in_idx = in_idx; d.in_off = in_off; d.gain_idx = gain_idx; d.gain_off = gain_off; d.dst_off = dst_off; d.ldw = ldw; d.col0 = col0; d.ncols = ncols; d.K = K; d.nrows = nrows; d.mode = mode; d.pad = 0; };
        for (int l = 0; l < 4; ++l) add(I_WGU, (size_t)l * 2048 * 11264, I_NORMG, (l * 5 + 2) * 2048, WS_WGU + l * SZ_WGU, 11264, 0, 11264, 2048, 11264, 1);
        for (int l = 0; l < 4; ++l) add(I_WDOWN, (size_t)l * 5632 * 2048, -1, 0, WS_WDOWN + l * SZ_WDOWN, 2048, 0, 2048, 5632, 2048, 0);
        for (int l = 0; l < 2; ++l) add(I_AWIN, (size_t)l * 2048 * A_COLS, I_NORMG, (l * 5 + 0) * 2048, WS_WAIN + l * SZ_WAIN, A_COLS, 0, A_COLS, 2048, A_COLS, 0);
        for (int l = 0; l < 2; ++l) add(I_AWOUT, (size_t)l * 1536 * 2048, -1, 0, WS_WAOUT + l * SZ_WAOUT, 2048, 0, 2048, 1536, 2048, 0);
        for (int lb = 0; lb < 2; ++lb) {
            const size_t src = (size_t)lb * 2048 * B_COLS_SRC, dst = WS_WBIN + lb * SZ_WBIN; const int go = ((2 + lb) * 5 + 0) * 2048;
            add(I_BWIN, src, I_NORMG, go, dst, B_COLS_SRC, 0, 1536, 2048, 1536, 0);
            add(I_BWIN, src, I_NORMG, go, dst + (size_t)1536 * 2048 * 2, B_COLS_SRC, 1572, 512, 2048, 512, 0);
            add(I_BWIN, src, I_NORMG, go, dst + (size_t)2048 * 2048 * 2, B_COLS_SRC, 1536, 36, 2048, 256, 0);
        }
        for (int lb = 0; lb < 2; ++lb) add(I_BWOUT, (size_t)lb * 2048 * 2048, -1, 0, WS_WBOUT + lb * SZ_WBOUT, 2048, 0, 2048, 2048, 2048, 0);
        for (int l = 0; l < 4; ++l) add(I_MEMWKV, (size_t)l * 2048 * 1024, I_NORMG, (l * 5 + 4) * 2048, WS_WMEM + (size_t)l * 1024 * 2048 * 2, 1024, 0, 1024, 2048, 1024, 0);
        add(I_KVW, 0, I_KVNG, 0, WS_WKV, 3072, 0, 3072, 2048, 3072, 0);
        add(I_WK1, 0, -1, 0, WS_WC1, 512, 0, 512, 4096, 512, 0);
        add(I_WV1, 0, -1, 0, WS_WC1 + SZ_WC1, 512, 0, 512, 4096, 512, 0);
        add(I_WK2, 0, -1, 0, WS_WC2, 128, 0, 128, 512, 256, 0);
        add(I_WV2, 0, -1, 0, WS_WC2 + SZ_WC2, 128, 0, 128, 512, 256, 0);
        p.njobs = n;
    }
    (void)hipMemsetAsync((char*)d_ws + WS_BAR, 0, WS_BAR_BYTES, stream);
    void* args[] = {&p};
    hipError_t e = hipLaunchCooperativeKernel((const void*)mega_fwd, dim3(grid_blocks), dim3(NTHREADS), args, LDS_BYTES, stream);
    if (e != hipSuccess) fprintf(stderr, "cooperative launch failed: %s (grid %d)\n", hipGetErrorString(e), grid_blocks);
}
```

```cpp
#include <hip/hip_runtime.h>
#include <hip/hip_cooperative_groups.h>
#include <cstdio>
#include <cstring>
namespace cg = cooperative_groups;
#define REP_P0 1
#define REP_GEMM 1
#define REP_ATT 1
#define REP_ATTA 1
#define REP_B1 1
#define REP_B2 1
#define REP_SYNC 1

#define LAS __attribute__((address_space(3)))
typedef unsigned short bf16_t;
typedef short bf16x8 __attribute__((ext_vector_type(8)));
typedef float f32x4 __attribute__((ext_vector_type(4)));
typedef float f32x2 __attribute__((ext_vector_type(2)));
typedef unsigned u32x4 __attribute__((ext_vector_type(4)));
typedef unsigned u32x2 __attribute__((ext_vector_type(2)));
typedef __bf16 bf16x2_t __attribute__((ext_vector_type(2)));

constexpr int D_MODEL = 2048, NTOK = 8192, SEQ = 2048, NBATCH = 4, DFF = 5632, HD = 128;
constexpr int A_COLS = 9728, B_COLS_SRC = 2084, B_COLS = 2304, NCMP = 127;
constexpr int NWAVES = 8, NTHREADS = 512;
constexpr int LDS_MAIN = 131072; constexpr int LDS_BYTES = LDS_MAIN + 64;

constexpr size_t SZ_WAIN = (size_t)A_COLS * 2048 * 2, SZ_WAOUT = (size_t)2048 * 1536 * 2, SZ_WBIN = (size_t)B_COLS * 2048 * 2, SZ_WBOUT = (size_t)2048 * 2048 * 2;
constexpr size_t SZ_WGU = (size_t)11264 * 2048 * 2, SZ_WDOWN = (size_t)2048 * 5632 * 2, SZ_WC1 = (size_t)512 * 4096 * 2, SZ_WC2 = (size_t)256 * 512 * 2;
constexpr size_t WS_WAIN = 0;
constexpr size_t WS_WAOUT = WS_WAIN + 2 * SZ_WAIN;
constexpr size_t WS_WBIN = WS_WAOUT + 2 * SZ_WAOUT;
constexpr size_t WS_WBOUT = WS_WBIN + 2 * SZ_WBIN;
constexpr size_t WS_WMEM = WS_WBOUT + 2 * SZ_WBOUT;
constexpr size_t WS_WGU = WS_WMEM + (size_t)4096 * 2048 * 2;
constexpr size_t WS_WDOWN = WS_WGU + 4 * SZ_WGU;
constexpr size_t WS_WKV = WS_WDOWN + 4 * SZ_WDOWN;
constexpr size_t WS_WC1 = WS_WKV + (size_t)3072 * 2048 * 2;
constexpr size_t WS_WC2 = WS_WC1 + 2 * SZ_WC1;
constexpr size_t WS_PROJ = WS_WC2 + 2 * SZ_WC2;
constexpr size_t WS_OBUF = WS_PROJ + (size_t)NTOK * A_COLS * 2;
constexpr size_t WS_XH = WS_OBUF + (size_t)NTOK * 2048 * 4;
constexpr size_t WS_CAT = WS_XH + (size_t)NTOK * 2048 * 2;
constexpr size_t WS_KVS = WS_CAT + (size_t)NTOK * 2048 * 2;
constexpr size_t WS_MEMKV = WS_KVS + (size_t)NTOK * 3072 * 2;
constexpr size_t WS_MEMHAT = WS_MEMKV + (size_t)1024 * 4096 * 2;
constexpr size_t WS_HID = WS_MEMHAT + (size_t)1024 * 2048 * 2;
constexpr size_t WS_KCV = WS_HID + (size_t)2 * 2048 * 512 * 2;
constexpr size_t WS_SEL = WS_KCV + (size_t)2 * 2048 * 256 * 2;
constexpr size_t WS_BAR = WS_SEL + (size_t)NTOK * 4 * 4;
constexpr size_t WS_BAR_BYTES = 16384;
constexpr size_t WS_END = WS_BAR + WS_BAR_BYTES;

#define LDS_WAIT() asm volatile("s_waitcnt lgkmcnt(0)" ::: "memory")
__device__ __forceinline__ unsigned f2bf(float f) { unsigned u = __builtin_bit_cast(unsigned, f); return (u + 0x7fffu + ((u >> 16) & 1u)) >> 16; }
__device__ __forceinline__ unsigned pk2(float lo, float hi) { const f32x2 v = {lo, hi}; return __builtin_bit_cast(unsigned, __builtin_convertvector(v, bf16x2_t)); }
__device__ __forceinline__ float bflo(unsigned w) { return __builtin_bit_cast(float, w << 16); }
__device__ __forceinline__ float bfhi(unsigned w) { return __builtin_bit_cast(float, w & 0xffff0000u); }
__device__ __forceinline__ float wave_sum(float v) {
#pragma unroll
    for (int o = 1; o < 64; o <<= 1) v += __shfl_xor(v, o);
    return v;
}
__device__ __forceinline__ float wave_max(float v) {
#pragma unroll
    for (int o = 1; o < 64; o <<= 1) v = fmaxf(v, __shfl_xor(v, o));
    return v;
}


#define XB_TMO      128
#define XB_XCNT(j)  (256  + 64 * (j))
#define XB_XSUB(j)  (1280 + 64 * (j))
#define XB_XGEN(j)  (2304 + 64 * (j))
#define XB_TOP      3328
#define XB_TOPGEN   3392
#define XCD_BAR_WORDS 3456
#define XB_SPIN_CAP (1u << 18)
__device__ __forceinline__ unsigned xb_ld(unsigned* p)              { return __hip_atomic_load(p, __ATOMIC_RELAXED, __HIP_MEMORY_SCOPE_AGENT); }
__device__ __forceinline__ unsigned xb_add(unsigned* p, unsigned v) { return __hip_atomic_fetch_add(p, v, __ATOMIC_RELAXED, __HIP_MEMORY_SCOPE_AGENT); }
__device__ __forceinline__ unsigned xb_xcc_id() { return (unsigned)__builtin_amdgcn_s_getreg((3 << 11) | 20) & 0xFu; }
#define XB_SPIN(cond, bar) do { unsigned _sp = 0; while (cond) { __builtin_amdgcn_s_sleep(1); \
    if ((++_sp & 255u) == 0u) { if (xb_ld(&(bar)[XB_TMO])) break; if (_sp > XB_SPIN_CAP) { atomicAdd(&(bar)[XB_TMO], 1u); break; } } } } while (0)
struct XcdBarrier { unsigned* bar; unsigned x; volatile LAS unsigned* st; };
__device__ __forceinline__ XcdBarrier xcd_barrier_post(unsigned* bar, volatile LAS unsigned* st) {
    XcdBarrier b; b.bar = bar; b.x = xb_xcc_id(); b.st = st;
    if (threadIdx.x == 0) (void)xb_add(&bar[XB_XCNT(b.x)], 1u);
    return b;
}
__device__ __forceinline__ void xcd_barrier_complete(unsigned* bar, unsigned x, unsigned& nloc, unsigned& nx) {
    const unsigned G = gridDim.x * gridDim.y * gridDim.z;
    unsigned sum, cnt, mine, sp = 0u;
    for (;;) {
        sum = 0u; cnt = 0u; mine = 0u;
#pragma unroll
        for (unsigned j = 0; j < 16; ++j) { const unsigned c = xb_ld(&bar[XB_XCNT(j)]); sum += c; cnt += (c > 0u) ? 1u : 0u; mine = (j == x) ? c : mine; }
        if (sum == G) break;
        __builtin_amdgcn_s_sleep(1);
        if ((++sp & 255u) == 0u) { if (xb_ld(&bar[XB_TMO])) break; if (sp > XB_SPIN_CAP) { atomicAdd(&bar[XB_TMO], 1u); break; } }
    }
    nloc = mine > 0u ? mine : 1u; nx = cnt > 0u ? cnt : 1u;
}
__device__ __forceinline__ void xcd_barrier(const XcdBarrier& b) {
    asm volatile("s_waitcnt vmcnt(0)" ::: "memory");
    __syncthreads();
    if (threadIdx.x == 0) {
        unsigned* bar = b.bar;
        __builtin_amdgcn_s_waitcnt(0);
        unsigned nloc = b.st[0], nx = b.st[1];
        if (nloc == 0u) { xcd_barrier_complete(bar, b.x, nloc, nx); b.st[0] = nloc; b.st[1] = nx; }
        const unsigned old = xb_add(&bar[XB_XSUB(b.x)], 1u);
        const unsigned gen = old / nloc;
        if (old + 1u == (gen + 1u) * nloc) {
            __builtin_amdgcn_fence(__ATOMIC_RELEASE, "agent");
            asm volatile("s_waitcnt vmcnt(0)" ::: "memory");
            const unsigned og = xb_add(&bar[XB_TOP], 1u);
            const unsigned tg = og / nx;
            if (og + 1u == (tg + 1u) * nx) xb_add(&bar[XB_TOPGEN], 1u);
            else XB_SPIN(xb_ld(&bar[XB_TOPGEN]) == tg, bar);
            __builtin_amdgcn_fence(__ATOMIC_ACQUIRE, "agent");
            xb_add(&bar[XB_XGEN(b.x)], 1u);
            asm volatile("s_waitcnt vmcnt(0)" ::: "memory");
        } else {
            XB_SPIN(xb_ld(&bar[XB_XGEN(b.x)]) == gen, bar);
            __builtin_amdgcn_fence(__ATOMIC_ACQUIRE, "agent");
            asm volatile("s_waitcnt vmcnt(0)" ::: "memory");
        }
    }
    __syncthreads();
}

namespace pg8 {
constexpr int BM = 256, BK = 64, HALF = 128, HTB = HALF * BK * 2, STAGE_BYTES = 8 * HTB, NXCD = 8, WGM = 8;
__device__ __forceinline__ int lds_byte(int r, int c) { const int st = (r >> 4) * 2 + (c >> 5), rr = r & 15, cc = c & 31, ob = rr * 64 + cc * 2; return st * 1024 + (ob ^ (((ob >> 9) & 1) << 5)); }
__device__ __forceinline__ void stage_rc(int b, int& R, int& C) { const int st = b / 1024, sb = b % 1024, swz = sb ^ (((sb >> 9) & 1) << 5); R = (st >> 1) * 16 + swz / 64; C = (st & 1) * 32 + (swz % 64) / 2; }
__device__ __forceinline__ int perm32(int rho) { const int n = rho >> 4, i = rho & 15; return 8 * (i >> 2) + 4 * n + (i & 3); }
struct Unit { int pm, pn; };
struct Gemm { const bf16_t* A; const bf16_t* Bt; int M, N, K; };
struct StaticOrder {
    int nM, nN, nwg, G, c;
    __device__ void init(int M, int N, int G_, int c_) { nM = M / BM; nN = N / BM; nwg = nM * nN; G = G_; c = c_; }
    __device__ bool next(int i, Unit& u) const {
        const long L = (long)i * G + c; if (L >= nwg) return false;
        int wgid = (int)L; { const int q = nwg / NXCD, r = nwg % NXCD, xcd = wgid % NXCD, off = wgid / NXCD; wgid = (xcd < r ? xcd * (q + 1) : r * (q + 1) + (xcd - r) * q) + off; }
        const int nig = WGM * nN, gid = wgid / nig, fm = gid * WGM, gsz = (nM - fm) < WGM ? (nM - fm) : WGM;
        u.pm = fm + ((wgid % nig) % gsz); u.pn = (wgid % nig) / gsz; return true;
    }
    __device__ __forceinline__ void a_ready(const Unit&) const {}
    __device__ __forceinline__ void done(const Unit&) const {}
};
__device__ __forceinline__ unsigned cvt_pk_bf16(float lo, float hi) { const f32x2 v = {lo, hi}; return __builtin_bit_cast(unsigned, __builtin_convertvector(v, bf16x2_t)); }

struct EpiF32 {
    static constexpr bool PERM = false;
    float* C; int ldc;
    __device__ __forceinline__ void operator()(const f32x4 (&acc)[2][2][4][2], const Unit& u, int wr, int wc, int fr, int fq) const {
        const int row0 = u.pm * BM + wr * 64 + fr, col0 = u.pn * BM + wc * 32 + 4 * fq;
#pragma unroll
        for (int ai = 0; ai < 2; ++ai)
#pragma unroll
            for (int m = 0; m < 4; ++m) { float* rowp = C + (size_t)(row0 + ai * HALF + m * 16) * ldc + col0;
#pragma unroll
                for (int bj = 0; bj < 2; ++bj)
#pragma unroll
                    for (int n = 0; n < 2; ++n) *(f32x4*)(rowp + bj * HALF + n * 16) = acc[ai][bj][m][n]; }
    }
};
__device__ __forceinline__ float gelu_tanh(float x) { const float t = 1.5957691216f * (x + 0.044715f * x * x * x); return x / (1.0f + __expf(-t)); }
template <int ACT  > struct EpiBf16 {
    static constexpr bool PERM = true;
    bf16_t* O; int ldc;
    int hm_heads, seq_shift;
    __device__ __forceinline__ void operator()(const f32x4 (&acc)[2][2][4][2], const Unit& u, int wr, int wc, int fr, int fq) const {
        const int row0 = u.pm * BM + wr * 64 + fr, col0 = u.pn * BM + wc * 32 + 8 * fq;
#pragma unroll
        for (int ai = 0; ai < 2; ++ai)
#pragma unroll
            for (int m = 0; m < 4; ++m) { const int row = row0 + ai * HALF + m * 16;
#pragma unroll
                for (int bj = 0; bj < 2; ++bj) { f32x4 v0 = acc[ai][bj][m][0], v1 = acc[ai][bj][m][1];
                    if (ACT == 1) {
#pragma unroll
                        for (int j = 0; j < 4; ++j) { v0[j] = gelu_tanh(v0[j]); v1[j] = gelu_tanh(v1[j]); } }
                    u32x4 w; w.x = cvt_pk_bf16(v0[0], v0[1]); w.y = cvt_pk_bf16(v0[2], v0[3]); w.z = cvt_pk_bf16(v1[0], v1[1]); w.w = cvt_pk_bf16(v1[2], v1[3]);
                    bf16_t* dst;
                    if (hm_heads > 0) { const int col = col0 + bj * HALF, b = row >> seq_shift, sq = row & ((1 << seq_shift) - 1);
                        dst = O + ((((size_t)(b * hm_heads + (col >> 7))) << seq_shift) + sq) * 128 + (col & 127); }
                    else dst = O + (size_t)row * ldc + col0 + bj * HALF;
                    *(u32x4*)dst = w; } }
    }
};
struct EpiSwiGLU {
    static constexpr bool PERM = true;
    bf16_t* O; int ldc;
    __device__ __forceinline__ void operator()(const f32x4 (&acc)[2][2][4][2], const Unit& u, int wr, int wc, int fr, int fq) const {
        const int row0 = u.pm * BM + wr * 64 + fr, col0 = u.pn * HALF + wc * 32 + 8 * fq;
#pragma unroll
        for (int ai = 0; ai < 2; ++ai)
#pragma unroll
            for (int m = 0; m < 4; ++m) { bf16_t* rowp = O + (size_t)(row0 + ai * HALF + m * 16) * ldc + col0;
                f32x4 v0, v1;
#pragma unroll
                for (int j = 0; j < 4; ++j) { const float g0 = acc[ai][0][m][0][j], g1 = acc[ai][0][m][1][j];
                    v0[j] = g0 / (1.0f + __expf(-g0)) * acc[ai][1][m][0][j]; v1[j] = g1 / (1.0f + __expf(-g1)) * acc[ai][1][m][1][j]; }
                u32x4 w; w.x = cvt_pk_bf16(v0[0], v0[1]); w.y = cvt_pk_bf16(v0[2], v0[3]); w.z = cvt_pk_bf16(v1[0], v1[1]); w.w = cvt_pk_bf16(v1[2], v1[3]);
                *(u32x4*)rowp = w; }
    }
};

template <class Epi, class Sched>
__device__ __forceinline__ void gemm_phase(LAS unsigned char* lds, const Gemm g, const Sched& S, const Epi& E) {
    int tid_ = threadIdx.x; asm volatile("" : "+v"(tid_));
    const int tid = tid_, wid = __builtin_amdgcn_readfirstlane(tid >> 6), lane = tid & 63, wr = wid >> 2, wc = wid & 3, fr = lane & 15, fq = lane >> 4;
    const int K = g.K, nt = K / BK;
    unsigned voffA[2], voffB[2];
#pragma unroll
    for (int i = 0; i < 2; ++i) { int R, C; stage_rc(tid * 16 + i * 8192, R, C); const int Rb = Epi::PERM ? ((R & ~31) + perm32(R & 31)) : R;
        voffA[i] = (unsigned)(R * K + C) * 2u; voffB[i] = (unsigned)(Rb * K + C) * 2u; }
    const size_t kstep = (size_t)(BK * 2);
    const size_t hstep = (size_t)HALF * K * 2;
    const size_t tstep = 2 * hstep;
    const unsigned ldsw = (unsigned)wid * 1024u;
    const int aoff = lds_byte(wr * 64 + fr, fq * 8), boff = lds_byte(wc * 32 + fr, fq * 8);
#define PG8_SA(b, h) (((b) * 2 + (h)) * HTB)
#define PG8_SB(b, h) ((4 + (b) * 2 + (h)) * HTB)
#define PG8_STAGE(bufoff, gbase, voff) do { _Pragma("unroll") for (int _i = 0; _i < 2; ++_i) \
        __builtin_amdgcn_global_load_lds((const unsigned*)((const char*)(gbase) + (voff)[_i]), (LAS unsigned*)(lds + (bufoff) + ldsw + _i * 8192), 16, 0, 0); } while (0)
#define PG8_LDA(dst, b, h) do { _Pragma("unroll") for (int m = 0; m < 4; ++m) _Pragma("unroll") for (int k = 0; k < 2; ++k) dst[m][k] = *(const LAS bf16x8*)(lds + PG8_SA(b, h) + aoff + m * 2048 + k * 1024); } while (0)
#define PG8_LDB(dst, b, h) do { _Pragma("unroll") for (int n = 0; n < 2; ++n) _Pragma("unroll") for (int k = 0; k < 2; ++k) dst[n][k] = *(const LAS bf16x8*)(lds + PG8_SB(b, h) + boff + n * 2048 + k * 1024); } while (0)
#define PG8_MMA(ai, bj, At, Bt) do { __builtin_amdgcn_s_setprio(1); _Pragma("unroll") for (int m = 0; m < 4; ++m) _Pragma("unroll") for (int n = 0; n < 2; ++n) _Pragma("unroll") for (int k = 0; k < 2; ++k) \
        acc[ai][bj][m][n] = __builtin_amdgcn_mfma_f32_16x16x32_bf16(Bt[n][k], At[m][k], acc[ai][bj][m][n], 0, 0, 0); __builtin_amdgcn_s_setprio(0); } while (0)
#define PG8_WAIT_V(n) asm volatile("s_waitcnt vmcnt(" #n ")" ::: "memory")
#define PG8_WAIT_L(n) asm volatile("s_waitcnt lgkmcnt(" #n ")" ::: "memory")
#define PG8_BAR __builtin_amdgcn_s_barrier()
#define PG8_SCHED __builtin_amdgcn_sched_barrier(0)
    Unit cur, nxt; int ui = 0;
    if (!S.next(0, cur)) return;
    f32x4 acc[2][2][4][2];
#pragma unroll
    for (int a = 0; a < 2; ++a)
#pragma unroll
        for (int b = 0; b < 2; ++b)
#pragma unroll
            for (int m = 0; m < 4; ++m)
#pragma unroll
                for (int n = 0; n < 2; ++n) acc[a][b][m][n] = (f32x4){0.f, 0.f, 0.f, 0.f};
    bf16x8 At[4][2], B0[2][2], B1[2][2];
    const char* cA = (const char*)g.A + (size_t)cur.pm * tstep; const char* cB = (const char*)g.Bt + (size_t)cur.pn * tstep;
    S.a_ready(cur);
    PG8_STAGE(PG8_SB(0, 0), cB, voffB); PG8_STAGE(PG8_SA(0, 0), cA, voffA); PG8_STAGE(PG8_SB(0, 1), cB + hstep, voffB); PG8_STAGE(PG8_SA(0, 1), cA + hstep, voffA);
    if (wr == 1) PG8_BAR;
    PG8_WAIT_V(4); PG8_BAR;
    PG8_STAGE(PG8_SB(1, 0), cB + kstep, voffB); PG8_STAGE(PG8_SA(1, 0), cA + kstep, voffA); PG8_STAGE(PG8_SB(1, 1), cB + hstep + kstep, voffB);
    PG8_WAIT_V(6); PG8_BAR;
    for (;;) {
        const bool has_next = S.next(ui + 1, nxt);
        const char* nA = has_next ? (const char*)g.A + (size_t)nxt.pm * tstep : cA; const char* nB = has_next ? (const char*)g.Bt + (size_t)nxt.pn * tstep : cB;
        for (int t = 0; t < nt; t += 2) {
            const bool last = (t == nt - 2);
            const char* a1 = cA + (size_t)(t + 1) * kstep;
            const char* a2 = last ? nA : cA + (size_t)(t + 2) * kstep; const char* b2 = last ? nB : cB + (size_t)(t + 2) * kstep;
            const char* a3 = a2 + kstep; const char* b3 = b2 + kstep;
            if (last && has_next) S.a_ready(nxt);
            PG8_LDB(B0, 0, 0); PG8_SCHED; PG8_LDA(At, 0, 0); PG8_STAGE(PG8_SA(1, 1), a1 + hstep, voffA);
            PG8_WAIT_L(8); PG8_BAR; PG8_WAIT_L(0); PG8_MMA(0, 0, At, B0); PG8_BAR; PG8_SCHED;
            PG8_LDB(B1, 0, 1); PG8_STAGE(PG8_SB(0, 0), b2, voffB);
            PG8_BAR; PG8_WAIT_L(0); PG8_MMA(0, 1, At, B1); PG8_BAR;
            PG8_LDA(At, 0, 1); PG8_STAGE(PG8_SA(0, 0), a2, voffA);
            PG8_BAR; PG8_WAIT_L(0); PG8_MMA(1, 0, At, B0); PG8_BAR; PG8_SCHED;
            PG8_STAGE(PG8_SB(0, 1), b2 + hstep, voffB);
            PG8_WAIT_V(6); PG8_BAR; PG8_MMA(1, 1, At, B1); PG8_BAR;
            PG8_LDB(B0, 1, 0); PG8_SCHED; PG8_LDA(At, 1, 0); PG8_STAGE(PG8_SA(0, 1), a2 + hstep, voffA);
            PG8_WAIT_L(8); PG8_BAR; PG8_WAIT_L(0); PG8_MMA(0, 0, At, B0); PG8_BAR; PG8_SCHED;
            PG8_LDB(B1, 1, 1); PG8_STAGE(PG8_SB(1, 0), b3, voffB);
            PG8_BAR; PG8_WAIT_L(0); PG8_MMA(0, 1, At, B1); PG8_BAR;
            PG8_LDA(At, 1, 1); PG8_STAGE(PG8_SA(1, 0), a3, voffA);
            PG8_BAR; PG8_WAIT_L(0); PG8_MMA(1, 0, At, B0); PG8_BAR; PG8_SCHED;
            PG8_STAGE(PG8_SB(1, 1), b3 + hstep, voffB);
            PG8_WAIT_V(6); PG8_BAR; PG8_MMA(1, 1, At, B1); PG8_BAR;
        }
        E(acc, cur, wr, wc, fr, fq); S.done(cur);
        if (!has_next) break;
#pragma unroll
        for (int a = 0; a < 2; ++a)
#pragma unroll
            for (int b = 0; b < 2; ++b)
#pragma unroll
                for (int m = 0; m < 4; ++m)
#pragma unroll
                    for (int n = 0; n < 2; ++n) acc[a][b][m][n] = (f32x4){0.f, 0.f, 0.f, 0.f};
        cur = nxt; cA = nA; cB = nB; ++ui;
    }
    PG8_WAIT_V(0);
    if (wr == 0) PG8_BAR;
    PG8_BAR;
#undef PG8_SA
#undef PG8_SB
#undef PG8_STAGE
#undef PG8_LDA
#undef PG8_LDB
#undef PG8_MMA
#undef PG8_WAIT_V
#undef PG8_WAIT_L
#undef PG8_BAR
#undef PG8_SCHED
}
}

struct JobDesc { unsigned long long in_off, dst_off; int in_idx, gain_idx, gain_off, ldw, col0, ncols, K, nrows, mode, pad; };
constexpr int MAXJOBS = 32;
struct Params { const float* in[17]; float* out; unsigned char* ws; JobDesc jobs[MAXJOBS]; int njobs, pad; };
enum { I_X = 0, I_MEM, I_NORMG, I_AWIN, I_AWOUT, I_BWIN, I_BWOUT, I_MEMWKV, I_WGU, I_WDOWN, I_KVNG, I_KVW, I_PE, I_WK1, I_WK2, I_WV1, I_WV2 };

struct ConvJob { const float* W; const float* gain; bf16_t* dst; int ldw, col0, ncols, K, nrows, mode; };
__device__ __forceinline__ bool conv_get(const Params& p, int j, ConvJob& J) {
    if (j >= p.njobs) return false;
    const JobDesc& d = p.jobs[j];
    J.W = p.in[d.in_idx] + d.in_off; J.gain = d.gain_idx >= 0 ? p.in[d.gain_idx] + d.gain_off : nullptr; J.dst = (bf16_t*)(p.ws + d.dst_off);
    J.ldw = d.ldw; J.col0 = d.col0; J.ncols = d.ncols; J.K = d.K; J.nrows = d.nrows; J.mode = d.mode;
    return true;
}
__device__ __forceinline__ void conv_load(const ConvJob& J, int it, int nblk, int lane, f32x4 (&v)[16]) {
    const int kb = it / nblk, nb = it - kb * nblk, k0 = 64 * kb, n = 64 * nb + 4 * (lane & 15), kr = lane >> 4;
    const bool ok = n < J.ncols;
    const int sc = J.mode == 1 ? (((n >> 7) & 1) * 5632 + (n >> 8) * 128 + (n & 127)) : (J.col0 + n);
    const float* src = J.W + (size_t)(k0 + kr) * J.ldw + sc;
#pragma unroll
    for (int i = 0; i < 16; ++i) v[i] = ok ? *(const f32x4*)(src + (size_t)(4 * i) * J.ldw) : (f32x4){0.f, 0.f, 0.f, 0.f};
}
__device__ __forceinline__ void conv_emit(const ConvJob& J, LAS float* scr, int it, int nblk, int lane, const f32x4 (&cur)[16]) {
    const int c4 = lane & 15, kr = lane >> 4, nb8 = lane >> 3, c = lane & 7;
    const int kb = it / nblk, nb = it - kb * nblk, k0 = 64 * kb, n0 = 64 * nb;
#pragma unroll
    for (int i = 0; i < 16; ++i) *(LAS f32x4*)(scr + (kr + 4 * i) * 64 + ((c4 ^ (i >> 1)) << 2)) = cur[i];
    LDS_WAIT();
    f32x4 g0 = {1.f, 1.f, 1.f, 1.f}, g1 = {1.f, 1.f, 1.f, 1.f};
    if (J.gain) { g0 = *(const f32x4*)(J.gain + k0 + 8 * c); g1 = *(const f32x4*)(J.gain + k0 + 8 * c + 4); }
#pragma unroll
    for (int j = 0; j < 8; ++j) { const int n = nb8 + 8 * j; const LAS float* t = scr + (8 * c) * 64 + ((((n >> 2) ^ c) << 2) | (n & 3));
        u32x4 o; o.x = pk2(t[0 * 64] * g0[0], t[1 * 64] * g0[1]); o.y = pk2(t[2 * 64] * g0[2], t[3 * 64] * g0[3]); o.z = pk2(t[4 * 64] * g1[0], t[5 * 64] * g1[1]); o.w = pk2(t[6 * 64] * g1[2], t[7 * 64] * g1[3]);
        *(u32x4*)(J.dst + (size_t)(n0 + n) * J.K + k0 + 8 * c) = o; }
    LDS_WAIT();
}
__device__ __forceinline__ void conv_run(const ConvJob& J, LAS float* scr, int gw, int ngw, int lane) {
    const int nblk = J.nrows / 64, kblk = J.K / 64, items = nblk * kblk;
    f32x4 bufA[16], bufB[16];
    int it = gw;
    if (it < items) conv_load(J, it, nblk, lane, bufA);
    while (it < items) {
        if (it + ngw < items) conv_load(J, it + ngw, nblk, lane, bufB);
        conv_emit(J, scr, it, nblk, lane, bufA);
        it += ngw; if (it >= items) break;
        if (it + ngw < items) conv_load(J, it + ngw, nblk, lane, bufA);
        conv_emit(J, scr, it, nblk, lane, bufB);
        it += ngw;
    }
}

__device__ __forceinline__ void rms_row(const float* xrow, bf16_t* orow, float* copy, int lane) {
    const f32x4* xr = (const f32x4*)xrow + lane;
    f32x4 v[8]; float s = 0.f;
#pragma unroll
    for (int j = 0; j < 8; ++j) { v[j] = xr[64 * j]; s += (v[j].x * v[j].x + v[j].y * v[j].y) + (v[j].z * v[j].z + v[j].w * v[j].w); }
    const float rs = rsqrtf(wave_sum(s) * (1.f / 2048.f) + 1e-6f);
    u32x2* o8 = (u32x2*)orow + lane;
#pragma unroll
    for (int j = 0; j < 8; ++j) { u32x2 w; w.x = pk2(v[j].x * rs, v[j].y * rs); w.y = pk2(v[j].z * rs, v[j].w * rs); o8[64 * j] = w; }
    if (copy) { f32x4* c4 = (f32x4*)copy + lane;
#pragma unroll
        for (int j = 0; j < 8; ++j) c4[64 * j] = v[j]; }
}
__device__ __forceinline__ void rowop_row(float* xrow, const bf16_t* orow, const float* gain, bf16_t* hrow, int lane) {
    const u32x2* o2 = (const u32x2*)orow + lane; f32x4* x4 = (f32x4*)xrow + lane; const f32x4* g4 = (const f32x4*)gain + lane;
    f32x4 o[8]; float s = 0.f;
#pragma unroll
    for (int j = 0; j < 8; ++j) { const u32x2 w = o2[64 * j]; o[j] = (f32x4){bflo(w.x), bfhi(w.x), bflo(w.y), bfhi(w.y)}; s += (o[j].x * o[j].x + o[j].y * o[j].y) + (o[j].z * o[j].z + o[j].w * o[j].w); }
    const float rs = rsqrtf(wave_sum(s) * (1.f / 2048.f) + 1e-6f);
    float s2 = 0.f;
#pragma unroll
    for (int j = 0; j < 8; ++j) { const f32x4 g = g4[64 * j]; f32x4 x = x4[64 * j]; x = x + o[j] * rs * g; x4[64 * j] = x; o[j] = x; s2 += (x.x * x.x + x.y * x.y) + (x.z * x.z + x.w * x.w); }
    const float rs2 = rsqrtf(wave_sum(s2) * (1.f / 2048.f) + 1e-6f);
    u32x2* o8 = (u32x2*)hrow + lane;
#pragma unroll
    for (int j = 0; j < 8; ++j) { u32x2 w; w.x = pk2(o[j].x * rs2, o[j].y * rs2); w.y = pk2(o[j].z * rs2, o[j].w * rs2); o8[64 * j] = w; }
}

typedef short s16x4 __attribute__((ext_vector_type(4)));
constexpr int AT_ROWB = 272, AT_TILEB = 64 * AT_ROWB, AT_STAGEB = 2 * AT_TILEB;
constexpr int AT_AUX = 2 * AT_STAGEB;
constexpr float SCALE2 = 0.12751743f;
constexpr float LOG2E = 1.4426950408889634f, LN2 = 0.6931471805599453f;
struct AttnArgs {
    const bf16_t* q; size_t qstride;
    const bf16_t* k; const bf16_t* v; size_t kvstride;
    unsigned tilemask;
    int nkeys, qpos0, kmul, maxdist;
    float slope2;
};
__device__ __forceinline__ void at_gload(const AttnArgs& A, int kt, int tid, u32x4 (&kr)[2], u32x4 (&vr)[2]) {
#pragma unroll
    for (int i = 0; i < 2; ++i) { const int id = tid + 512 * i, row = id >> 4, c16 = id & 15; const size_t off = (size_t)(64 * kt + row) * A.kvstride + 8 * c16;
        kr[i] = *(const u32x4*)(A.k + off); vr[i] = *(const u32x4*)(A.v + off); }
}
__device__ __forceinline__ void at_lstore(LAS unsigned char* st, int tid, const u32x4 (&kr)[2], const u32x4 (&vr)[2]) {
#pragma unroll
    for (int i = 0; i < 2; ++i) { const int id = tid + 512 * i, row = id >> 4, c16 = id & 15;
        *(LAS u32x4*)(st + row * AT_ROWB + c16 * 16) = kr[i];
        const int prow = (row & ~12) | (((row >> 2) & 1) << 3) | (((row >> 3) & 1) << 2), swz = ((prow & 3) << 2) | ((prow >> 2) & 3);
        *(LAS u32x4*)(st + AT_TILEB + prow * 256 + ((c16 ^ swz) << 4)) = vr[i]; }
}
__device__ __forceinline__ bf16x8 pack8(const f32x4& a, const f32x4& b) {
    u32x4 w; w.x = pg8::cvt_pk_bf16(a[0], a[1]); w.y = pg8::cvt_pk_bf16(a[2], a[3]); w.z = pg8::cvt_pk_bf16(b[0], b[1]); w.w = pg8::cvt_pk_bf16(b[2], b[3]);
    return __builtin_bit_cast(bf16x8, w);
}
__device__ __forceinline__ bf16x8 tr_pair(const LAS unsigned char* p0, const LAS unsigned char* p1) {
    const s16x4 lo = __builtin_amdgcn_ds_read_tr16_b64_v4i16((LAS s16x4*)p0), hi = __builtin_amdgcn_ds_read_tr16_b64_v4i16((LAS s16x4*)p1);
    return __builtin_shufflevector(lo, hi, 0, 1, 2, 3, 4, 5, 6, 7);
}
template <bool USE_SEL>
__device__ __forceinline__ void attn_core(LAS unsigned char* lds, const AttnArgs& A, unsigned selmask, int tid, f32x4 (&o)[8], float& m, float& l) {
    const int lane = tid & 63, wave = __builtin_amdgcn_readfirstlane(tid >> 6), fr = lane & 15, fq = lane >> 4, row = wave * 16 + fr, qpos = A.qpos0 + row;
    bf16x8 qf[4];
    { const bf16_t* qp = A.q + (size_t)row * A.qstride + 8 * fq;
#pragma unroll
      for (int dc = 0; dc < 4; ++dc) qf[dc] = *(const bf16x8*)(qp + 32 * dc); }
    m = -INFINITY; l = 0.f;
#pragma unroll
    for (int db = 0; db < 8; ++db) o[db] = (f32x4){0.f, 0.f, 0.f, 0.f};
    unsigned tm = A.tilemask;
    if (tm == 0u) return;
    const int wq0 = A.qpos0 + 16 * wave;
    const bool nomask = A.kmul == 0;
    auto tile = [&](const int kt, const LAS unsigned char* st) {
        const int dlo = wq0 - 64 * kt - 63, dhi = wq0 + 15 - 64 * kt;
        const bool tsel = USE_SEL ? (((selmask >> kt) & 1u) != 0u) : true;
        if (!nomask && (dhi < 0 || dlo > A.maxdist || (USE_SEL && !__any(tsel)))) return;
        const bool interior = nomask || (dlo >= 0 && dhi <= A.maxdist && (!USE_SEL || __all(tsel)));
        f32x4 s[4];
        { const LAS unsigned char* kbase = st + fr * AT_ROWB + fq * 16;
#pragma unroll
          for (int kb = 0; kb < 4; ++kb) { s[kb] = (f32x4){0.f, 0.f, 0.f, 0.f};
#pragma unroll
              for (int dc = 0; dc < 4; ++dc) { const bf16x8 kf = *(const LAS bf16x8*)(kbase + kb * 16 * AT_ROWB + dc * 64); s[kb] = __builtin_amdgcn_mfma_f32_16x16x32_bf16(kf, qf[dc], s[kb], 0, 0, 0); } } }
        const int vq = fr >> 2, vp = fr & 3, vS = (vq << 2) | (2 * (fq & 1) + (fq >> 1)), vx0 = ((vp >> 1) ^ vS) & 1, vS14 = vS & 14;
        const LAS unsigned char* vbase = st + AT_TILEB + 256 * (8 * (fq & 1) + 4 * (fq >> 1) + vq) + 8 * (vp & 1);
        bf16x8 vf0[8];
#pragma unroll
        for (int db = 0; db < 8; ++db) { const int co = (((2 * db) ^ vS14) | vx0) << 4; vf0[db] = tr_pair(vbase + co, vbase + 16 * 256 + co); }
        const int D0 = (USE_SEL && !tsel) ? -(1 << 30) : (qpos - 64 * kt - 4 * fq);
        const float B0 = nomask ? 0.f : -A.slope2 * (float)(qpos - 64 * kt - 4 * fq);
        float tmax = -INFINITY;
        if (interior) {
#pragma unroll
            for (int kb = 0; kb < 4; ++kb)
#pragma unroll
                for (int e = 0; e < 4; ++e) { const float x = fmaf(s[kb][e], SCALE2, fmaf(A.slope2, (float)(16 * kb + e), B0)); s[kb][e] = x; tmax = fmaxf(tmax, x); }
        } else {
#pragma unroll
            for (int kb = 0; kb < 4; ++kb)
#pragma unroll
                for (int e = 0; e < 4; ++e) { const bool valid = (unsigned)(D0 - (16 * kb + e)) <= (unsigned)A.maxdist;
                    const float x = valid ? fmaf(s[kb][e], SCALE2, fmaf(A.slope2, (float)(16 * kb + e), B0)) : -INFINITY; s[kb][e] = x; tmax = fmaxf(tmax, x); }
        }
        tmax = fmaxf(tmax, __shfl_xor(tmax, 16)); tmax = fmaxf(tmax, __shfl_xor(tmax, 32));
        const float mnew = fmaxf(m, tmax), muse = (mnew == -INFINITY) ? 0.f : mnew;
        if (!__all(mnew == m)) {
            const float alpha = __builtin_amdgcn_exp2f(m - muse);
            l *= alpha;
#pragma unroll
            for (int db = 0; db < 8; ++db) o[db] *= alpha;
        }
        m = mnew;
#pragma unroll
        for (int kb = 0; kb < 4; ++kb)
#pragma unroll
            for (int e = 0; e < 4; ++e) { const float pv = __builtin_amdgcn_exp2f(s[kb][e] - muse); s[kb][e] = pv; l += pv; }
        bf16x8 vf1[8];
#pragma unroll
        for (int db = 0; db < 8; ++db) { const int co = (((2 * db) ^ vS14) | vx0) << 4; vf1[db] = tr_pair(vbase + 32 * 256 + co, vbase + 48 * 256 + co); }
        const bf16x8 pf0 = pack8(s[0], s[1]), pf1 = pack8(s[2], s[3]);
#pragma unroll
        for (int db = 0; db < 8; ++db) o[db] = __builtin_amdgcn_mfma_f32_16x16x32_bf16(vf0[db], pf0, o[db], 0, 0, 0);
#pragma unroll
        for (int db = 0; db < 8; ++db) o[db] = __builtin_amdgcn_mfma_f32_16x16x32_bf16(vf1[db], pf1, o[db], 0, 0, 0);
    };
    u32x4 krA[2], vrA[2], krB[2], vrB[2];
    int k0 = 31 - __builtin_clz(tm); tm &= ~(1u << k0);
    int k1 = -1; if (tm) { k1 = 31 - __builtin_clz(tm); tm &= ~(1u << k1); }
    at_gload(A, k0, tid, krA, vrA); if (k1 >= 0) at_gload(A, k1, tid, krB, vrB);
    at_lstore(lds, tid, krA, vrA); __syncthreads();
    for (;;) {
        int k2 = -1; if (tm) { k2 = 31 - __builtin_clz(tm); tm &= ~(1u << k2); }
        if (k2 >= 0) at_gload(A, k2, tid, krA, vrA);
        tile(k0, lds);
        if (k1 >= 0) at_lstore(lds + AT_STAGEB, tid, krB, vrB);
        __syncthreads();
        if (k1 < 0) break;
        int k3 = -1; if (tm) { k3 = 31 - __builtin_clz(tm); tm &= ~(1u << k3); }
        if (k3 >= 0) at_gload(A, k3, tid, krB, vrB);
        tile(k1, lds + AT_STAGEB);
        if (k2 >= 0) at_lstore(lds, tid, krA, vrA);
        __syncthreads();
        if (k2 < 0) break;
        k0 = k2; k1 = k3;
    }
    l += __shfl_xor(l, 16); l += __shfl_xor(l, 32);
}
__device__ __forceinline__ void at_store_o(bf16_t* orow, const f32x4 (&o)[8], float inv, int fq) {
#pragma unroll
    for (int db = 0; db < 8; ++db) { u32x2 w; w.x = pg8::cvt_pk_bf16(o[db][0] * inv, o[db][1] * inv); w.y = pg8::cvt_pk_bf16(o[db][2] * inv, o[db][3] * inv); *(u32x2*)(orow + 16 * db + 4 * fq) = w; }
}
__device__ __forceinline__ void mem_attn_wg(LAS unsigned char* lds, const bf16_t* proj, int nh, int mq0, const bf16_t* memkv, int l, bf16_t* cat, int ldc, int memoff, int b, int h, int qb, int tid_) {
    int tid = tid_; asm volatile("" : "+v"(tid));
    const int t0 = b * SEQ + qb * 128;
    AttnArgs A; A.q = proj + ((size_t)(b * nh + mq0 + h) * SEQ + qb * 128) * HD; A.qstride = HD; A.k = memkv + (size_t)(b * 32 + l * 8 + h) * 256 * HD; A.v = A.k + (size_t)4 * 256 * HD; A.kvstride = HD;
    A.tilemask = 0xFu; A.nkeys = 256; A.qpos0 = 1 << 20; A.kmul = 0; A.maxdist = 0x7fffffff; A.slope2 = 0.f;
    f32x4 o[8]; float m, lsum; attn_core<false>(lds, A, 0u, tid, o, m, lsum);
    const int lane = tid & 63, row = (tid >> 6) * 16 + (lane & 15);
    at_store_o(cat + (size_t)(t0 + row) * ldc + memoff + h * HD, o, 1.0f / fmaxf(lsum, 1e-30f), lane >> 4);
}
__device__ __forceinline__ void dil_attn_wg(LAS unsigned char* lds, const bf16_t* proj, bf16_t* og, float* lse, int b, int hh, int x, int tid_) {
    int tid = tid_; asm volatile("" : "+v"(tid));
    const int gi = hh >> 3, j = hh & 7, d = gi == 0 ? 1 : (gi == 1 ? 4 : 16), nqb = 16 / d, r = x / nqb, qb = x % nqb, c0 = qb * 128, L = SEQ / d;
    const float slope = exp2f(-8.0f * (float)(hh + 1) / 24.0f);
    AttnArgs A; A.q = proj + ((size_t)(b * 76 + hh) * SEQ + c0 * d + r) * HD; A.qstride = (size_t)d * HD;
    A.k = proj + ((size_t)(b * 76 + 24 + hh) * SEQ + r) * HD; A.v = A.k + (size_t)24 * SEQ * HD; A.kvstride = (size_t)d * HD;
    const int ktc = c0 >> 6; A.tilemask = (ktc >= 2 ? (0xFu << (ktc - 2)) : 0x3u); A.nkeys = L; A.qpos0 = c0; A.kmul = 1; A.maxdist = 128; A.slope2 = slope * (float)d * LOG2E;
    f32x4 o[8]; float m, lsum; attn_core<false>(lds, A, 0u, tid, o, m, lsum);
    const int lane = tid & 63, fr = lane & 15, fq = lane >> 4, row = (tid >> 6) * 16 + fr;
    const size_t t = (size_t)b * SEQ + (size_t)(c0 + row) * d + r;
    at_store_o(og + ((size_t)gi * NTOK + t) * 1024 + j * HD, o, 1.0f / fmaxf(lsum, 1e-30f), fq);
    if (fq == 0) lse[((size_t)gi * NTOK + t) * 8 + j] = m * LN2 + __logf(fmaxf(lsum, 1e-30f));
}
__device__ __forceinline__ void cmp_sel_wg(LAS unsigned char* lds, const bf16_t* proj, const bf16_t* kc, const bf16_t* vc, bf16_t* ocmp, unsigned* sel, int b, int g, int qb, int tid_) {
    int tid = tid_; asm volatile("" : "+v"(tid));
    const int lane = tid & 63, wave = tid >> 6, fr = lane & 15, fq = lane >> 4, row = wave * 16 + fr, t0 = b * SEQ + qb * 128, spos_ = qb * 128 + row, cur = spos_ >> 6;
#pragma unroll
    for (int i = 0; i < 4; ++i) { const int id = tid + 512 * i, n = id >> 4, c16 = id & 15; const size_t off = ((size_t)(b * NCMP + n) * 4 + g) * 256 + 8 * c16;
        *(LAS u32x4*)(lds + n * AT_ROWB + c16 * 16) = *(const u32x4*)(kc + off); *(LAS u32x4*)(lds + 2 * AT_TILEB + n * AT_ROWB + c16 * 16) = *(const u32x4*)(vc + off); }
    __syncthreads();
    float imp[8];
#pragma unroll
    for (int kb = 0; kb < 8; ++kb) imp[kb] = 0.f;
    for (int r = 0; r < 3; ++r) {
        const int h = 3 * g + r; const float slope2 = exp2f(-8.0f * (float)(h + 1) / 12.0f) * LOG2E;
        int z = 0; asm volatile("" : "+v"(z));
        const int spos = spos_ + z;
        bf16x8 qf[4];
        { const bf16_t* qp = proj + ((size_t)(b * 18 + h) * SEQ + qb * 128 + row) * HD + 8 * fq;
#pragma unroll
          for (int dc = 0; dc < 4; ++dc) qf[dc] = *(const bf16x8*)(qp + 32 * dc); }
        f32x4 s[8];
        { const LAS unsigned char* kbase = lds + fr * AT_ROWB + fq * 16 + z;
#pragma unroll
          for (int kb = 0; kb < 8; ++kb) { s[kb] = (f32x4){0.f, 0.f, 0.f, 0.f};
#pragma unroll
              for (int dc = 0; dc < 4; ++dc) { const bf16x8 kf = *(const LAS bf16x8*)(kbase + kb * 16 * AT_ROWB + dc * 64); s[kb] = __builtin_amdgcn_mfma_f32_16x16x32_bf16(kf, qf[dc], s[kb], 0, 0, 0); } } }
        float tmax = -INFINITY;
#pragma unroll
        for (int kb = 0; kb < 8; ++kb)
#pragma unroll
            for (int e = 0; e < 4; ++e) { const int n = 16 * kb + 4 * fq + e, dist = spos - (16 * n + 31); const bool valid = (dist >= 0) && (n < NCMP);
                const float x = valid ? (s[kb][e] * SCALE2 - slope2 * (float)dist) : -INFINITY; s[kb][e] = x; tmax = fmaxf(tmax, x); }
        tmax = fmaxf(tmax, __shfl_xor(tmax, 16)); tmax = fmaxf(tmax, __shfl_xor(tmax, 32));
        const float muse = (tmax == -INFINITY) ? 0.f : tmax;
        float lsum = 0.f;
#pragma unroll
        for (int kb = 0; kb < 8; ++kb)
#pragma unroll
            for (int e = 0; e < 4; ++e) { const float pv = __builtin_amdgcn_exp2f(s[kb][e] - muse); s[kb][e] = pv; lsum += pv; }
        lsum += __shfl_xor(lsum, 16); lsum += __shfl_xor(lsum, 32);
        const float inv = 1.0f / fmaxf(lsum, 1e-30f);
#pragma unroll
        for (int kb = 0; kb < 8; ++kb) s[kb] *= inv;
#pragma unroll
        for (int kb = 0; kb < 8; ++kb) { const float t1 = __shfl(s[kb][3], (lane - 16) & 63); const float t0v = kb > 0 ? __shfl(s[kb > 0 ? kb - 1 : 0][3], (lane - 16) & 63) : 0.f;
            imp[kb] += s[kb][0] + s[kb][1] + s[kb][2] + 0.5f * s[kb][3] + 0.5f * (fq == 0 ? t0v : t1); }
        f32x4 o[8];
#pragma unroll
        for (int db = 0; db < 8; ++db) o[db] = (f32x4){0.f, 0.f, 0.f, 0.f};
        { const LAS unsigned char* vbase = lds + 2 * AT_TILEB + (4 * fq + (fr >> 2)) * AT_ROWB + 8 * (fr & 3);
#pragma unroll
          for (int c = 0; c < 4; ++c) { const bf16x8 pf = pack8(s[2 * c], s[2 * c + 1]);
#pragma unroll
              for (int db = 0; db < 8; ++db) { const bf16x8 vf = tr_pair(vbase + c * 32 * AT_ROWB + db * 32, vbase + c * 32 * AT_ROWB + 16 * AT_ROWB + db * 32);
                  o[db] = __builtin_amdgcn_mfma_f32_16x16x32_bf16(vf, pf, o[db], 0, 0, 0); } } }
        at_store_o(ocmp + (size_t)(t0 + row) * 1536 + h * HD, o, 1.0f, fq);
    }
    LAS float* rk = (LAS float*)(lds + AT_AUX + wave * 2048) + fr * 32;
    float mine[8];
#pragma unroll
    for (int kb = 0; kb < 8; ++kb) { const int j = 4 * kb + fq; const bool forced = (j == 0) || (j == cur) || (j == cur - 1);
        mine[kb] = forced ? 1e4f : (j > cur ? -1e4f : imp[kb]); rk[j] = mine[kb]; }
    LDS_WAIT();
    int rank[8];
#pragma unroll
    for (int kb = 0; kb < 8; ++kb) rank[kb] = 0;
#pragma unroll
    for (int j4 = 0; j4 < 8; ++j4) { const f32x4 v = *(const LAS f32x4*)(rk + 4 * j4);
#pragma unroll
        for (int e = 0; e < 4; ++e) { const int jj = 4 * j4 + e;
#pragma unroll
            for (int kb = 0; kb < 8; ++kb) { const int j = 4 * kb + fq; rank[kb] += (v[e] > mine[kb] || (v[e] == mine[kb] && jj < j)) ? 1 : 0; } } }
    unsigned bits = 0u;
#pragma unroll
    for (int kb = 0; kb < 8; ++kb) { const int j = 4 * kb + fq; if (rank[kb] < 16 && j <= cur) bits |= 1u << j; }
    bits |= __shfl_xor(bits, 16); bits |= __shfl_xor(bits, 32);
    if (fq == 0) sel[(size_t)(t0 + row) * 4 + g] = bits;
    __syncthreads();
}
__device__ __forceinline__ void nsa_attn_wg(LAS unsigned char* lds, const bf16_t* proj, const bf16_t* kvs, const unsigned* sel, const bf16_t* ocmp, bf16_t* cat, int b, int h, int qb, int tid_) {
    int tid = tid_; asm volatile("" : "+v"(tid));
    const int lane = tid & 63, wave = tid >> 6, fr = lane & 15, fq = lane >> 4, row = wave * 16 + fr, g = h / 3, t0 = b * SEQ + qb * 128;
    const float slope2 = exp2f(-8.0f * (float)(h + 1) / 12.0f) * LOG2E;
    const unsigned selmask = sel[(size_t)(t0 + row) * 4 + g];
    unsigned um = selmask;
#pragma unroll
    for (int o_ = 1; o_ < 64; o_ <<= 1) um |= __shfl_xor(um, o_);
    LAS unsigned* wgw = (LAS unsigned*)(lds + AT_AUX + 8 * 2048);
    if (lane == 0) wgw[wave] = um;
    __syncthreads();
    um = wgw[0] | wgw[1] | wgw[2] | wgw[3] | wgw[4] | wgw[5] | wgw[6] | wgw[7];
    um = __builtin_amdgcn_readfirstlane(um);
    AttnArgs A; A.q = proj + ((size_t)(b * 18 + h) * SEQ + qb * 128) * HD; A.qstride = HD; A.kvstride = HD; A.nkeys = SEQ; A.qpos0 = qb * 128; A.kmul = 1; A.slope2 = slope2;
    const bf16_t* kvb = kvs + (size_t)(b * 24 + g) * SEQ * HD;
    constexpr size_t KIND = (size_t)4 * SEQ * HD;
    A.k = kvb + 2 * KIND; A.v = kvb + 3 * KIND; A.maxdist = 0x7fffffff; A.tilemask = um & (0xffffffffu >> (31 - (2 * qb + 1)));
    f32x4 os[8]; float m, lsum; attn_core<true>(lds, A, selmask, tid, os, m, lsum);
    { const float inv = 1.0f / fmaxf(lsum, 1e-30f);
#pragma unroll
      for (int db = 0; db < 8; ++db) os[db] *= inv; }
    A.k = kvb + 4 * KIND; A.v = kvb + 5 * KIND; A.maxdist = 511;
    { const int k0 = 2 * qb - 8 < 0 ? 0 : 2 * qb - 8, k1 = 2 * qb + 1; A.tilemask = (0xffffffffu >> (31 - k1)) & (0xffffffffu << k0); }
    f32x4 ow[8]; attn_core<false>(lds, A, 0u, tid, ow, m, lsum);
    const float invw = 1.0f / fmaxf(lsum, 1e-30f);
    const bf16_t* gp = proj + ((size_t)(b * 18 + 16) * SEQ + qb * 128 + row) * HD + h * 3;
    const float g0 = 1.0f / (1.0f + __expf(-bflo((unsigned)gp[0]))), g1 = 1.0f / (1.0f + __expf(-bflo((unsigned)gp[1]))), g2 = invw / (1.0f + __expf(-bflo((unsigned)gp[2])));
    bf16_t* orow = cat + (size_t)(t0 + row) * 2048 + h * HD + 4 * fq; const bf16_t* crow = ocmp + (size_t)(t0 + row) * 1536 + h * HD + 4 * fq;
#pragma unroll
    for (int db = 0; db < 8; ++db) { const u32x2 c = *(const u32x2*)(crow + 16 * db);
        const float r0 = g0 * bflo(c.x) + g1 * os[db][0] + g2 * ow[db][0], r1 = g0 * bfhi(c.x) + g1 * os[db][1] + g2 * ow[db][1];
        const float r2 = g0 * bflo(c.y) + g1 * os[db][2] + g2 * ow[db][2], r3 = g0 * bfhi(c.y) + g1 * os[db][3] + g2 * ow[db][3];
        u32x2 w; w.x = pg8::cvt_pk_bf16(r0, r1); w.y = pg8::cvt_pk_bf16(r2, r3); *(u32x2*)(orow + 16 * db) = w; }
}

__device__ __forceinline__ int opq_tid() { int t = threadIdx.x; asm volatile("" : "+v"(t)); return t; }
__global__ void __launch_bounds__(NTHREADS, 2) mega_fwd(Params p) {
    extern __shared__ __attribute__((aligned(16))) unsigned char lds_raw[];
    LAS unsigned char* lds = (LAS unsigned char*)lds_raw;
    cg::grid_group grid = cg::this_grid();
    const int tid = threadIdx.x, lane = tid & 63, wave = __builtin_amdgcn_readfirstlane(tid >> 6);
    const int G = gridDim.x, bid = blockIdx.x;
    volatile LAS unsigned* bst = (volatile LAS unsigned*)(lds + LDS_MAIN);
    if (tid < 2) bst[tid] = 0u;
    __syncthreads();
    const XcdBarrier gbar = xcd_barrier_post((unsigned*)(p.ws + WS_BAR), bst);
    grid.sync();
    const int gw = bid * NWAVES + wave, ngw = G * NWAVES;
    unsigned char* ws = p.ws;
    float* X = p.out;
    bf16_t* XH = (bf16_t*)(ws + WS_XH); bf16_t* PROJ = (bf16_t*)(ws + WS_PROJ); float* OBUF = (float*)(ws + WS_OBUF);
    bf16_t* CAT = (bf16_t*)(ws + WS_CAT); bf16_t* KVS = (bf16_t*)(ws + WS_KVS); bf16_t* MEMKV = (bf16_t*)(ws + WS_MEMKV); bf16_t* MEMHAT = (bf16_t*)(ws + WS_MEMHAT);
    bf16_t* OG = (bf16_t*)(ws + WS_KVS); float* LSE = (float*)(ws + WS_HID); unsigned* SEL = (unsigned*)(ws + WS_SEL);
    bf16_t* OCMP = (bf16_t*)(ws + WS_OBUF);
    bf16_t* OBF = (bf16_t*)(ws + WS_OBUF + (size_t)NTOK * 2048 * 2);
    bf16_t* HID = (bf16_t*)(ws + WS_HID); bf16_t* KCV = (bf16_t*)(ws + WS_KCV); bf16_t* BLK = (bf16_t*)(ws + WS_OBUF);
    LAS float* wscr = (LAS float*)(lds + wave * 16384);

    for (int rep_ = 0; rep_ < REP_P0; ++rep_) {
        ConvJob J;
        for (int j = 0; conv_get(p, j, J); ++j) conv_run(J, wscr, gw, ngw, lane);
        for (int m = gw; m < 1024; m += ngw) rms_row(p.in[I_MEM] + (size_t)m * 2048, MEMHAT + (size_t)m * 2048, nullptr, lane);
        for (int m = gw; m < NTOK; m += ngw) rms_row(p.in[I_X] + (size_t)m * 2048, XH + (size_t)m * 2048, X + (size_t)m * 2048, lane);
    }
    for (int rs_ = 0; rs_ < REP_SYNC; ++rs_) xcd_barrier(gbar);

    for (int l = 0; l < 4; ++l) {
        const bool isA = l < 2;
        for (int jb = 0; jb < 3; ++jb) {
            pg8::Gemm g; bf16_t* O; int ldc; int c = bid; int hm = 0, ssh = 11;
            if (jb == 0) { g.A = XH; g.M = NTOK; g.K = 2048;
                if (isA) { g.Bt = (const bf16_t*)(ws + WS_WAIN + l * SZ_WAIN); g.N = A_COLS; O = PROJ; ldc = A_COLS; hm = 76; }
                else { g.Bt = (const bf16_t*)(ws + WS_WBIN + (l - 2) * SZ_WBIN); g.N = B_COLS; O = PROJ; ldc = B_COLS; hm = 18; } }
            else if (jb == 1) { if (l != 0) continue; g.A = MEMHAT; g.Bt = (const bf16_t*)(ws + WS_WMEM); g.M = 1024; g.N = 4096; g.K = 2048; O = MEMKV; ldc = 4096; c = (bid + 64) % G; hm = 32; ssh = 8; }
            else { if (l != 2) continue; g.A = XH; g.Bt = (const bf16_t*)(ws + WS_WKV); g.M = NTOK; g.N = 3072; g.K = 2048; O = KVS; ldc = 3072; hm = 24; }
            pg8::StaticOrder S; S.init(g.M, g.N, G, c);
            pg8::EpiBf16<0> E{O, ldc, hm, ssh};
            for (int rep_ = 0; rep_ < REP_GEMM; ++rep_) pg8::gemm_phase(lds, g, S, E);
        }
        for (int rs_ = 0; rs_ < REP_SYNC; ++rs_) xcd_barrier(gbar);
        if (l == 2) {
            const int lane = opq_tid() & 63;
            for (int it = gw; it < 2 * 2048; it += ngw) {
                const int w = it >> 11, row = it & 2047; bf16_t* dst = BLK + ((size_t)w * 2048 + row) * 4096;
                if (row < NBATCH * NCMP * 4) { const int gg = row & 3, bn = row >> 2, bb = bn / NCMP, n = bn % NCMP;
                    const bf16_t* src = KVS + ((size_t)(bb * 24 + w * 4 + gg) * SEQ + 16 * n) * HD; const float* pe = p.in[I_PE] + w * 32 * HD;
                    for (int ll = 0; ll < 32; ++ll) { const unsigned v = *(const unsigned*)(src + (size_t)ll * HD + 2 * lane); const f32x2 e = *(const f32x2*)(pe + ll * HD + 2 * lane);
                        *(unsigned*)(dst + ll * HD + 2 * lane) = pk2(bflo(v) + e.x, bfhi(v) + e.y); } }
                else { for (int ll = 0; ll < 32; ++ll) *(unsigned*)(dst + ll * HD + 2 * lane) = 0u; }
            }
            for (int rs_ = 0; rs_ < REP_SYNC; ++rs_) xcd_barrier(gbar);
            for (int w = 0; w < 2; ++w) { pg8::Gemm g{BLK + (size_t)w * 2048 * 4096, (const bf16_t*)(ws + WS_WC1 + w * SZ_WC1), 2048, 512, 4096};
                pg8::StaticOrder S; S.init(2048, 512, G, (bid + 128 * w) % G); pg8::EpiBf16<1> E{HID + (size_t)w * 2048 * 512, 512, 0, 11}; for (int rep_ = 0; rep_ < REP_GEMM; ++rep_) pg8::gemm_phase(lds, g, S, E); }
            for (int rs_ = 0; rs_ < REP_SYNC; ++rs_) xcd_barrier(gbar);
            for (int w = 0; w < 2; ++w) { pg8::Gemm g{HID + (size_t)w * 2048 * 512, (const bf16_t*)(ws + WS_WC2 + w * SZ_WC2), 2048, 256, 512};
                pg8::StaticOrder S; S.init(2048, 256, G, (bid + 128 * w) % G); pg8::EpiBf16<0> E{KCV + (size_t)w * 2048 * 256, 256, 0, 11}; for (int rep_ = 0; rep_ < REP_GEMM; ++rep_) pg8::gemm_phase(lds, g, S, E); }
            for (int rs_ = 0; rs_ < REP_SYNC; ++rs_) xcd_barrier(gbar);
        }
        if (isA) {
            for (int rep_ = 0; rep_ < REP_ATT * REP_ATTA; ++rep_)
            for (int it = bid; it < 1792; it += G) {
                if (it < 1536) { const int x = it & 15, bh = it >> 4; dil_attn_wg(lds, PROJ, OG, LSE, bh / 24, bh % 24, x, opq_tid()); }
                else { const int u = it - 1536; mem_attn_wg(lds, PROJ, 76, 72, MEMKV, l, CAT, 1536, 1024, u >> 6, (u >> 4) & 3, u & 15, opq_tid()); }
            }
            for (int rs_ = 0; rs_ < REP_SYNC; ++rs_) xcd_barrier(gbar);
            for (int rep_ = 0; rep_ < REP_ATT; ++rep_)
            for (int it = bid * NTHREADS + opq_tid(); it < NTOK * 8 * 16; it += G * NTHREADS) { const int c8 = it & 15, tj = it >> 4;
                const float l0 = LSE[tj], l1 = LSE[(size_t)NTOK * 8 + tj], l2 = LSE[(size_t)2 * NTOK * 8 + tj], mx = fmaxf(l0, fmaxf(l1, l2));
                float e0 = __expf(l0 - mx), e1 = __expf(l1 - mx), e2 = __expf(l2 - mx); const float inv = 1.0f / (e0 + e1 + e2); e0 *= inv; e1 *= inv; e2 *= inv;
                const u32x4 a = *(const u32x4*)(OG + (size_t)tj * 128 + 8 * c8), bq = *(const u32x4*)(OG + ((size_t)NTOK * 8 + tj) * 128 + 8 * c8), cq = *(const u32x4*)(OG + ((size_t)2 * NTOK * 8 + tj) * 128 + 8 * c8);
                u32x4 w;
                w.x = pk2(e0 * bflo(a.x) + e1 * bflo(bq.x) + e2 * bflo(cq.x), e0 * bfhi(a.x) + e1 * bfhi(bq.x) + e2 * bfhi(cq.x));
                w.y = pk2(e0 * bflo(a.y) + e1 * bflo(bq.y) + e2 * bflo(cq.y), e0 * bfhi(a.y) + e1 * bfhi(bq.y) + e2 * bfhi(cq.y));
                w.z = pk2(e0 * bflo(a.z) + e1 * bflo(bq.z) + e2 * bflo(cq.z), e0 * bfhi(a.z) + e1 * bfhi(bq.z) + e2 * bfhi(cq.z));
                w.w = pk2(e0 * bflo(a.w) + e1 * bflo(bq.w) + e2 * bflo(cq.w), e0 * bfhi(a.w) + e1 * bfhi(bq.w) + e2 * bfhi(cq.w));
                const int t = tj >> 3, j = tj & 7;
                *(u32x4*)(CAT + (size_t)t * 1536 + j * HD + 8 * c8) = w; }
        } else {
            for (int rep_ = 0; rep_ < REP_ATT * REP_B1; ++rep_)
            for (int it = bid; it < 256; it += G) cmp_sel_wg(lds, PROJ, KCV, KCV + (size_t)2048 * 256, OCMP, SEL, it >> 6, (it >> 4) & 3, it & 15, opq_tid());
            for (int rs_ = 0; rs_ < REP_SYNC; ++rs_) xcd_barrier(gbar);
            for (int rep_ = 0; rep_ < REP_ATT * REP_B2; ++rep_)
            for (int kq = bid; kq < 1024; kq += G) {
                const int rnd = kq >> 8, pos = kq & 255, it = rnd * 256 + ((rnd & 1) ? (255 - pos) : pos);
                if (it < 768) { const int qb = 15 - it / 48, bh = it % 48; nsa_attn_wg(lds, PROJ, KVS, SEL, OCMP, CAT, bh / 12, bh % 12, qb, opq_tid()); }
                else { const int u = it - 768; mem_attn_wg(lds, PROJ, 18, 12, MEMKV, l, CAT, 2048, 1536, u >> 6, (u >> 4) & 3, u & 15, opq_tid()); }
            }
        }
        for (int rs_ = 0; rs_ < REP_SYNC; ++rs_) xcd_barrier(gbar);
        for (int hf = 0; hf < 2; ++hf) {
            if (hf == 1) { pg8::Gemm g{XH, (const bf16_t*)(ws + WS_WGU + l * SZ_WGU), NTOK, 11264, 2048}; pg8::StaticOrder S; S.init(NTOK, 11264, G, bid);
                pg8::EpiSwiGLU E{PROJ, DFF}; for (int rep_ = 0; rep_ < REP_GEMM; ++rep_) pg8::gemm_phase(lds, g, S, E); for (int rs_ = 0; rs_ < REP_SYNC; ++rs_) xcd_barrier(gbar); }
            { pg8::Gemm g; g.M = NTOK; g.N = 2048;
              if (hf == 0) { g.A = CAT; g.K = isA ? 1536 : 2048; g.Bt = isA ? (const bf16_t*)(ws + WS_WAOUT + l * SZ_WAOUT) : (const bf16_t*)(ws + WS_WBOUT + (l - 2) * SZ_WBOUT); }
              else { g.A = PROJ; g.K = DFF; g.Bt = (const bf16_t*)(ws + WS_WDOWN + l * SZ_WDOWN); }
              pg8::StaticOrder S; S.init(NTOK, 2048, G, bid); pg8::EpiBf16<0> E{OBF, 2048, 0, 11}; for (int rep_ = 0; rep_ < REP_GEMM; ++rep_) pg8::gemm_phase(lds, g, S, E); }
            for (int rs_ = 0; rs_ < REP_SYNC; ++rs_) xcd_barrier(gbar);
            const float* gain = p.in[I_NORMG] + (l * 5 + (hf == 0 ? 1 : 3)) * 2048;
            for (int m = gw; m < NTOK; m += ngw) rowop_row(X + (size_t)m * 2048, OBF + (size_t)m * 2048, gain, XH + (size_t)m * 2048, opq_tid() & 63);
            for (int rs_ = 0; rs_ < REP_SYNC; ++rs_) xcd_barrier(gbar);
        }
    }
}

extern "C" void kernel_launch(void* const* d_in, const int* in_sizes, int n_in, void* d_out, int out_size, void* d_ws, size_t ws_size, hipStream_t stream) {
    static int grid_blocks = 0;
    if (grid_blocks == 0) {
        if (n_in != 17 || ws_size < WS_END) { fprintf(stderr, "kernel_launch: unexpected n_in %d or ws_size %zu (< %zu)\n", n_in, ws_size, (size_t)WS_END); grid_blocks = -1; return; }
        int dev = 0, cus = 0, per_cu = 0;
        hipGetDevice(&dev);
        hipDeviceGetAttribute(&cus, hipDeviceAttributeMultiprocessorCount, dev);
        hipFuncSetAttribute((const void*)mega_fwd, hipFuncAttributeMaxDynamicSharedMemorySize, LDS_BYTES);
        hipOccupancyMaxActiveBlocksPerMultiprocessor(&per_cu, (const void*)mega_fwd, NTHREADS, LDS_BYTES);
        if (per_cu < 1) per_cu = 1;
        if (per_cu > 1) per_cu = 1;
        grid_blocks = cus * per_cu;
        (void)hipGetLastError();
    }
    if (grid_blocks < 0) return;
    static Params p;
    memset(&p, 0, sizeof(p));
    for (int i = 0; i < 17; ++i) p.in[i] = (const float*)d_in[i];
    p.out = (float*)d_out; p.ws = (unsigned char*)d_ws;
    {
        int n = 0;
        auto add = [&](int in_idx, size_t in_off, int gain_idx, int gain_off, size_t dst_off, int ldw, int col0, int ncols, int K, int nrows, int mode) {
            JobDesc& d = p.jobs[n++]; d.in_idx = in_idx; d.in_off = in_off; d.gain_idx = gain_idx; d.gain_off = gain_off; d.dst_off = dst_off; d.ldw = ldw; d.col0 = col0; d.ncols = ncols; d.K = K; d.nrows = nrows; d.mode = mode; d.pad = 0; };
        for (int l = 0; l < 4; ++l) add(I_WGU, (size_t)l * 2048 * 11264, I_NORMG, (l * 5 + 2) * 2048, WS_WGU + l * SZ_WGU, 11264, 0, 11264, 2048, 11264, 1);
        for (int l = 0; l < 4; ++l) add(I_WDOWN, (size_t)l * 5632 * 2048, -1, 0, WS_WDOWN + l * SZ_WDOWN, 2048, 0, 2048, 5632, 2048, 0);
        for (int l = 0; l < 2; ++l) add(I_AWIN, (size_t)l * 2048 * A_COLS, I_NORMG, (l * 5 + 0) * 2048, WS_WAIN + l * SZ_WAIN, A_COLS, 0, A_COLS, 2048, A_COLS, 0);
        for (int l = 0; l < 2; ++l) add(I_AWOUT, (size_t)l * 1536 * 2048, -1, 0, WS_WAOUT + l * SZ_WAOUT, 2048, 0, 2048, 1536, 2048, 0);
        for (int lb = 0; lb < 2; ++lb) {
            const size_t src = (size_t)lb * 2048 * B_COLS_SRC, dst = WS_WBIN + lb * SZ_WBIN; const int go = ((2 + lb) * 5 + 0) * 2048;
            add(I_BWIN, src, I_NORMG, go, dst, B_COLS_SRC, 0, 1536, 2048, 1536, 0);
            add(I_BWIN, src, I_NORMG, go, dst + (size_t)1536 * 2048 * 2, B_COLS_SRC, 1572, 512, 2048, 512, 0);
            add(I_BWIN, src, I_NORMG, go, dst + (size_t)2048 * 2048 * 2, B_COLS_SRC, 1536, 36, 2048, 256, 0);
        }
        for (int lb = 0; lb < 2; ++lb) add(I_BWOUT, (size_t)lb * 2048 * 2048, -1, 0, WS_WBOUT + lb * SZ_WBOUT, 2048, 0, 2048, 2048, 2048, 0);
        for (int l = 0; l < 4; ++l) add(I_MEMWKV, (size_t)l * 2048 * 1024, I_NORMG, (l * 5 + 4) * 2048, WS_WMEM + (size_t)l * 1024 * 2048 * 2, 1024, 0, 1024, 2048, 1024, 0);
        add(I_KVW, 0, I_KVNG, 0, WS_WKV, 3072, 0, 3072, 2048, 3072, 0);
        add(I_WK1, 0, -1, 0, WS_WC1, 512, 0, 512, 4096, 512, 0);
        add(I_WV1, 0, -1, 0, WS_WC1 + SZ_WC1, 512, 0, 512, 4096, 512, 0);
        add(I_WK2, 0, -1, 0, WS_WC2, 128, 0, 128, 512, 256, 0);
        add(I_WV2, 0, -1, 0, WS_WC2 + SZ_WC2, 128, 0, 128, 512, 256, 0);
        p.njobs = n;
    }
    (void)hipMemsetAsync((char*)d_ws + WS_BAR, 0, WS_BAR_BYTES, stream);
    void* args[] = {&p};
    hipError_t e = hipLaunchCooperativeKernel((const void*)mega_fwd, dim3(grid_blocks), dim3(NTHREADS), args, LDS_BYTES, stream);
    if (e != hipSuccess) fprintf(stderr, "cooperative launch failed: %s (grid %d)\n", hipGetErrorString(e), grid_blocks);
}
```

```cpp
#include <hip/hip_runtime.h>
#include <hip/hip_cooperative_groups.h>
#include <cstdio>
#include <cstring>
namespace cg = cooperative_groups;
#define REP_P0 1
#define REP_GEMM 1
#define REP_ATT 1
#define REP_ATTA 1
#define REP_B1 1
#define REP_B2 1
#define REP_SYNC 1
#define PROBE_ATT 0
#define TPROBE 0
#define STAGGER_US 0

#define LAS __attribute__((address_space(3)))
typedef unsigned short bf16_t;
typedef short bf16x8 __attribute__((ext_vector_type(8)));
typedef float f32x4 __attribute__((ext_vector_type(4)));
typedef float f32x2 __attribute__((ext_vector_type(2)));
typedef unsigned u32x4 __attribute__((ext_vector_type(4)));
typedef unsigned u32x2 __attribute__((ext_vector_type(2)));
typedef __bf16 bf16x2_t __attribute__((ext_vector_type(2)));

constexpr int D_MODEL = 2048, NTOK = 8192, SEQ = 2048, NBATCH = 4, DFF = 5632, HD = 128;
constexpr int A_COLS = 9728, B_COLS_SRC = 2084, B_COLS = 2304, NCMP = 127;
constexpr int NWAVES = 8, NTHREADS = 512;
constexpr int LDS_MAIN = 131072; constexpr int LDS_BYTES = LDS_MAIN + 64;

constexpr size_t SZ_WAIN = (size_t)A_COLS * 2048 * 2, SZ_WAOUT = (size_t)2048 * 1536 * 2, SZ_WBIN = (size_t)B_COLS * 2048 * 2, SZ_WBOUT = (size_t)2048 * 2048 * 2;
constexpr size_t SZ_WGU = (size_t)11264 * 2048 * 2, SZ_WDOWN = (size_t)2048 * 5632 * 2, SZ_WC1 = (size_t)512 * 4096 * 2, SZ_WC2 = (size_t)256 * 512 * 2;
constexpr size_t WS_WAIN = 0;
constexpr size_t WS_WAOUT = WS_WAIN + 2 * SZ_WAIN;
constexpr size_t WS_WBIN = WS_WAOUT + 2 * SZ_WAOUT;
constexpr size_t SZ_WKV = (size_t)3072 * 2048 * 2;
constexpr size_t WS_WKV = WS_WBIN + SZ_WBIN;
constexpr size_t WS_WBIN1 = WS_WKV + SZ_WKV;
constexpr size_t WS_WBOUT = WS_WBIN1 + SZ_WBIN;
constexpr size_t WS_WMEM = WS_WBOUT + 2 * SZ_WBOUT;
constexpr size_t WS_WGU = WS_WMEM + (size_t)4096 * 2048 * 2;
constexpr size_t WS_WDOWN = WS_WGU + 4 * SZ_WGU;
constexpr size_t WS_WC1 = WS_WDOWN + 4 * SZ_WDOWN;
constexpr size_t WS_WC2 = WS_WC1 + 2 * SZ_WC1;
constexpr size_t WS_PROJ = WS_WC2 + 2 * SZ_WC2;
constexpr size_t WS_OBUF = WS_PROJ + (size_t)NTOK * A_COLS * 2;
constexpr size_t WS_XH = WS_OBUF + (size_t)NTOK * 2048 * 4;
constexpr size_t WS_CAT = WS_XH + (size_t)NTOK * 2048 * 2;
constexpr size_t WS_KVS = WS_CAT + (size_t)NTOK * 2048 * 2;
constexpr size_t WS_MEMKV = WS_KVS + (size_t)NTOK * 3072 * 2;
constexpr size_t WS_MEMHAT = WS_MEMKV + (size_t)1024 * 4096 * 2;
constexpr size_t WS_HID = WS_MEMHAT + (size_t)1024 * 2048 * 2;
constexpr size_t WS_KCV = WS_HID + (size_t)2 * 2048 * 512 * 2;
constexpr size_t WS_SEL = WS_KCV + (size_t)2 * 2048 * 256 * 2;
constexpr size_t WS_XS = WS_SEL + (size_t)NTOK * 4 * 4;
constexpr size_t WS_UM = WS_XS + (size_t)NTOK * 4;
constexpr size_t WS_BAR = WS_UM + 4096;
constexpr size_t WS_BAR_BYTES = 16384;
constexpr size_t WS_END = WS_BAR + WS_BAR_BYTES;

#define LDS_WAIT() asm volatile("s_waitcnt lgkmcnt(0)" ::: "memory")
__device__ __forceinline__ unsigned f2bf(float f) { unsigned u = __builtin_bit_cast(unsigned, f); return (u + 0x7fffu + ((u >> 16) & 1u)) >> 16; }
__device__ __forceinline__ unsigned pk2(float lo, float hi) { const f32x2 v = {lo, hi}; return __builtin_bit_cast(unsigned, __builtin_convertvector(v, bf16x2_t)); }
__device__ __forceinline__ float bflo(unsigned w) { return __builtin_bit_cast(float, w << 16); }
__device__ __forceinline__ float bfhi(unsigned w) { return __builtin_bit_cast(float, w & 0xffff0000u); }
__device__ __forceinline__ float wave_sum(float v) {
#pragma unroll
    for (int o = 1; o < 64; o <<= 1) v += __shfl_xor(v, o);
    return v;
}
__device__ __forceinline__ float wave_max(float v) {
#pragma unroll
    for (int o = 1; o < 64; o <<= 1) v = fmaxf(v, __shfl_xor(v, o));
    return v;
}


#define XB_TMO      128
#define XB_XCNT(j)  (256  + 64 * (j))
#define XB_XSUB(j)  (1280 + 64 * (j))
#define XB_XGEN(j)  (2304 + 64 * (j))
#define XB_TOP      3328
#define XB_TOPGEN   3392
#define XCD_BAR_WORDS 3456
#define XB_SPIN_CAP (1u << 18)
__device__ __forceinline__ unsigned xb_ld(unsigned* p)              { return __hip_atomic_load(p, __ATOMIC_RELAXED, __HIP_MEMORY_SCOPE_AGENT); }
__device__ __forceinline__ unsigned xb_add(unsigned* p, unsigned v) { return __hip_atomic_fetch_add(p, v, __ATOMIC_RELAXED, __HIP_MEMORY_SCOPE_AGENT); }
__device__ __forceinline__ unsigned xb_xcc_id() { return (unsigned)__builtin_amdgcn_s_getreg((3 << 11) | 20) & 0xFu; }
#define XB_SPIN(cond, bar) do { unsigned _sp = 0; while (cond) { __builtin_amdgcn_s_sleep(1); \
    if ((++_sp & 255u) == 0u) { if (xb_ld(&(bar)[XB_TMO])) break; if (_sp > XB_SPIN_CAP) { atomicAdd(&(bar)[XB_TMO], 1u); break; } } } } while (0)
struct XcdBarrier { unsigned* bar; unsigned x; volatile LAS unsigned* st; };
__device__ __forceinline__ XcdBarrier xcd_barrier_post(unsigned* bar, volatile LAS unsigned* st) {
    XcdBarrier b; b.bar = bar; b.x = xb_xcc_id(); b.st = st;
    if (threadIdx.x == 0) (void)xb_add(&bar[XB_XCNT(b.x)], 1u);
    return b;
}
__device__ __forceinline__ void xcd_barrier_complete(unsigned* bar, unsigned x, unsigned& nloc, unsigned& nx) {
    const unsigned G = gridDim.x * gridDim.y * gridDim.z;
    unsigned sum, cnt, mine, sp = 0u;
    for (;;) {
        sum = 0u; cnt = 0u; mine = 0u;
#pragma unroll
        for (unsigned j = 0; j < 16; ++j) { const unsigned c = xb_ld(&bar[XB_XCNT(j)]); sum += c; cnt += (c > 0u) ? 1u : 0u; mine = (j == x) ? c : mine; }
        if (sum == G) break;
        __builtin_amdgcn_s_sleep(1);
        if ((++sp & 255u) == 0u) { if (xb_ld(&bar[XB_TMO])) break; if (sp > XB_SPIN_CAP) { atomicAdd(&bar[XB_TMO], 1u); break; } }
    }
    nloc = mine > 0u ? mine : 1u; nx = cnt > 0u ? cnt : 1u;
}
__device__ __forceinline__ void xcd_barrier(const XcdBarrier& b) {
    asm volatile("s_waitcnt vmcnt(0)" ::: "memory");
    __syncthreads();
    if (threadIdx.x == 0) {
        unsigned* bar = b.bar;
        __builtin_amdgcn_s_waitcnt(0);
        unsigned nloc = b.st[0], nx = b.st[1];
        if (nloc == 0u) { xcd_barrier_complete(bar, b.x, nloc, nx); b.st[0] = nloc; b.st[1] = nx; }
        const unsigned old = xb_add(&bar[XB_XSUB(b.x)], 1u);
        const unsigned gen = old / nloc;
        if (old + 1u == (gen + 1u) * nloc) {
            __builtin_amdgcn_fence(__ATOMIC_RELEASE, "agent");
            asm volatile("s_waitcnt vmcnt(0)" ::: "memory");
            const unsigned og = xb_add(&bar[XB_TOP], 1u);
            const unsigned tg = og / nx;
            if (og + 1u == (tg + 1u) * nx) xb_add(&bar[XB_TOPGEN], 1u);
            else XB_SPIN(xb_ld(&bar[XB_TOPGEN]) == tg, bar);
            __builtin_amdgcn_fence(__ATOMIC_ACQUIRE, "agent");
            xb_add(&bar[XB_XGEN(b.x)], 1u);
            asm volatile("s_waitcnt vmcnt(0)" ::: "memory");
        } else {
            XB_SPIN(xb_ld(&bar[XB_XGEN(b.x)]) == gen, bar);
            __builtin_amdgcn_fence(__ATOMIC_ACQUIRE, "agent");
            asm volatile("s_waitcnt vmcnt(0)" ::: "memory");
        }
    }
    __syncthreads();
}

namespace pg8 {
constexpr int BM = 256, BK = 64, HALF = 128, HTB = HALF * BK * 2, STAGE_BYTES = 8 * HTB, NXCD = 8, WGM = 8;
__device__ __forceinline__ int lds_byte(int r, int c) { const int st = (r >> 4) * 2 + (c >> 5), rr = r & 15, cc = c & 31, ob = rr * 64 + cc * 2; return st * 1024 + (ob ^ (((ob >> 9) & 1) << 5)); }
__device__ __forceinline__ void stage_rc(int b, int& R, int& C) { const int st = b / 1024, sb = b % 1024, swz = sb ^ (((sb >> 9) & 1) << 5); R = (st >> 1) * 16 + swz / 64; C = (st & 1) * 32 + (swz % 64) / 2; }
__device__ __forceinline__ int perm32(int rho) { const int n = rho >> 4, i = rho & 15; return 8 * (i >> 2) + 4 * n + (i & 3); }
struct Unit { int pm, pn; };
struct Gemm { const bf16_t* A; const bf16_t* Bt; int M, N, K; };
struct StaticOrder {
    int nM, nN, nwg, G, c;
    __device__ void init(int M, int N, int G_, int c_) { nM = M / BM; nN = N / BM; nwg = nM * nN; G = G_; c = c_; }
    __device__ bool next(int i, Unit& u) const {
        const long L = (long)i * G + c; if (L >= nwg) return false;
        int wgid = (int)L; { const int q = nwg / NXCD, r = nwg % NXCD, xcd = wgid % NXCD, off = wgid / NXCD; wgid = (xcd < r ? xcd * (q + 1) : r * (q + 1) + (xcd - r) * q) + off; }
        const int nig = WGM * nN, gid = wgid / nig, fm = gid * WGM, gsz = (nM - fm) < WGM ? (nM - fm) : WGM;
        u.pm = fm + ((wgid % nig) % gsz); u.pn = (wgid % nig) / gsz; return true;
    }
    __device__ __forceinline__ void a_ready(const Unit&) const {}
    __device__ __forceinline__ void done(const Unit&) const {}
};
__device__ __forceinline__ unsigned cvt_pk_bf16(float lo, float hi) { const f32x2 v = {lo, hi}; return __builtin_bit_cast(unsigned, __builtin_convertvector(v, bf16x2_t)); }

struct EpiF32 {
    static constexpr bool PERM = false;
    float* C; int ldc;
    __device__ __forceinline__ void operator()(const f32x4 (&acc)[2][2][4][2], const Unit& u, int wr, int wc, int fr, int fq) const {
        const int row0 = u.pm * BM + wr * 64 + fr, col0 = u.pn * BM + wc * 32 + 4 * fq;
#pragma unroll
        for (int ai = 0; ai < 2; ++ai)
#pragma unroll
            for (int m = 0; m < 4; ++m) { float* rowp = C + (size_t)(row0 + ai * HALF + m * 16) * ldc + col0;
#pragma unroll
                for (int bj = 0; bj < 2; ++bj)
#pragma unroll
                    for (int n = 0; n < 2; ++n) *(f32x4*)(rowp + bj * HALF + n * 16) = acc[ai][bj][m][n]; }
    }
};
__device__ __forceinline__ float gelu_tanh(float x) { const float t = 1.5957691216f * (x + 0.044715f * x * x * x); return x / (1.0f + __expf(-t)); }
template <int ACT  > struct EpiBf16 {
    static constexpr bool PERM = true;
    bf16_t* O; int ldc;
    int hm_heads, seq_shift; int split_pn; bf16_t* O2; int hm2;
    __device__ __forceinline__ void operator()(const f32x4 (&acc)[2][2][4][2], const Unit& u, int wr, int wc, int fr, int fq) const {
        const int row0 = u.pm * BM + wr * 64 + fr, col0 = u.pn * BM + wc * 32 + 8 * fq;
#pragma unroll
        for (int ai = 0; ai < 2; ++ai)
#pragma unroll
            for (int m = 0; m < 4; ++m) { const int row = row0 + ai * HALF + m * 16;
#pragma unroll
                for (int bj = 0; bj < 2; ++bj) { f32x4 v0 = acc[ai][bj][m][0], v1 = acc[ai][bj][m][1];
                    if (ACT == 1) {
#pragma unroll
                        for (int j = 0; j < 4; ++j) { v0[j] = gelu_tanh(v0[j]); v1[j] = gelu_tanh(v1[j]); } }
                    u32x4 w; w.x = cvt_pk_bf16(v0[0], v0[1]); w.y = cvt_pk_bf16(v0[2], v0[3]); w.z = cvt_pk_bf16(v1[0], v1[1]); w.w = cvt_pk_bf16(v1[2], v1[3]);
                    bf16_t* dst;
                    if (hm_heads > 0) { const bool second = u.pn >= split_pn; bf16_t* base = second ? O2 : O; const int nh = second ? hm2 : hm_heads;
                        const int col = col0 + bj * HALF - (second ? split_pn * BM : 0), b = row >> seq_shift, sq = row & ((1 << seq_shift) - 1);
                        dst = base + ((((size_t)(b * nh + (col >> 7))) << seq_shift) + sq) * 128 + (col & 127); }
                    else dst = O + (size_t)row * ldc + col0 + bj * HALF;
                    *(u32x4*)dst = w; } }
    }
};
struct EpiSwiGLU {
    static constexpr bool PERM = true;
    bf16_t* O; int ldc;
    __device__ __forceinline__ void operator()(const f32x4 (&acc)[2][2][4][2], const Unit& u, int wr, int wc, int fr, int fq) const {
        const int row0 = u.pm * BM + wr * 64 + fr, col0 = u.pn * HALF + wc * 32 + 8 * fq;
#pragma unroll
        for (int ai = 0; ai < 2; ++ai)
#pragma unroll
            for (int m = 0; m < 4; ++m) { bf16_t* rowp = O + (size_t)(row0 + ai * HALF + m * 16) * ldc + col0;
                f32x4 v0, v1;
#pragma unroll
                for (int j = 0; j < 4; ++j) { const float g0 = acc[ai][0][m][0][j], g1 = acc[ai][0][m][1][j];
                    v0[j] = g0 / (1.0f + __expf(-g0)) * acc[ai][1][m][0][j]; v1[j] = g1 / (1.0f + __expf(-g1)) * acc[ai][1][m][1][j]; }
                u32x4 w; w.x = cvt_pk_bf16(v0[0], v0[1]); w.y = cvt_pk_bf16(v0[2], v0[3]); w.z = cvt_pk_bf16(v1[0], v1[1]); w.w = cvt_pk_bf16(v1[2], v1[3]);
                *(u32x4*)rowp = w; }
    }
};

template <class Epi, class Sched>
__device__ __forceinline__ void gemm_phase(LAS unsigned char* lds, const Gemm g, const Sched& S, const Epi& E) {
    int tid_ = threadIdx.x; asm volatile("" : "+v"(tid_));
    const int tid = tid_, wid = __builtin_amdgcn_readfirstlane(tid >> 6), lane = tid & 63, wr = wid >> 2, wc = wid & 3, fr = lane & 15, fq = lane >> 4;
    const int K = g.K, nt = K / BK;
    unsigned voffA[2], voffB[2];
#pragma unroll
    for (int i = 0; i < 2; ++i) { int R, C; stage_rc(tid * 16 + i * 8192, R, C); const int Rb = Epi::PERM ? ((R & ~31) + perm32(R & 31)) : R;
        voffA[i] = (unsigned)(R * K + C) * 2u; voffB[i] = (unsigned)(Rb * K + C) * 2u; }
    const size_t kstep = (size_t)(BK * 2);
    const size_t hstep = (size_t)HALF * K * 2;
    const size_t tstep = 2 * hstep;
    const unsigned ldsw = (unsigned)wid * 1024u;
    const int aoff = lds_byte(wr * 64 + fr, fq * 8), boff = lds_byte(wc * 32 + fr, fq * 8);
#define PG8_SA(b, h) (((b) * 2 + (h)) * HTB)
#define PG8_SB(b, h) ((4 + (b) * 2 + (h)) * HTB)
#define PG8_STAGE(bufoff, gbase, voff) do { _Pragma("unroll") for (int _i = 0; _i < 2; ++_i) \
        __builtin_amdgcn_global_load_lds((const unsigned*)((const char*)(gbase) + (voff)[_i]), (LAS unsigned*)(lds + (bufoff) + ldsw + _i * 8192), 16, 0, 0); } while (0)
#define PG8_LDA(dst, b, h) do { _Pragma("unroll") for (int m = 0; m < 4; ++m) _Pragma("unroll") for (int k = 0; k < 2; ++k) dst[m][k] = *(const LAS bf16x8*)(lds + PG8_SA(b, h) + aoff + m * 2048 + k * 1024); } while (0)
#define PG8_LDB(dst, b, h) do { _Pragma("unroll") for (int n = 0; n < 2; ++n) _Pragma("unroll") for (int k = 0; k < 2; ++k) dst[n][k] = *(const LAS bf16x8*)(lds + PG8_SB(b, h) + boff + n * 2048 + k * 1024); } while (0)
#define PG8_MMA(ai, bj, At, Bt) do { __builtin_amdgcn_s_setprio(1); _Pragma("unroll") for (int m = 0; m < 4; ++m) _Pragma("unroll") for (int n = 0; n < 2; ++n) _Pragma("unroll") for (int k = 0; k < 2; ++k) \
        acc[ai][bj][m][n] = __builtin_amdgcn_mfma_f32_16x16x32_bf16(Bt[n][k], At[m][k], acc[ai][bj][m][n], 0, 0, 0); __builtin_amdgcn_s_setprio(0); } while (0)
#define PG8_WAIT_V(n) asm volatile("s_waitcnt vmcnt(" #n ")" ::: "memory")
#define PG8_WAIT_L(n) asm volatile("s_waitcnt lgkmcnt(" #n ")" ::: "memory")
#define PG8_BAR __builtin_amdgcn_s_barrier()
#define PG8_SCHED __builtin_amdgcn_sched_barrier(0)
    Unit cur, nxt; int ui = 0;
    if (!S.next(0, cur)) return;
    f32x4 acc[2][2][4][2];
#pragma unroll
    for (int a = 0; a < 2; ++a)
#pragma unroll
        for (int b = 0; b < 2; ++b)
#pragma unroll
            for (int m = 0; m < 4; ++m)
#pragma unroll
                for (int n = 0; n < 2; ++n) acc[a][b][m][n] = (f32x4){0.f, 0.f, 0.f, 0.f};
    bf16x8 At[4][2], B0[2][2], B1[2][2];
    const char* cA = (const char*)g.A + (size_t)cur.pm * tstep; const char* cB = (const char*)g.Bt + (size_t)cur.pn * tstep;
    S.a_ready(cur);
    PG8_STAGE(PG8_SB(0, 0), cB, voffB); PG8_STAGE(PG8_SA(0, 0), cA, voffA); PG8_STAGE(PG8_SB(0, 1), cB + hstep, voffB); PG8_STAGE(PG8_SA(0, 1), cA + hstep, voffA);
    if (wr == 1) PG8_BAR;
    PG8_WAIT_V(4); PG8_BAR;
    PG8_STAGE(PG8_SB(1, 0), cB + kstep, voffB); PG8_STAGE(PG8_SA(1, 0), cA + kstep, voffA); PG8_STAGE(PG8_SB(1, 1), cB + hstep + kstep, voffB);
    PG8_WAIT_V(6); PG8_BAR;
    for (;;) {
        const bool has_next = S.next(ui + 1, nxt);
        const char* nA = has_next ? (const char*)g.A + (size_t)nxt.pm * tstep : cA; const char* nB = has_next ? (const char*)g.Bt + (size_t)nxt.pn * tstep : cB;
        for (int t = 0; t < nt; t += 2) {
            const bool last = (t == nt - 2);
            const char* a1 = cA + (size_t)(t + 1) * kstep;
            const char* a2 = last ? nA : cA + (size_t)(t + 2) * kstep; const char* b2 = last ? nB : cB + (size_t)(t + 2) * kstep;
            const char* a3 = a2 + kstep; const char* b3 = b2 + kstep;
            if (last && has_next) S.a_ready(nxt);
            PG8_LDB(B0, 0, 0); PG8_SCHED; PG8_LDA(At, 0, 0); PG8_STAGE(PG8_SA(1, 1), a1 + hstep, voffA);
            PG8_WAIT_L(8); PG8_BAR; PG8_WAIT_L(0); PG8_MMA(0, 0, At, B0); PG8_BAR; PG8_SCHED;
            PG8_LDB(B1, 0, 1); PG8_STAGE(PG8_SB(0, 0), b2, voffB);
            PG8_BAR; PG8_WAIT_L(0); PG8_MMA(0, 1, At, B1); PG8_BAR;
            PG8_LDA(At, 0, 1); PG8_STAGE(PG8_SA(0, 0), a2, voffA);
            PG8_BAR; PG8_WAIT_L(0); PG8_MMA(1, 0, At, B0); PG8_BAR; PG8_SCHED;
            PG8_STAGE(PG8_SB(0, 1), b2 + hstep, voffB);
            PG8_WAIT_V(6); PG8_BAR; PG8_MMA(1, 1, At, B1); PG8_BAR;
            PG8_LDB(B0, 1, 0); PG8_SCHED; PG8_LDA(At, 1, 0); PG8_STAGE(PG8_SA(0, 1), a2 + hstep, voffA);
            PG8_WAIT_L(8); PG8_BAR; PG8_WAIT_L(0); PG8_MMA(0, 0, At, B0); PG8_BAR; PG8_SCHED;
            PG8_LDB(B1, 1, 1); PG8_STAGE(PG8_SB(1, 0), b3, voffB);
            PG8_BAR; PG8_WAIT_L(0); PG8_MMA(0, 1, At, B1); PG8_BAR;
            PG8_LDA(At, 1, 1); PG8_STAGE(PG8_SA(1, 0), a3, voffA);
            PG8_BAR; PG8_WAIT_L(0); PG8_MMA(1, 0, At, B0); PG8_BAR; PG8_SCHED;
            PG8_STAGE(PG8_SB(1, 1), b3 + hstep, voffB);
            PG8_WAIT_V(6); PG8_BAR; PG8_MMA(1, 1, At, B1); PG8_BAR;
        }
        E(acc, cur, wr, wc, fr, fq); S.done(cur);
        if (!has_next) break;
#pragma unroll
        for (int a = 0; a < 2; ++a)
#pragma unroll
            for (int b = 0; b < 2; ++b)
#pragma unroll
                for (int m = 0; m < 4; ++m)
#pragma unroll
                    for (int n = 0; n < 2; ++n) acc[a][b][m][n] = (f32x4){0.f, 0.f, 0.f, 0.f};
        cur = nxt; cA = nA; cB = nB; ++ui;
    }
    PG8_WAIT_V(0);
    if (wr == 0) PG8_BAR;
    PG8_BAR;
#undef PG8_SA
#undef PG8_SB
#undef PG8_STAGE
#undef PG8_LDA
#undef PG8_LDB
#undef PG8_MMA
#undef PG8_WAIT_V
#undef PG8_WAIT_L
#undef PG8_BAR
#undef PG8_SCHED
}
}

struct JobDesc { unsigned long long in_off, dst_off; int in_idx, gain_idx, gain_off, ldw, col0, ncols, K, nrows, mode, pad; };
constexpr int MAXJOBS = 32;
struct Params { const float* in[17]; float* out; unsigned char* ws; JobDesc jobs[MAXJOBS]; int njobs, pad; };
enum { I_X = 0, I_MEM, I_NORMG, I_AWIN, I_AWOUT, I_BWIN, I_BWOUT, I_MEMWKV, I_WGU, I_WDOWN, I_KVNG, I_KVW, I_PE, I_WK1, I_WK2, I_WV1, I_WV2 };

struct ConvJob { const float* W; const float* gain; bf16_t* dst; int ldw, col0, ncols, K, nrows, mode; };
__device__ __forceinline__ bool conv_get(const Params& p, int j, ConvJob& J) {
    if (j >= p.njobs) return false;
    const JobDesc& d = p.jobs[j];
    J.W = p.in[d.in_idx] + d.in_off; J.gain = d.gain_idx >= 0 ? p.in[d.gain_idx] + d.gain_off : nullptr; J.dst = (bf16_t*)(p.ws + d.dst_off);
    J.ldw = d.ldw; J.col0 = d.col0; J.ncols = d.ncols; J.K = d.K; J.nrows = d.nrows; J.mode = d.mode;
    return true;
}
__device__ __forceinline__ void conv_load(const ConvJob& J, int it, int nblk, int lane, f32x4 (&v)[16]) {
    const int kb = it / nblk, nb = it - kb * nblk, k0 = 64 * kb, n = 64 * nb + 4 * (lane & 15), kr = lane >> 4;
    const bool ok = n < J.ncols;
    const int sc = J.mode == 1 ? (((n >> 7) & 1) * 5632 + (n >> 8) * 128 + (n & 127)) : (J.col0 + n);
    const float* src = J.W + (size_t)(k0 + kr) * J.ldw + sc;
#pragma unroll
    for (int i = 0; i < 16; ++i) v[i] = ok ? *(const f32x4*)(src + (size_t)(4 * i) * J.ldw) : (f32x4){0.f, 0.f, 0.f, 0.f};
}
__device__ __forceinline__ void conv_emit(const ConvJob& J, LAS float* scr, int it, int nblk, int lane, const f32x4 (&cur)[16]) {
    const int c4 = lane & 15, kr = lane >> 4, nb8 = lane >> 3, c = lane & 7;
    const int kb = it / nblk, nb = it - kb * nblk, k0 = 64 * kb, n0 = 64 * nb;
#pragma unroll
    for (int i = 0; i < 16; ++i) *(LAS f32x4*)(scr + (kr + 4 * i) * 64 + ((c4 ^ (i >> 1)) << 2)) = cur[i];
    LDS_WAIT();
    f32x4 g0 = {1.f, 1.f, 1.f, 1.f}, g1 = {1.f, 1.f, 1.f, 1.f};
    if (J.gain) { g0 = *(const f32x4*)(J.gain + k0 + 8 * c); g1 = *(const f32x4*)(J.gain + k0 + 8 * c + 4); }
#pragma unroll
    for (int j = 0; j < 8; ++j) { const int n = nb8 + 8 * j; const LAS float* t = scr + (8 * c) * 64 + ((((n >> 2) ^ c) << 2) | (n & 3));
        u32x4 o; o.x = pk2(t[0 * 64] * g0[0], t[1 * 64] * g0[1]); o.y = pk2(t[2 * 64] * g0[2], t[3 * 64] * g0[3]); o.z = pk2(t[4 * 64] * g1[0], t[5 * 64] * g1[1]); o.w = pk2(t[6 * 64] * g1[2], t[7 * 64] * g1[3]);
        *(u32x4*)(J.dst + (size_t)(n0 + n) * J.K + k0 + 8 * c) = o; }
    LDS_WAIT();
}
__device__ __forceinline__ void conv_run(const ConvJob& J, LAS float* scr, int gw, int ngw, int lane) {
    const int nblk = J.nrows / 64, kblk = J.K / 64, items = nblk * kblk;
    f32x4 bufA[16], bufB[16];
    int it = gw;
    if (it < items) conv_load(J, it, nblk, lane, bufA);
    while (it < items) {
        if (it + ngw < items) conv_load(J, it + ngw, nblk, lane, bufB);
        conv_emit(J, scr, it, nblk, lane, bufA);
        it += ngw; if (it >= items) break;
        if (it + ngw < items) conv_load(J, it + ngw, nblk, lane, bufA);
        conv_emit(J, scr, it, nblk, lane, bufB);
        it += ngw;
    }
}

__device__ __forceinline__ void rms_row(const float* xrow, bf16_t* orow, float* scale_out, int lane) {
    const f32x4* xr = (const f32x4*)xrow + lane;
    f32x4 v[8]; float s = 0.f;
#pragma unroll
    for (int j = 0; j < 8; ++j) { v[j] = xr[64 * j]; s += (v[j].x * v[j].x + v[j].y * v[j].y) + (v[j].z * v[j].z + v[j].w * v[j].w); }
    const float ms = wave_sum(s) * (1.f / 2048.f) + 1e-6f, rs = rsqrtf(ms);
    u32x2* o8 = (u32x2*)orow + lane;
#pragma unroll
    for (int j = 0; j < 8; ++j) { u32x2 w; w.x = pk2(v[j].x * rs, v[j].y * rs); w.y = pk2(v[j].z * rs, v[j].w * rs); o8[64 * j] = w; }
    if (scale_out && lane == 0) *scale_out = sqrtf(ms);
}
__device__ __forceinline__ void rowop_row(bf16_t* hrow, float* scale, const bf16_t* orow, const float* gain, float* outrow, int lane) {
    const u32x2* o2 = (const u32x2*)orow + lane; u32x2* h2 = (u32x2*)hrow + lane; const f32x4* g4 = (const f32x4*)gain + lane;
    const float sc = *scale;
    f32x4 o[8]; float s = 0.f;
#pragma unroll
    for (int j = 0; j < 8; ++j) { const u32x2 w = o2[64 * j]; o[j] = (f32x4){bflo(w.x), bfhi(w.x), bflo(w.y), bfhi(w.y)}; s += (o[j].x * o[j].x + o[j].y * o[j].y) + (o[j].z * o[j].z + o[j].w * o[j].w); }
    const float rs = rsqrtf(wave_sum(s) * (1.f / 2048.f) + 1e-6f);
    float s2 = 0.f;
#pragma unroll
    for (int j = 0; j < 8; ++j) { const f32x4 g = g4[64 * j]; const u32x2 w = h2[64 * j]; f32x4 x = (f32x4){bflo(w.x), bfhi(w.x), bflo(w.y), bfhi(w.y)} * sc; x = x + o[j] * rs * g; o[j] = x; s2 += (x.x * x.x + x.y * x.y) + (x.z * x.z + x.w * x.w); }
    if (outrow) { f32x4* x4 = (f32x4*)outrow + lane;
#pragma unroll
        for (int j = 0; j < 8; ++j) x4[64 * j] = o[j];
        return; }
    const float ms2 = wave_sum(s2) * (1.f / 2048.f) + 1e-6f, rs2 = rsqrtf(ms2);
#pragma unroll
    for (int j = 0; j < 8; ++j) { u32x2 w; w.x = pk2(o[j].x * rs2, o[j].y * rs2); w.y = pk2(o[j].z * rs2, o[j].w * rs2); h2[64 * j] = w; }
    if (lane == 0) *scale = sqrtf(ms2);
}

typedef short s16x4 __attribute__((ext_vector_type(4)));
constexpr int AT_ROWB = 272, AT_TILEB = 64 * AT_ROWB, AT_STAGEB = 2 * AT_TILEB;
constexpr int AT_AUX = 2 * AT_STAGEB;
constexpr float SCALE2 = 0.12751743f;
constexpr float LOG2E = 1.4426950408889634f, LN2 = 0.6931471805599453f;
struct AttnArgs {
    const bf16_t* q; size_t qstride;
    const bf16_t* k; const bf16_t* v; size_t kvstride;
    unsigned tilemask;
    int nkeys, qpos0, kmul, maxdist;
    float slope2;
    int nrows;
};
__device__ __forceinline__ void at_gload(const AttnArgs& A, int kt, int tid, u32x4 (&kr)[2], u32x4 (&vr)[2]) {
#pragma unroll
    for (int i = 0; i < 2; ++i) { const int id = tid + 512 * i, row = id >> 4, c16 = id & 15; const size_t off = (size_t)(64 * kt + row) * A.kvstride + 8 * c16;
        kr[i] = *(const u32x4*)(A.k + off); vr[i] = *(const u32x4*)(A.v + off); }
}
__device__ __forceinline__ void at_lstore(LAS unsigned char* st, int tid, const u32x4 (&kr)[2], const u32x4 (&vr)[2]) {
#pragma unroll
    for (int i = 0; i < 2; ++i) { const int id = tid + 512 * i, row = id >> 4, c16 = id & 15;
        *(LAS u32x4*)(st + row * AT_ROWB + c16 * 16) = kr[i];
        const int prow = (row & ~12) | (((row >> 2) & 1) << 3) | (((row >> 3) & 1) << 2), swz = ((prow & 3) << 2) | ((prow >> 2) & 3);
        *(LAS u32x4*)(st + AT_TILEB + prow * 256 + ((c16 ^ swz) << 4)) = vr[i]; }
}
__device__ __forceinline__ bf16x8 pack8(const f32x4& a, const f32x4& b) {
    u32x4 w; w.x = pg8::cvt_pk_bf16(a[0], a[1]); w.y = pg8::cvt_pk_bf16(a[2], a[3]); w.z = pg8::cvt_pk_bf16(b[0], b[1]); w.w = pg8::cvt_pk_bf16(b[2], b[3]);
    return __builtin_bit_cast(bf16x8, w);
}
__device__ __forceinline__ bf16x8 tr_pair(const LAS unsigned char* p0, const LAS unsigned char* p1) {
    const s16x4 lo = __builtin_amdgcn_ds_read_tr16_b64_v4i16((LAS s16x4*)p0), hi = __builtin_amdgcn_ds_read_tr16_b64_v4i16((LAS s16x4*)p1);
    return __builtin_shufflevector(lo, hi, 0, 1, 2, 3, 4, 5, 6, 7);
}
struct AttnPre { bf16x8 qf[2][4]; u32x4 kA[2], vA[2], kB[2], vB[2]; };
__device__ __forceinline__ void attn_issue_q(const AttnArgs& A, int tid, AttnPre& P) {
    const int lane = tid & 63, wave = tid >> 6, fr = lane & 15, fq = lane >> 4;
#pragma unroll
    for (int rb = 0; rb < 2; ++rb) { const bf16_t* qp = A.q + (size_t)(wave * 32 + rb * 16 + fr) * A.qstride + 8 * fq;
#pragma unroll
        for (int dc = 0; dc < 4; ++dc) P.qf[rb][dc] = *(const bf16x8*)(qp + 32 * dc); }
}
__device__ __forceinline__ void attn_issue_kv(const AttnArgs& A, int tid, AttnPre& P) {
    unsigned tm = A.tilemask;
    if (tm == 0u) return;
    const int k0 = 31 - __builtin_clz(tm); tm &= ~(1u << k0);
    at_gload(A, k0, tid, P.kA, P.vA);
    if (tm) { const int k1 = 31 - __builtin_clz(tm); at_gload(A, k1, tid, P.kB, P.vB); }
}
template <bool USE_SEL>
__device__ __forceinline__ void attn_run(LAS unsigned char* lds, const AttnArgs& A, const unsigned (&selmask)[2], int tid, AttnPre& P, f32x4 (&o)[2][8], float (&m)[2], float (&l)[2]) {
    const int lane = tid & 63, wave = __builtin_amdgcn_readfirstlane(tid >> 6), fr = lane & 15, fq = lane >> 4;
    bf16x8 (&qf)[2][4] = P.qf;
#pragma unroll
    for (int rb = 0; rb < 2; ++rb) { m[rb] = -INFINITY; l[rb] = 0.f;
#pragma unroll
        for (int db = 0; db < 8; ++db) o[rb][db] = (f32x4){0.f, 0.f, 0.f, 0.f}; }
    unsigned tm = A.tilemask;
    if (tm == 0u) return;
    const int wr0 = 32 * wave, wq0 = A.qpos0 + wr0;
    const int qp0 = A.qpos0 + wr0 + fr;
    const bool nomask = A.kmul == 0;
    auto tile = [&](const int kt, const LAS unsigned char* st) {
        if (wr0 >= A.nrows) return;
        const int dlo = wq0 - 64 * kt - 63, dhi = wq0 + 31 - 64 * kt;
        bool tsel[2]; tsel[0] = USE_SEL ? (((selmask[0] >> kt) & 1u) != 0u) : true; tsel[1] = USE_SEL ? (((selmask[1] >> kt) & 1u) != 0u) : true;
        if (!nomask && (dhi < 0 || dlo > A.maxdist || (USE_SEL && !__any(tsel[0] || tsel[1])))) return;
        const bool interior = nomask || (dlo >= 0 && dhi <= A.maxdist && (!USE_SEL || __all(tsel[0] && tsel[1])));
        f32x4 s[2][4];
        { const LAS unsigned char* kbase = st + fr * AT_ROWB + fq * 16;
#pragma unroll
          for (int kb = 0; kb < 4; ++kb) { s[0][kb] = (f32x4){0.f, 0.f, 0.f, 0.f}; s[1][kb] = (f32x4){0.f, 0.f, 0.f, 0.f};
#pragma unroll
              for (int dc = 0; dc < 4; ++dc) { const bf16x8 kf = *(const LAS bf16x8*)(kbase + kb * 16 * AT_ROWB + dc * 64);
                  s[0][kb] = __builtin_amdgcn_mfma_f32_16x16x32_bf16(kf, qf[0][dc], s[0][kb], 0, 0, 0); s[1][kb] = __builtin_amdgcn_mfma_f32_16x16x32_bf16(kf, qf[1][dc], s[1][kb], 0, 0, 0); } } }
        float muse[2];
        bool moved = false;
#pragma unroll
        for (int rb = 0; rb < 2; ++rb) {
            const int D0r = qp0 + 16 * rb - 64 * kt - 4 * fq, D0 = (USE_SEL && !tsel[rb]) ? -(1 << 30) : D0r;
            const float B0 = nomask ? 0.f : -A.slope2 * (float)D0r;
            float tmax = -INFINITY;
            if (interior) {
#pragma unroll
                for (int kb = 0; kb < 4; ++kb)
#pragma unroll
                    for (int e = 0; e < 4; ++e) { const float x = fmaf(s[rb][kb][e], SCALE2, fmaf(A.slope2, (float)(16 * kb + e), B0)); s[rb][kb][e] = x; tmax = fmaxf(tmax, x); }
            } else {
#pragma unroll
                for (int kb = 0; kb < 4; ++kb)
#pragma unroll
                    for (int e = 0; e < 4; ++e) { const bool valid = (unsigned)(D0 - (16 * kb + e)) <= (unsigned)A.maxdist;
                        const float x = valid ? fmaf(s[rb][kb][e], SCALE2, fmaf(A.slope2, (float)(16 * kb + e), B0)) : -INFINITY; s[rb][kb][e] = x; tmax = fmaxf(tmax, x); }
            }
            tmax = fmaxf(tmax, __shfl_xor(tmax, 16)); tmax = fmaxf(tmax, __shfl_xor(tmax, 32));
            const float mnew = fmaxf(m[rb], tmax); muse[rb] = (mnew == -INFINITY) ? 0.f : mnew;
            moved = moved || (mnew != m[rb]);
            if (!__all(mnew == m[rb])) {
                const float alpha = __builtin_amdgcn_exp2f(m[rb] - muse[rb]);
                l[rb] *= alpha;
#pragma unroll
                for (int db = 0; db < 8; ++db) o[rb][db] *= alpha;
            }
            m[rb] = mnew;
#pragma unroll
            for (int kb = 0; kb < 4; ++kb)
#pragma unroll
                for (int e = 0; e < 4; ++e) { const float pv = __builtin_amdgcn_exp2f(s[rb][kb][e] - muse[rb]); s[rb][kb][e] = pv; l[rb] += pv; }
        }
        (void)moved;
        const int vq = fr >> 2, vp = fr & 3, vS = (vq << 2) | (2 * (fq & 1) + (fq >> 1)), vx0 = ((vp >> 1) ^ vS) & 1, vS14 = vS & 14;
        const LAS unsigned char* vbase = st + AT_TILEB + 256 * (8 * (fq & 1) + 4 * (fq >> 1) + vq) + 8 * (vp & 1);
#pragma unroll
        for (int c = 0; c < 2; ++c) { const bf16x8 pf0 = pack8(s[0][2 * c], s[0][2 * c + 1]), pf1 = pack8(s[1][2 * c], s[1][2 * c + 1]);
#pragma unroll
            for (int db = 0; db < 8; ++db) { const int co = (((2 * db) ^ vS14) | vx0) << 4; const bf16x8 vf = tr_pair(vbase + c * 32 * 256 + co, vbase + (c * 32 + 16) * 256 + co);
                o[0][db] = __builtin_amdgcn_mfma_f32_16x16x32_bf16(vf, pf0, o[0][db], 0, 0, 0); o[1][db] = __builtin_amdgcn_mfma_f32_16x16x32_bf16(vf, pf1, o[1][db], 0, 0, 0); } }
    };
    u32x4 (&krA)[2] = P.kA; u32x4 (&vrA)[2] = P.vA; u32x4 (&krB)[2] = P.kB; u32x4 (&vrB)[2] = P.vB;
    int k0 = 31 - __builtin_clz(tm); tm &= ~(1u << k0);
    int k1 = -1; if (tm) { k1 = 31 - __builtin_clz(tm); tm &= ~(1u << k1); }
    at_lstore(lds, tid, krA, vrA); __syncthreads();
    for (;;) {
        int k2 = -1; if (tm) { k2 = 31 - __builtin_clz(tm); tm &= ~(1u << k2); }
        if (k2 >= 0) at_gload(A, k2, tid, krA, vrA);
        tile(k0, lds);
        if (k1 >= 0) at_lstore(lds + AT_STAGEB, tid, krB, vrB);
        __syncthreads();
        if (k1 < 0) break;
        int k3 = -1; if (tm) { k3 = 31 - __builtin_clz(tm); tm &= ~(1u << k3); }
        if (k3 >= 0) at_gload(A, k3, tid, krB, vrB);
        tile(k1, lds + AT_STAGEB);
        if (k2 >= 0) at_lstore(lds, tid, krA, vrA);
        __syncthreads();
        if (k2 < 0) break;
        k0 = k2; k1 = k3;
    }
#pragma unroll
    for (int rb = 0; rb < 2; ++rb) { l[rb] += __shfl_xor(l[rb], 16); l[rb] += __shfl_xor(l[rb], 32); }
}
template <bool USE_SEL>
__device__ __forceinline__ void attn_core(LAS unsigned char* lds, const AttnArgs& A, const unsigned (&selmask)[2], int tid, f32x4 (&o)[2][8], float (&m)[2], float (&l)[2]) {
    AttnPre P; attn_issue_q(A, tid, P); attn_issue_kv(A, tid, P); attn_run<USE_SEL>(lds, A, selmask, tid, P, o, m, l);
}
__device__ __forceinline__ void at_store_o(bf16_t* orow, const f32x4 (&o)[8], float inv, int fq) {
#pragma unroll
    for (int db = 0; db < 8; ++db) { u32x2 w; w.x = pg8::cvt_pk_bf16(o[db][0] * inv, o[db][1] * inv); w.y = pg8::cvt_pk_bf16(o[db][2] * inv, o[db][3] * inv); *(u32x2*)(orow + 16 * db + 4 * fq) = w; }
}
__device__ __forceinline__ void mem_args(AttnArgs& A, const bf16_t* proj, int nh, int mq0, const bf16_t* memkv, int l, int b, int h, int qb) {
    A.q = proj + ((size_t)(b * nh + mq0 + h) * SEQ + qb * 256) * HD; A.qstride = HD; A.k = memkv + (size_t)(b * 32 + l * 8 + h) * 256 * HD; A.v = A.k + (size_t)4 * 256 * HD; A.kvstride = HD;
    A.tilemask = 0xFu; A.nkeys = 256; A.qpos0 = 1 << 20; A.kmul = 0; A.maxdist = 0x7fffffff; A.slope2 = 0.f; A.nrows = 256;
}
__device__ __forceinline__ void mem_attn_wg(LAS unsigned char* lds, const bf16_t* proj, int nh, int mq0, const bf16_t* memkv, int l, bf16_t* cat, int ldc, int memoff, int b, int h, int qb, int tid_) {
    int tid = tid_; asm volatile("" : "+v"(tid));
    AttnArgs A; mem_args(A, proj, nh, mq0, memkv, l, b, h, qb);
    const unsigned nosel[2] = {0u, 0u};
    f32x4 o[2][8]; float m[2], lsum[2]; attn_core<false>(lds, A, nosel, tid, o, m, lsum);
    const int lane = tid & 63, t0 = b * SEQ + qb * 256;
#pragma unroll
    for (int rb = 0; rb < 2; ++rb) { const int row = (tid >> 6) * 32 + rb * 16 + (lane & 15);
        at_store_o(cat + (size_t)(t0 + row) * ldc + memoff + h * HD, o[rb], 1.0f / fmaxf(lsum[rb], 1e-30f), lane >> 4); }
}
__device__ __forceinline__ void dil_attn_wg(LAS unsigned char* lds, const bf16_t* proj, bf16_t* og, float* lse, int b, int hh, int x, int tid_) {
    int tid = tid_; asm volatile("" : "+v"(tid));
    const int gi = hh >> 3, j = hh & 7, d = gi == 0 ? 1 : (gi == 1 ? 4 : 16), L = SEQ / d, nqb = gi == 0 ? 8 : (gi == 1 ? 2 : 1), r = x / nqb, qb = x % nqb, c0 = qb * 256;
    const float slope = exp2f(-8.0f * (float)(hh + 1) / 24.0f);
    AttnArgs A; A.q = proj + ((size_t)(b * 76 + hh) * SEQ + c0 * d + r) * HD; A.qstride = (size_t)d * HD;
    A.k = proj + ((size_t)(b * 76 + 24 + hh) * SEQ + r) * HD; A.v = A.k + (size_t)24 * SEQ * HD; A.kvstride = (size_t)d * HD;
    { const int ktc = c0 >> 6, k0 = ktc - 2 < 0 ? 0 : ktc - 2, kend = (ktc + 4 < L / 64 ? ktc + 4 : L / 64) - 1; A.tilemask = (0xffffffffu >> (31 - kend)) & (0xffffffffu << k0); }
    A.nkeys = L; A.qpos0 = c0; A.kmul = 1; A.maxdist = 128; A.slope2 = slope * (float)d * LOG2E; A.nrows = L - c0 < 256 ? L - c0 : 256;
    const unsigned nosel[2] = {0u, 0u};
    f32x4 o[2][8]; float m[2], lsum[2]; attn_core<false>(lds, A, nosel, tid, o, m, lsum);
    const int lane = tid & 63, fr = lane & 15, fq = lane >> 4;
#pragma unroll
    for (int rb = 0; rb < 2; ++rb) { const int row = (tid >> 6) * 32 + rb * 16 + fr;
        if (row < A.nrows) { const size_t t = (size_t)b * SEQ + (size_t)(c0 + row) * d + r;
            at_store_o(og + ((size_t)gi * NTOK + t) * 1024 + j * HD, o[rb], 1.0f / fmaxf(lsum[rb], 1e-30f), fq);
            if (fq == 0) lse[((size_t)gi * NTOK + t) * 8 + j] = m[rb] * LN2 + __logf(fmaxf(lsum[rb], 1e-30f)); } }
}
__device__ __forceinline__ void cmp_sel_wg(LAS unsigned char* lds, const bf16_t* proj, const bf16_t* kc, const bf16_t* vc, bf16_t* ocmp, unsigned* sel, unsigned* umw, int b, int g, int qb, int tid_) {
    int tid = tid_; asm volatile("" : "+v"(tid));
    const int lane = tid & 63, wave = tid >> 6, fr = lane & 15, fq = lane >> 4, row = wave * 16 + fr, t0 = b * SEQ + qb * 128, spos_ = qb * 128 + row, cur = spos_ >> 6;
    bf16x8 qf3[3][4];
#pragma unroll
    for (int r = 0; r < 3; ++r) { const bf16_t* qp = proj + ((size_t)(b * 18 + 3 * g + r) * SEQ + qb * 128 + row) * HD + 8 * fq;
#pragma unroll
        for (int dc = 0; dc < 4; ++dc) qf3[r][dc] = *(const bf16x8*)(qp + 32 * dc); }
#pragma unroll
    for (int i = 0; i < 4; ++i) { const int id = tid + 512 * i, n = id >> 4, c16 = id & 15; const size_t off = ((size_t)(b * NCMP + n) * 4 + g) * 256 + 8 * c16;
        *(LAS u32x4*)(lds + n * AT_ROWB + c16 * 16) = *(const u32x4*)(kc + off); *(LAS u32x4*)(lds + 2 * AT_TILEB + n * AT_ROWB + c16 * 16) = *(const u32x4*)(vc + off); }
    __syncthreads();
    float imp[8];
#pragma unroll
    for (int kb = 0; kb < 8; ++kb) imp[kb] = 0.f;
#pragma unroll
    for (int r = 0; r < 3; ++r) {
        const int h = 3 * g + r; const float slope2 = exp2f(-8.0f * (float)(h + 1) / 12.0f) * LOG2E;
        int z = 0; asm volatile("" : "+v"(z));
        const int spos = spos_ + z;
        const bf16x8 (&qf)[4] = qf3[r];
        f32x4 s[8];
        { const LAS unsigned char* kbase = lds + fr * AT_ROWB + fq * 16 + z;
#pragma unroll
          for (int kb = 0; kb < 8; ++kb) { s[kb] = (f32x4){0.f, 0.f, 0.f, 0.f};
#pragma unroll
              for (int dc = 0; dc < 4; ++dc) { const bf16x8 kf = *(const LAS bf16x8*)(kbase + kb * 16 * AT_ROWB + dc * 64); s[kb] = __builtin_amdgcn_mfma_f32_16x16x32_bf16(kf, qf[dc], s[kb], 0, 0, 0); } } }
        float tmax = -INFINITY;
#pragma unroll
        for (int kb = 0; kb < 8; ++kb)
#pragma unroll
            for (int e = 0; e < 4; ++e) { const int n = 16 * kb + 4 * fq + e, dist = spos - (16 * n + 31); const bool valid = (dist >= 0) && (n < NCMP);
                const float x = valid ? (s[kb][e] * SCALE2 - slope2 * (float)dist) : -INFINITY; s[kb][e] = x; tmax = fmaxf(tmax, x); }
        tmax = fmaxf(tmax, __shfl_xor(tmax, 16)); tmax = fmaxf(tmax, __shfl_xor(tmax, 32));
        const float muse = (tmax == -INFINITY) ? 0.f : tmax;
        float lsum = 0.f;
#pragma unroll
        for (int kb = 0; kb < 8; ++kb)
#pragma unroll
            for (int e = 0; e < 4; ++e) { const float pv = __builtin_amdgcn_exp2f(s[kb][e] - muse); s[kb][e] = pv; lsum += pv; }
        lsum += __shfl_xor(lsum, 16); lsum += __shfl_xor(lsum, 32);
        const float inv = 1.0f / fmaxf(lsum, 1e-30f);
#pragma unroll
        for (int kb = 0; kb < 8; ++kb) s[kb] *= inv;
#pragma unroll
        for (int kb = 0; kb < 8; ++kb) { const float t1 = __shfl(s[kb][3], (lane - 16) & 63); const float t0v = kb > 0 ? __shfl(s[kb > 0 ? kb - 1 : 0][3], (lane - 16) & 63) : 0.f;
            imp[kb] += s[kb][0] + s[kb][1] + s[kb][2] + 0.5f * s[kb][3] + 0.5f * (fq == 0 ? t0v : t1); }
        f32x4 o[8];
#pragma unroll
        for (int db = 0; db < 8; ++db) o[db] = (f32x4){0.f, 0.f, 0.f, 0.f};
        { const LAS unsigned char* vbase = lds + 2 * AT_TILEB + (4 * fq + (fr >> 2)) * AT_ROWB + 8 * (fr & 3);
#pragma unroll
          for (int c = 0; c < 4; ++c) { const bf16x8 pf = pack8(s[2 * c], s[2 * c + 1]);
#pragma unroll
              for (int db = 0; db < 8; ++db) { const bf16x8 vf = tr_pair(vbase + c * 32 * AT_ROWB + db * 32, vbase + c * 32 * AT_ROWB + 16 * AT_ROWB + db * 32);
                  o[db] = __builtin_amdgcn_mfma_f32_16x16x32_bf16(vf, pf, o[db], 0, 0, 0); } } }
        at_store_o(ocmp + (size_t)(t0 + row) * 1536 + h * HD, o, 1.0f, fq);
    }
    LAS float* rk = (LAS float*)(lds + AT_AUX + wave * 2048) + fr * 32;
    float mine[8];
#pragma unroll
    for (int kb = 0; kb < 8; ++kb) { const int j = 4 * kb + fq; const bool forced = (j == 0) || (j == cur) || (j == cur - 1);
        mine[kb] = forced ? 1e4f : (j > cur ? -1e4f : imp[kb]); rk[j] = mine[kb]; }
    LDS_WAIT();
    int rank[8];
#pragma unroll
    for (int kb = 0; kb < 8; ++kb) rank[kb] = 0;
#pragma unroll
    for (int j4 = 0; j4 < 8; ++j4) { const f32x4 v = *(const LAS f32x4*)(rk + 4 * j4);
#pragma unroll
        for (int e = 0; e < 4; ++e) { const int jj = 4 * j4 + e;
#pragma unroll
            for (int kb = 0; kb < 8; ++kb) { const int j = 4 * kb + fq; rank[kb] += (v[e] > mine[kb] || (v[e] == mine[kb] && jj < j)) ? 1 : 0; } } }
    unsigned bits = 0u;
#pragma unroll
    for (int kb = 0; kb < 8; ++kb) { const int j = 4 * kb + fq; if (rank[kb] < 16 && j <= cur) bits |= 1u << j; }
    bits |= __shfl_xor(bits, 16); bits |= __shfl_xor(bits, 32);
    if (fq == 0) sel[(size_t)(t0 + row) * 4 + g] = bits;
    { unsigned wb = bits;
#pragma unroll
      for (int o_ = 1; o_ < 16; o_ <<= 1) wb |= __shfl_xor(wb, o_);
      LAS unsigned* wgw = (LAS unsigned*)(lds + AT_AUX + 8 * 2048);
      if (lane == 0) wgw[wave] = wb;
      __syncthreads();
      if (tid == 0) umw[(b * 4 + g) * 16 + qb] = wgw[0] | wgw[1] | wgw[2] | wgw[3] | wgw[4] | wgw[5] | wgw[6] | wgw[7]; }
}
__device__ __forceinline__ void nsa_attn_wg(LAS unsigned char* lds, const bf16_t* proj, const bf16_t* kvs, const unsigned* sel, const unsigned* umw, const bf16_t* ocmp, bf16_t* cat, int b, int h, int qb, int tid_) {
    int tid = tid_; asm volatile("" : "+v"(tid));
    const int lane = tid & 63, wave = tid >> 6, fr = lane & 15, fq = lane >> 4, g = h / 3, t0 = b * SEQ + qb * 256;
    const float slope2 = exp2f(-8.0f * (float)(h + 1) / 12.0f) * LOG2E;
    const unsigned umv = __hip_atomic_load(umw + (b * 4 + g) * 16 + 2 * qb, __ATOMIC_RELAXED, __HIP_MEMORY_SCOPE_AGENT) | __hip_atomic_load(umw + (b * 4 + g) * 16 + 2 * qb + 1, __ATOMIC_RELAXED, __HIP_MEMORY_SCOPE_AGENT);
    unsigned selmask[2];
#pragma unroll
    for (int rb = 0; rb < 2; ++rb) selmask[rb] = sel[(size_t)(t0 + wave * 32 + rb * 16 + fr) * 4 + g];
    const bf16_t* kvb = kvs + (size_t)(b * 24 + g) * SEQ * HD;
    constexpr size_t KIND = (size_t)4 * SEQ * HD;
    AttnArgs Aw; Aw.q = proj + ((size_t)(b * 18 + h) * SEQ + qb * 256) * HD; Aw.qstride = HD; Aw.kvstride = HD; Aw.nkeys = SEQ; Aw.qpos0 = qb * 256; Aw.kmul = 1; Aw.slope2 = slope2; Aw.nrows = 256;
    Aw.k = kvb + 4 * KIND; Aw.v = kvb + 5 * KIND; Aw.maxdist = 511;
    { const int k0 = 4 * qb - 8 < 0 ? 0 : 4 * qb - 8, k1 = 4 * qb + 3; Aw.tilemask = (0xffffffffu >> (31 - k1)) & (0xffffffffu << k0); }
    AttnPre Pw; attn_issue_q(Aw, tid, Pw); attn_issue_kv(Aw, tid, Pw);
    const unsigned um = (unsigned)__builtin_amdgcn_readfirstlane((int)umv);
    AttnArgs As = Aw; As.k = kvb + 2 * KIND; As.v = kvb + 3 * KIND; As.maxdist = 0x7fffffff; As.tilemask = um & (0xffffffffu >> (31 - (4 * qb + 3)));
    f32x4 o[2][8]; float m[2], lsum[2];
    { const unsigned nosel[2] = {0u, 0u}; attn_run<false>(lds, Aw, nosel, tid, Pw, o, m, lsum); }
    AttnPre Ps; attn_issue_kv(As, tid, Ps);
#pragma unroll
    for (int rb = 0; rb < 2; ++rb) at_store_o(cat + (size_t)(t0 + wave * 32 + rb * 16 + fr) * 2048 + h * HD, o[rb], 1.0f / fmaxf(lsum[rb], 1e-30f), fq);
#pragma unroll
    for (int rb = 0; rb < 2; ++rb)
#pragma unroll
        for (int dc = 0; dc < 4; ++dc) Ps.qf[rb][dc] = Pw.qf[rb][dc];
    attn_run<true>(lds, As, selmask, tid, Ps, o, m, lsum);
#pragma unroll
    for (int rb = 0; rb < 2; ++rb) { const int row = wave * 32 + rb * 16 + fr;
        const bf16_t* gp = proj + ((size_t)(b * 18 + 16) * SEQ + qb * 256 + row) * HD + h * 3;
        const float g0 = 1.0f / (1.0f + __expf(-bflo((unsigned)gp[0]))), g1 = 1.0f / (fmaxf(lsum[rb], 1e-30f) * (1.0f + __expf(-bflo((unsigned)gp[1])))), g2 = 1.0f / (1.0f + __expf(-bflo((unsigned)gp[2])));
        bf16_t* orow = cat + (size_t)(t0 + row) * 2048 + h * HD + 4 * fq; const bf16_t* crow = ocmp + (size_t)(t0 + row) * 1536 + h * HD + 4 * fq;
#pragma unroll
        for (int db = 0; db < 8; ++db) { const u32x2 c = *(const u32x2*)(crow + 16 * db), wv = *(const u32x2*)(orow + 16 * db);
            const float r0 = g0 * bflo(c.x) + g1 * o[rb][db][0] + g2 * bflo(wv.x), r1 = g0 * bfhi(c.x) + g1 * o[rb][db][1] + g2 * bfhi(wv.x);
            const float r2 = g0 * bflo(c.y) + g1 * o[rb][db][2] + g2 * bflo(wv.y), r3 = g0 * bfhi(c.y) + g1 * o[rb][db][3] + g2 * bfhi(wv.y);
            u32x2 w; w.x = pg8::cvt_pk_bf16(r0, r1); w.y = pg8::cvt_pk_bf16(r2, r3); *(u32x2*)(orow + 16 * db) = w; } }
}
__device__ __forceinline__ int opq_tid() { int t = threadIdx.x; asm volatile("" : "+v"(t)); return t; }
__global__ void __launch_bounds__(NTHREADS, 2) mega_fwd(Params p) {
    extern __shared__ __attribute__((aligned(16))) unsigned char lds_raw[];
    LAS unsigned char* lds = (LAS unsigned char*)lds_raw;
    cg::grid_group grid = cg::this_grid();
    const int tid = threadIdx.x, lane = tid & 63, wave = __builtin_amdgcn_readfirstlane(tid >> 6);
    const int G = gridDim.x, bid = blockIdx.x;
    volatile LAS unsigned* bst = (volatile LAS unsigned*)(lds + LDS_MAIN);
    if (tid < 2) bst[tid] = 0u;
    __syncthreads();
    const XcdBarrier gbar = xcd_barrier_post((unsigned*)(p.ws + WS_BAR), bst);
    grid.sync();
    const int gw = bid * NWAVES + wave, ngw = G * NWAVES;
    unsigned char* ws = p.ws;
    float* X = p.out;
    bf16_t* XH = (bf16_t*)(ws + WS_XH); bf16_t* PROJ = (bf16_t*)(ws + WS_PROJ); float* OBUF = (float*)(ws + WS_OBUF);
    bf16_t* CAT = (bf16_t*)(ws + WS_CAT); bf16_t* KVS = (bf16_t*)(ws + WS_KVS); bf16_t* MEMKV = (bf16_t*)(ws + WS_MEMKV); bf16_t* MEMHAT = (bf16_t*)(ws + WS_MEMHAT);
    bf16_t* OG = (bf16_t*)(ws + WS_KVS); float* LSE = (float*)(ws + WS_HID); unsigned* SEL = (unsigned*)(ws + WS_SEL); unsigned* UMW = (unsigned*)(ws + WS_UM); float* XS = (float*)(ws + WS_XS);
    bf16_t* OCMP = (bf16_t*)(ws + WS_OBUF);
    bf16_t* OBF = (bf16_t*)(ws + WS_OBUF + (size_t)NTOK * 2048 * 2);
    bf16_t* HID = (bf16_t*)(ws + WS_HID); bf16_t* KCV = (bf16_t*)(ws + WS_KCV); bf16_t* BLK = (bf16_t*)(ws + WS_OBUF);
    LAS float* wscr = (LAS float*)(lds + wave * 16384);

    for (int rep_ = 0; rep_ < REP_P0; ++rep_) {
        ConvJob J;
        for (int j = 0; conv_get(p, j, J); ++j) conv_run(J, wscr, gw, ngw, lane);
        for (int m = gw; m < 1024; m += ngw) rms_row(p.in[I_MEM] + (size_t)m * 2048, MEMHAT + (size_t)m * 2048, nullptr, lane);
        for (int m = gw; m < NTOK; m += ngw) rms_row(p.in[I_X] + (size_t)m * 2048, XH + (size_t)m * 2048, XS + m, lane);
    }
    for (int rs_ = 0; rs_ < REP_SYNC; ++rs_) xcd_barrier(gbar);

    unsigned long long tp0 = 0, tp1 = 0;
    for (int l = 0; l < 4; ++l) {
        const bool isA = l < 2;
        for (int jb = 0; jb < 3; ++jb) {
            pg8::Gemm g; bf16_t* O; int ldc; int c = bid; int hm = 0, ssh = 11, spn = 1 << 20, hm2 = 0; bf16_t* O2 = nullptr;
            if (jb == 0) { g.A = XH; g.M = NTOK; g.K = 2048;
                if (isA) { g.Bt = (const bf16_t*)(ws + WS_WAIN + l * SZ_WAIN); g.N = A_COLS; O = PROJ; ldc = A_COLS; hm = 76; }
                else { g.Bt = (const bf16_t*)(ws + (l == 2 ? WS_WBIN : WS_WBIN1)); g.N = l == 2 ? B_COLS + 3072 : B_COLS; O = PROJ; ldc = B_COLS; hm = 18; if (l == 2) { spn = 9; O2 = KVS; hm2 = 24; } } }
            else if (jb == 1) { if (l != 0) continue; g.A = MEMHAT; g.Bt = (const bf16_t*)(ws + WS_WMEM); g.M = 1024; g.N = 4096; g.K = 2048; O = MEMKV; ldc = 4096; c = (bid + 64) % G; hm = 32; ssh = 8; }
            else continue;
            pg8::StaticOrder S; S.init(g.M, g.N, G, c);
            pg8::EpiBf16<0> E{O, ldc, hm, ssh, spn, O2, hm2};
            for (int rep_ = 0; rep_ < REP_GEMM; ++rep_) pg8::gemm_phase(lds, g, S, E);
        }
        for (int rs_ = 0; rs_ < REP_SYNC; ++rs_) xcd_barrier(gbar);
        if (l == 2) {
            const int lane = opq_tid() & 63;
            for (int it = gw; it < 2 * 2048; it += ngw) {
                const int w = it >> 11, row = it & 2047; bf16_t* dst = BLK + ((size_t)w * 2048 + row) * 4096;
                if (row < NBATCH * NCMP * 4) { const int gg = row & 3, bn = row >> 2, bb = bn / NCMP, n = bn % NCMP;
                    const bf16_t* src = KVS + ((size_t)(bb * 24 + w * 4 + gg) * SEQ + 16 * n) * HD; const float* pe = p.in[I_PE] + w * 32 * HD;
                    for (int ll = 0; ll < 32; ++ll) { const unsigned v = *(const unsigned*)(src + (size_t)ll * HD + 2 * lane); const f32x2 e = *(const f32x2*)(pe + ll * HD + 2 * lane);
                        *(unsigned*)(dst + ll * HD + 2 * lane) = pk2(bflo(v) + e.x, bfhi(v) + e.y); } }
                else { for (int ll = 0; ll < 32; ++ll) *(unsigned*)(dst + ll * HD + 2 * lane) = 0u; }
            }
            for (int rs_ = 0; rs_ < REP_SYNC; ++rs_) xcd_barrier(gbar);
            for (int w = 0; w < 2; ++w) { pg8::Gemm g{BLK + (size_t)w * 2048 * 4096, (const bf16_t*)(ws + WS_WC1 + w * SZ_WC1), 2048, 512, 4096};
                pg8::StaticOrder S; S.init(2048, 512, G, (bid + 128 * w) % G); pg8::EpiBf16<1> E{HID + (size_t)w * 2048 * 512, 512, 0, 11, 1 << 20, nullptr, 0}; for (int rep_ = 0; rep_ < REP_GEMM; ++rep_) pg8::gemm_phase(lds, g, S, E); }
            for (int rs_ = 0; rs_ < REP_SYNC; ++rs_) xcd_barrier(gbar);
            for (int w = 0; w < 2; ++w) { pg8::Gemm g{HID + (size_t)w * 2048 * 512, (const bf16_t*)(ws + WS_WC2 + w * SZ_WC2), 2048, 256, 512};
                pg8::StaticOrder S; S.init(2048, 256, G, (bid + 128 * w) % G); pg8::EpiBf16<0> E{KCV + (size_t)w * 2048 * 256, 256, 0, 11, 1 << 20, nullptr, 0}; for (int rep_ = 0; rep_ < REP_GEMM; ++rep_) pg8::gemm_phase(lds, g, S, E); }
            for (int rs_ = 0; rs_ < REP_SYNC; ++rs_) xcd_barrier(gbar);
        }
        if (isA) {
            for (int it = bid; it < 1152; it += G) {
                if (it < 512) { const int gi = it >> 8, u = it & 255; dil_attn_wg(lds, PROJ, OG, LSE, u >> 6, gi * 8 + ((u >> 3) & 7), u & 7, opq_tid()); }
                else if (it < 640) { const int u = it - 512; mem_attn_wg(lds, PROJ, 76, 72, MEMKV, l, CAT, 1536, 1024, u >> 5, (u >> 3) & 3, u & 7, opq_tid()); }
                else { const int u = it - 640; dil_attn_wg(lds, PROJ, OG, LSE, u >> 7, 16 + ((u >> 4) & 7), u & 15, opq_tid()); }
            }
            for (int rs_ = 0; rs_ < REP_SYNC; ++rs_) xcd_barrier(gbar);
            for (int rep_ = 0; rep_ < REP_ATT; ++rep_)
            for (int it = bid * NTHREADS + opq_tid(); it < NTOK * 8 * 16; it += G * NTHREADS) { const int c8 = it & 15, tj = it >> 4;
                const float l0 = LSE[tj], l1 = LSE[(size_t)NTOK * 8 + tj], l2 = LSE[(size_t)2 * NTOK * 8 + tj], mx = fmaxf(l0, fmaxf(l1, l2));
                float e0 = __expf(l0 - mx), e1 = __expf(l1 - mx), e2 = __expf(l2 - mx); const float inv = 1.0f / (e0 + e1 + e2); e0 *= inv; e1 *= inv; e2 *= inv;
                const u32x4 a = *(const u32x4*)(OG + (size_t)tj * 128 + 8 * c8), bq = *(const u32x4*)(OG + ((size_t)NTOK * 8 + tj) * 128 + 8 * c8), cq = *(const u32x4*)(OG + ((size_t)2 * NTOK * 8 + tj) * 128 + 8 * c8);
                u32x4 w;
                w.x = pk2(e0 * bflo(a.x) + e1 * bflo(bq.x) + e2 * bflo(cq.x), e0 * bfhi(a.x) + e1 * bfhi(bq.x) + e2 * bfhi(cq.x));
                w.y = pk2(e0 * bflo(a.y) + e1 * bflo(bq.y) + e2 * bflo(cq.y), e0 * bfhi(a.y) + e1 * bfhi(bq.y) + e2 * bfhi(cq.y));
                w.z = pk2(e0 * bflo(a.z) + e1 * bflo(bq.z) + e2 * bflo(cq.z), e0 * bfhi(a.z) + e1 * bfhi(bq.z) + e2 * bfhi(cq.z));
                w.w = pk2(e0 * bflo(a.w) + e1 * bflo(bq.w) + e2 * bflo(cq.w), e0 * bfhi(a.w) + e1 * bfhi(bq.w) + e2 * bfhi(cq.w));
                const int t = tj >> 3, j = tj & 7;
                *(u32x4*)(CAT + (size_t)t * 1536 + j * HD + 8 * c8) = w; }
        } else {
            if (TPROBE == 1 && l == 2) tp0 = __builtin_amdgcn_s_memrealtime();
            for (int rep_ = 0; rep_ < REP_ATT * REP_B1; ++rep_)
            for (int it = bid; it < 256; it += G) cmp_sel_wg(lds, PROJ, KCV, KCV + (size_t)2048 * 256, OCMP, SEL, UMW, it >> 6, (it >> 4) & 3, it & 15, opq_tid());
            if (TPROBE == 1 && l == 2) tp1 = __builtin_amdgcn_s_memrealtime();
            if (TPROBE == 2 && l == 2) tp0 = __builtin_amdgcn_s_memrealtime();
            for (int rs_ = 0; rs_ < REP_SYNC; ++rs_) xcd_barrier(gbar);
            for (int v = bid; v < 256; v += G) {
                if (v < 240) { const int k = v / 48, j = v % 48;
                    nsa_attn_wg(lds, PROJ, KVS, SEL, UMW, OCMP, CAT, j / 12, j % 12, 7 - k, opq_tid());
                    if (k < 2) { const int u = k * 48 + j; mem_attn_wg(lds, PROJ, 18, 12, MEMKV, l, CAT, 2048, 1536, u >> 5, (u >> 3) & 3, u & 7, opq_tid()); }
                    else nsa_attn_wg(lds, PROJ, KVS, SEL, UMW, OCMP, CAT, j / 12, j % 12, k - 2, opq_tid());
                } else { for (int q2 = 0; q2 < 2; ++q2) { const int u = 96 + (v - 240) * 2 + q2; mem_attn_wg(lds, PROJ, 18, 12, MEMKV, l, CAT, 2048, 1536, u >> 5, (u >> 3) & 3, u & 7, opq_tid()); } }
            }
        }
        for (int rs_ = 0; rs_ < REP_SYNC; ++rs_) xcd_barrier(gbar);
            if (TPROBE == 2 && l == 2) tp1 = __builtin_amdgcn_s_memrealtime();
        for (int hf = 0; hf < 2; ++hf) {
            if (hf == 1) { pg8::Gemm g{XH, (const bf16_t*)(ws + WS_WGU + l * SZ_WGU), NTOK, 11264, 2048}; pg8::StaticOrder S; S.init(NTOK, 11264, G, bid);
                pg8::EpiSwiGLU E{PROJ, DFF}; if (TPROBE == 3 && l == 0) tp0 = __builtin_amdgcn_s_memrealtime();
                if (STAGGER_US > 0 && bid >= 128) { const unsigned long long t0 = __builtin_amdgcn_s_memrealtime(); while (__builtin_amdgcn_s_memrealtime() - t0 < (unsigned long long)STAGGER_US * 100ull) __builtin_amdgcn_s_sleep(16); } for (int rep_ = 0; rep_ < REP_GEMM; ++rep_) pg8::gemm_phase(lds, g, S, E); if (TPROBE == 3 && l == 0) tp1 = __builtin_amdgcn_s_memrealtime(); for (int rs_ = 0; rs_ < REP_SYNC; ++rs_) xcd_barrier(gbar); }
            { pg8::Gemm g; g.M = NTOK; g.N = 2048;
              if (hf == 0) { g.A = CAT; g.K = isA ? 1536 : 2048; g.Bt = isA ? (const bf16_t*)(ws + WS_WAOUT + l * SZ_WAOUT) : (const bf16_t*)(ws + WS_WBOUT + (l - 2) * SZ_WBOUT); }
              else { g.A = PROJ; g.K = DFF; g.Bt = (const bf16_t*)(ws + WS_WDOWN + l * SZ_WDOWN); }
              pg8::StaticOrder S; S.init(NTOK, 2048, G, bid); pg8::EpiBf16<0> E{OBF, 2048, 0, 11, 1 << 20, nullptr, 0}; if (TPROBE == 4 && l == 0 && hf == 1) tp0 = __builtin_amdgcn_s_memrealtime(); for (int rep_ = 0; rep_ < REP_GEMM; ++rep_) pg8::gemm_phase(lds, g, S, E); if (TPROBE == 4 && l == 0 && hf == 1) tp1 = __builtin_amdgcn_s_memrealtime(); }
            for (int rs_ = 0; rs_ < REP_SYNC; ++rs_) xcd_barrier(gbar);
            const float* gain = p.in[I_NORMG] + (l * 5 + (hf == 0 ? 1 : 3)) * 2048;
            const bool fin = (l == 3 && hf == 1);
            for (int m = gw; m < NTOK; m += ngw) rowop_row(XH + (size_t)m * 2048, XS + m, OBF + (size_t)m * 2048, gain, fin ? X + (size_t)m * 2048 : nullptr, opq_tid() & 63);
            for (int rs_ = 0; rs_ < REP_SYNC; ++rs_) xcd_barrier(gbar);
        }
    }
    if (TPROBE && bid == 0) { const unsigned long long dt = (tp1 - tp0) * 32ull, t0 = __builtin_amdgcn_s_memrealtime(); while (__builtin_amdgcn_s_memrealtime() - t0 < dt) __builtin_amdgcn_s_sleep(8); }
}

extern "C" void kernel_launch(void* const* d_in, const int* in_sizes, int n_in, void* d_out, int out_size, void* d_ws, size_t ws_size, hipStream_t stream) {
    static int grid_blocks = 0;
    if (grid_blocks == 0) {
        if (n_in != 17 || ws_size < WS_END) { fprintf(stderr, "kernel_launch: unexpected n_in %d or ws_size %zu (< %zu)\n", n_in, ws_size, (size_t)WS_END); grid_blocks = -1; return; }
        int dev = 0, cus = 0, per_cu = 0;
        hipGetDevice(&dev);
        hipDeviceGetAttribute(&cus, hipDeviceAttributeMultiprocessorCount, dev);
        hipFuncSetAttribute((const void*)mega_fwd, hipFuncAttributeMaxDynamicSharedMemorySize, LDS_BYTES);
        hipOccupancyMaxActiveBlocksPerMultiprocessor(&per_cu, (const void*)mega_fwd, NTHREADS, LDS_BYTES);
        if (per_cu < 1) per_cu = 1;
        if (per_cu > 1) per_cu = 1;
        grid_blocks = cus * per_cu;
        (void)hipGetLastError();
    }
    if (grid_blocks < 0) return;
    static Params p;
    memset(&p, 0, sizeof(p));
    for (int i = 0; i < 17; ++i) p.in[i] = (const float*)d_in[i];
    p.out = (float*)d_out; p.ws = (unsigned char*)d_ws;
    {
        int n = 0;
        auto add = [&](int in_idx, size_t in_off, int gain_idx, int gain_off, size_t dst_off, int ldw, int col0, int ncols, int K, int nrows, int mode) {
            JobDesc& d = p.jobs[n++]; d.in_idx = in_idx; d.in_off = in_off; d.gain_idx = gain_idx; d.gain_off = gain_off; d.dst_off = dst_off; d.ldw = ldw; d.col0 = col0; d.ncols = ncols; d.K = K; d.nrows = nrows; d.mode = mode; d.pad = 0; };
        for (int l = 0; l < 4; ++l) add(I_WGU, (size_t)l * 2048 * 11264, I_NORMG, (l * 5 + 2) * 2048, WS_WGU + l * SZ_WGU, 11264, 0, 11264, 2048, 11264, 1);
        for (int l = 0; l < 4; ++l) add(I_WDOWN, (size_t)l * 5632 * 2048, -1, 0, WS_WDOWN + l * SZ_WDOWN, 2048, 0, 2048, 5632, 2048, 0);
        for (int l = 0; l < 2; ++l) add(I_AWIN, (size_t)l * 2048 * A_COLS, I_NORMG, (l * 5 + 0) * 2048, WS_WAIN + l * SZ_WAIN, A_COLS, 0, A_COLS, 2048, A_COLS, 0);
        for (int l = 0; l < 2; ++l) add(I_AWOUT, (size_t)l * 1536 * 2048, -1, 0, WS_WAOUT + l * SZ_WAOUT, 2048, 0, 2048, 1536, 2048, 0);
        for (int lb = 0; lb < 2; ++lb) {
            const size_t src = (size_t)lb * 2048 * B_COLS_SRC, dst = lb == 0 ? WS_WBIN : WS_WBIN1; const int go = ((2 + lb) * 5 + 0) * 2048;
            add(I_BWIN, src, I_NORMG, go, dst, B_COLS_SRC, 0, 1536, 2048, 1536, 0);
            add(I_BWIN, src, I_NORMG, go, dst + (size_t)1536 * 2048 * 2, B_COLS_SRC, 1572, 512, 2048, 512, 0);
            add(I_BWIN, src, I_NORMG, go, dst + (size_t)2048 * 2048 * 2, B_COLS_SRC, 1536, 36, 2048, 256, 0);
        }
        for (int lb = 0; lb < 2; ++lb) add(I_BWOUT, (size_t)lb * 2048 * 2048, -1, 0, WS_WBOUT + lb * SZ_WBOUT, 2048, 0, 2048, 2048, 2048, 0);
        for (int l = 0; l < 4; ++l) add(I_MEMWKV, (size_t)l * 2048 * 1024, I_NORMG, (l * 5 + 4) * 2048, WS_WMEM + (size_t)l * 1024 * 2048 * 2, 1024, 0, 1024, 2048, 1024, 0);
        add(I_KVW, 0, I_KVNG, 0, WS_WKV, 3072, 0, 3072, 2048, 3072, 0);
        add(I_WK1, 0, -1, 0, WS_WC1, 512, 0, 512, 4096, 512, 0);
        add(I_WV1, 0, -1, 0, WS_WC1 + SZ_WC1, 512, 0, 512, 4096, 512, 0);
        add(I_WK2, 0, -1, 0, WS_WC2, 128, 0, 128, 512, 256, 0);
        add(I_WV2, 0, -1, 0, WS_WC2 + SZ_WC2, 128, 0, 128, 512, 256, 0);
        p.njobs = n;
    }
    (void)hipMemsetAsync((char*)d_ws + WS_BAR, 0, WS_BAR_BYTES, stream);
    void* args[] = {&p};
    hipError_t e = hipLaunchCooperativeKernel((const void*)mega_fwd, dim3(grid_blocks), dim3(NTHREADS), args, LDS_BYTES, stream);
    if (e != hipSuccess) fprintf(stderr, "cooperative launch failed: %s (grid %d)\n", hipGetErrorString(e), grid_blocks);
}
```

```cpp
#include <hip/hip_runtime.h>
#include <hip/hip_cooperative_groups.h>
#include <cstdio>
#include <cstring>
namespace cg = cooperative_groups;
#define REP_P0 1
#define REP_GEMM 1
#define REP_ATT 1
#define REP_ATTA 1
#define REP_B1 1
#define REP_B2 1
#define REP_SYNC 1
#define PROBE_ATT 0
#define TPROBE 0
#define STAGGER_US 0

#define LAS __attribute__((address_space(3)))
typedef unsigned short bf16_t;
typedef short bf16x8 __attribute__((ext_vector_type(8)));
typedef float f32x4 __attribute__((ext_vector_type(4)));
typedef float f32x2 __attribute__((ext_vector_type(2)));
typedef unsigned u32x4 __attribute__((ext_vector_type(4)));
typedef unsigned u32x2 __attribute__((ext_vector_type(2)));
typedef __bf16 bf16x2_t __attribute__((ext_vector_type(2)));

constexpr int D_MODEL = 2048, NTOK = 8192, SEQ = 2048, NBATCH = 4, DFF = 5632, HD = 128;
constexpr int A_COLS = 9728, B_COLS_SRC = 2084, B_COLS = 2304, NCMP = 127;
constexpr int NWAVES = 8, NTHREADS = 512;
constexpr int LDS_MAIN = 131072; constexpr int LDS_BYTES = LDS_MAIN + 64;

constexpr size_t SZ_WAIN = (size_t)A_COLS * 2048 * 2, SZ_WAOUT = (size_t)2048 * 1536 * 2, SZ_WBIN = (size_t)B_COLS * 2048 * 2, SZ_WBOUT = (size_t)2048 * 2048 * 2;
constexpr size_t SZ_WGU = (size_t)11264 * 2048 * 2, SZ_WDOWN = (size_t)2048 * 5632 * 2, SZ_WC1 = (size_t)512 * 4096 * 2, SZ_WC2 = (size_t)256 * 512 * 2;
constexpr size_t WS_WAIN = 0;
constexpr size_t WS_WAOUT = WS_WAIN + 2 * SZ_WAIN;
constexpr size_t WS_WBIN = WS_WAOUT + 2 * SZ_WAOUT;
constexpr size_t SZ_WKV = (size_t)3072 * 2048 * 2;
constexpr size_t WS_WKV = WS_WBIN + SZ_WBIN;
constexpr size_t WS_WBIN1 = WS_WKV + SZ_WKV;
constexpr size_t WS_WBOUT = WS_WBIN1 + SZ_WBIN;
constexpr size_t WS_WMEM = WS_WBOUT + 2 * SZ_WBOUT;
constexpr size_t WS_WGU = WS_WMEM + (size_t)4096 * 2048 * 2;
constexpr size_t WS_WDOWN = WS_WGU + 4 * SZ_WGU;
constexpr size_t WS_WC1 = WS_WDOWN + 4 * SZ_WDOWN;
constexpr size_t WS_WC2 = WS_WC1 + 2 * SZ_WC1;
constexpr size_t WS_PROJ = WS_WC2 + 2 * SZ_WC2;
constexpr size_t WS_OBUF = WS_PROJ + (size_t)NTOK * A_COLS * 2;
constexpr size_t WS_XH = WS_OBUF + (size_t)NTOK * 2048 * 4;
constexpr size_t WS_CAT = WS_XH + (size_t)NTOK * 2048 * 2;
constexpr size_t WS_KVS = WS_CAT + (size_t)NTOK * 2048 * 2;
constexpr size_t WS_MEMKV = WS_KVS + (size_t)NTOK * 3072 * 2;
constexpr size_t WS_MEMHAT = WS_MEMKV + (size_t)1024 * 4096 * 2;
constexpr size_t WS_HID = WS_MEMHAT + (size_t)1024 * 2048 * 2;
constexpr size_t WS_KCV = WS_HID + (size_t)2 * 2048 * 512 * 2;
constexpr size_t WS_SEL = WS_KCV + (size_t)2 * 2048 * 256 * 2;
constexpr size_t WS_XS = WS_SEL + (size_t)NTOK * 4 * 4;
constexpr size_t WS_UM = WS_XS + (size_t)NTOK * 4;
constexpr size_t WS_BAR = WS_UM + 4096;
constexpr size_t WS_BAR_BYTES = 16384;
constexpr size_t WS_END = WS_BAR + WS_BAR_BYTES;

#define LDS_WAIT() asm volatile("s_waitcnt lgkmcnt(0)" ::: "memory")
__device__ __forceinline__ unsigned f2bf(float f) { unsigned u = __builtin_bit_cast(unsigned, f); return (u + 0x7fffu + ((u >> 16) & 1u)) >> 16; }
__device__ __forceinline__ unsigned pk2(float lo, float hi) { const f32x2 v = {lo, hi}; return __builtin_bit_cast(unsigned, __builtin_convertvector(v, bf16x2_t)); }
__device__ __forceinline__ float bflo(unsigned w) { return __builtin_bit_cast(float, w << 16); }
__device__ __forceinline__ float bfhi(unsigned w) { return __builtin_bit_cast(float, w & 0xffff0000u); }
__device__ __forceinline__ float wave_sum(float v) {
#pragma unroll
    for (int o = 1; o < 64; o <<= 1) v += __shfl_xor(v, o);
    return v;
}
__device__ __forceinline__ float wave_max(float v) {
#pragma unroll
    for (int o = 1; o < 64; o <<= 1) v = fmaxf(v, __shfl_xor(v, o));
    return v;
}


#define XB_TMO      128
#define XB_XCNT(j)  (256  + 64 * (j))
#define XB_XSUB(j)  (1280 + 64 * (j))
#define XB_XGEN(j)  (2304 + 64 * (j))
#define XB_TOP      3328
#define XB_TOPGEN   3392
#define XCD_BAR_WORDS 3456
#define XB_SPIN_CAP (1u << 18)
__device__ __forceinline__ unsigned xb_ld(unsigned* p)              { return __hip_atomic_load(p, __ATOMIC_RELAXED, __HIP_MEMORY_SCOPE_AGENT); }
__device__ __forceinline__ unsigned xb_add(unsigned* p, unsigned v) { return __hip_atomic_fetch_add(p, v, __ATOMIC_RELAXED, __HIP_MEMORY_SCOPE_AGENT); }
__device__ __forceinline__ unsigned xb_xcc_id() { return (unsigned)__builtin_amdgcn_s_getreg((3 << 11) | 20) & 0xFu; }
#define XB_SPIN(cond, bar) do { unsigned _sp = 0; while (cond) { __builtin_amdgcn_s_sleep(1); \
    if ((++_sp & 255u) == 0u) { if (xb_ld(&(bar)[XB_TMO])) break; if (_sp > XB_SPIN_CAP) { atomicAdd(&(bar)[XB_TMO], 1u); break; } } } } while (0)
struct XcdBarrier { unsigned* bar; unsigned x; volatile LAS unsigned* st; };
__device__ __forceinline__ XcdBarrier xcd_barrier_post(unsigned* bar, volatile LAS unsigned* st) {
    XcdBarrier b; b.bar = bar; b.x = xb_xcc_id(); b.st = st;
    if (threadIdx.x == 0) (void)xb_add(&bar[XB_XCNT(b.x)], 1u);
    return b;
}
__device__ __forceinline__ void xcd_barrier_complete(unsigned* bar, unsigned x, unsigned& nloc, unsigned& nx) {
    const unsigned G = gridDim.x * gridDim.y * gridDim.z;
    unsigned sum, cnt, mine, sp = 0u;
    for (;;) {
        sum = 0u; cnt = 0u; mine = 0u;
#pragma unroll
        for (unsigned j = 0; j < 16; ++j) { const unsigned c = xb_ld(&bar[XB_XCNT(j)]); sum += c; cnt += (c > 0u) ? 1u : 0u; mine = (j == x) ? c : mine; }
        if (sum == G) break;
        __builtin_amdgcn_s_sleep(1);
        if ((++sp & 255u) == 0u) { if (xb_ld(&bar[XB_TMO])) break; if (sp > XB_SPIN_CAP) { atomicAdd(&bar[XB_TMO], 1u); break; } }
    }
    nloc = mine > 0u ? mine : 1u; nx = cnt > 0u ? cnt : 1u;
}
__device__ __forceinline__ void xcd_barrier(const XcdBarrier& b) {
    asm volatile("s_waitcnt vmcnt(0)" ::: "memory");
    __syncthreads();
    if (threadIdx.x == 0) {
        unsigned* bar = b.bar;
        __builtin_amdgcn_s_waitcnt(0);
        unsigned nloc = b.st[0], nx = b.st[1];
        if (nloc == 0u) { xcd_barrier_complete(bar, b.x, nloc, nx); b.st[0] = nloc; b.st[1] = nx; }
        const unsigned old = xb_add(&bar[XB_XSUB(b.x)], 1u);
        const unsigned gen = old / nloc;
        if (old + 1u == (gen + 1u) * nloc) {
            __builtin_amdgcn_fence(__ATOMIC_RELEASE, "agent");
            asm volatile("s_waitcnt vmcnt(0)" ::: "memory");
            const unsigned og = xb_add(&bar[XB_TOP], 1u);
            const unsigned tg = og / nx;
            if (og + 1u == (tg + 1u) * nx) xb_add(&bar[XB_TOPGEN], 1u);
            else XB_SPIN(xb_ld(&bar[XB_TOPGEN]) == tg, bar);
            __builtin_amdgcn_fence(__ATOMIC_ACQUIRE, "agent");
            xb_add(&bar[XB_XGEN(b.x)], 1u);
            asm volatile("s_waitcnt vmcnt(0)" ::: "memory");
        } else {
            XB_SPIN(xb_ld(&bar[XB_XGEN(b.x)]) == gen, bar);
            __builtin_amdgcn_fence(__ATOMIC_ACQUIRE, "agent");
            asm volatile("s_waitcnt vmcnt(0)" ::: "memory");
        }
    }
    __syncthreads();
}

namespace pg8 {
constexpr int BM = 256, BK = 64, HALF = 128, HTB = HALF * BK * 2, STAGE_BYTES = 8 * HTB, NXCD = 8, WGM = 8;
__device__ __forceinline__ int lds_byte(int r, int c) { const int st = (r >> 4) * 2 + (c >> 5), rr = r & 15, cc = c & 31, ob = rr * 64 + cc * 2; return st * 1024 + (ob ^ (((ob >> 9) & 1) << 5)); }
__device__ __forceinline__ void stage_rc(int b, int& R, int& C) { const int st = b / 1024, sb = b % 1024, swz = sb ^ (((sb >> 9) & 1) << 5); R = (st >> 1) * 16 + swz / 64; C = (st & 1) * 32 + (swz % 64) / 2; }
__device__ __forceinline__ int perm32(int rho) { const int n = rho >> 4, i = rho & 15; return 8 * (i >> 2) + 4 * n + (i & 3); }
struct Unit { int pm, pn; };
struct Gemm { const bf16_t* A; const bf16_t* Bt; int M, N, K; };
struct StaticOrder {
    int nM, nN, nwg, G, c;
    __device__ void init(int M, int N, int G_, int c_) { nM = M / BM; nN = N / BM; nwg = nM * nN; G = G_; c = c_; }
    __device__ bool next(int i, Unit& u) const {
        const long L = (long)i * G + c; if (L >= nwg) return false;
        int wgid = (int)L; { const int q = nwg / NXCD, r = nwg % NXCD, xcd = wgid % NXCD, off = wgid / NXCD; wgid = (xcd < r ? xcd * (q + 1) : r * (q + 1) + (xcd - r) * q) + off; }
        const int nig = WGM * nN, gid = wgid / nig, fm = gid * WGM, gsz = (nM - fm) < WGM ? (nM - fm) : WGM;
        u.pm = fm + ((wgid % nig) % gsz); u.pn = (wgid % nig) / gsz; return true;
    }
    __device__ __forceinline__ void a_ready(const Unit&) const {}
    __device__ __forceinline__ void done(const Unit&) const {}
};
__device__ __forceinline__ unsigned cvt_pk_bf16(float lo, float hi) { const f32x2 v = {lo, hi}; return __builtin_bit_cast(unsigned, __builtin_convertvector(v, bf16x2_t)); }

struct EpiF32 {
    static constexpr bool PERM = false;
    float* C; int ldc;
    __device__ __forceinline__ void operator()(const f32x4 (&acc)[2][2][4][2], const Unit& u, int wr, int wc, int fr, int fq) const {
        const int row0 = u.pm * BM + wr * 64 + fr, col0 = u.pn * BM + wc * 32 + 4 * fq;
#pragma unroll
        for (int ai = 0; ai < 2; ++ai)
#pragma unroll
            for (int m = 0; m < 4; ++m) { float* rowp = C + (size_t)(row0 + ai * HALF + m * 16) * ldc + col0;
#pragma unroll
                for (int bj = 0; bj < 2; ++bj)
#pragma unroll
                    for (int n = 0; n < 2; ++n) *(f32x4*)(rowp + bj * HALF + n * 16) = acc[ai][bj][m][n]; }
    }
};
__device__ __forceinline__ float gelu_tanh(float x) { const float t = 1.5957691216f * (x + 0.044715f * x * x * x); return x / (1.0f + __expf(-t)); }
template <int ACT  > struct EpiBf16 {
    static constexpr bool PERM = true;
    bf16_t* O; int ldc;
    int hm_heads, seq_shift; int split_pn; bf16_t* O2; int hm2;
    __device__ __forceinline__ void operator()(const f32x4 (&acc)[2][2][4][2], const Unit& u, int wr, int wc, int fr, int fq) const {
        const int row0 = u.pm * BM + wr * 64 + fr, col0 = u.pn * BM + wc * 32 + 8 * fq;
#pragma unroll
        for (int ai = 0; ai < 2; ++ai)
#pragma unroll
            for (int m = 0; m < 4; ++m) { const int row = row0 + ai * HALF + m * 16;
#pragma unroll
                for (int bj = 0; bj < 2; ++bj) { f32x4 v0 = acc[ai][bj][m][0], v1 = acc[ai][bj][m][1];
                    if (ACT == 1) {
#pragma unroll
                        for (int j = 0; j < 4; ++j) { v0[j] = gelu_tanh(v0[j]); v1[j] = gelu_tanh(v1[j]); } }
                    u32x4 w; w.x = cvt_pk_bf16(v0[0], v0[1]); w.y = cvt_pk_bf16(v0[2], v0[3]); w.z = cvt_pk_bf16(v1[0], v1[1]); w.w = cvt_pk_bf16(v1[2], v1[3]);
                    bf16_t* dst;
                    if (hm_heads > 0) { const bool second = u.pn >= split_pn; bf16_t* base = second ? O2 : O; const int nh = second ? hm2 : hm_heads;
                        const int col = col0 + bj * HALF - (second ? split_pn * BM : 0), b = row >> seq_shift, sq = row & ((1 << seq_shift) - 1);
                        dst = base + ((((size_t)(b * nh + (col >> 7))) << seq_shift) + sq) * 128 + (col & 127); }
                    else dst = O + (size_t)row * ldc + col0 + bj * HALF;
                    *(u32x4*)dst = w; } }
    }
};
struct EpiSwiGLU {
    static constexpr bool PERM = true;
    bf16_t* O; int ldc;
    __device__ __forceinline__ void operator()(const f32x4 (&acc)[2][2][4][2], const Unit& u, int wr, int wc, int fr, int fq) const {
        const int row0 = u.pm * BM + wr * 64 + fr, col0 = u.pn * HALF + wc * 32 + 8 * fq;
#pragma unroll
        for (int ai = 0; ai < 2; ++ai)
#pragma unroll
            for (int m = 0; m < 4; ++m) { bf16_t* rowp = O + (size_t)(row0 + ai * HALF + m * 16) * ldc + col0;
                f32x4 v0, v1;
#pragma unroll
                for (int j = 0; j < 4; ++j) { const float g0 = acc[ai][0][m][0][j], g1 = acc[ai][0][m][1][j];
                    v0[j] = g0 / (1.0f + __expf(-g0)) * acc[ai][1][m][0][j]; v1[j] = g1 / (1.0f + __expf(-g1)) * acc[ai][1][m][1][j]; }
                u32x4 w; w.x = cvt_pk_bf16(v0[0], v0[1]); w.y = cvt_pk_bf16(v0[2], v0[3]); w.z = cvt_pk_bf16(v1[0], v1[1]); w.w = cvt_pk_bf16(v1[2], v1[3]);
                *(u32x4*)rowp = w; }
    }
};

template <class Epi, class Sched>
__device__ __forceinline__ void gemm_phase(LAS unsigned char* lds, const Gemm g, const Sched& S, const Epi& E) {
    int tid_ = threadIdx.x; asm volatile("" : "+v"(tid_));
    const int tid = tid_, wid = __builtin_amdgcn_readfirstlane(tid >> 6), lane = tid & 63, wr = wid >> 2, wc = wid & 3, fr = lane & 15, fq = lane >> 4;
    const int K = g.K, nt = K / BK;
    unsigned voffA[2], voffB[2];
#pragma unroll
    for (int i = 0; i < 2; ++i) { int R, C; stage_rc(tid * 16 + i * 8192, R, C); const int Rb = Epi::PERM ? ((R & ~31) + perm32(R & 31)) : R;
        voffA[i] = (unsigned)(R * K + C) * 2u; voffB[i] = (unsigned)(Rb * K + C) * 2u; }
    const size_t kstep = (size_t)(BK * 2);
    const size_t hstep = (size_t)HALF * K * 2;
    const size_t tstep = 2 * hstep;
    const unsigned ldsw = (unsigned)wid * 1024u;
    const int aoff = lds_byte(wr * 64 + fr, fq * 8), boff = lds_byte(wc * 32 + fr, fq * 8);
#define PG8_SA(b, h) (((b) * 2 + (h)) * HTB)
#define PG8_SB(b, h) ((4 + (b) * 2 + (h)) * HTB)
#define PG8_STAGE(bufoff, gbase, voff) do { _Pragma("unroll") for (int _i = 0; _i < 2; ++_i) \
        __builtin_amdgcn_global_load_lds((const unsigned*)((const char*)(gbase) + (voff)[_i]), (LAS unsigned*)(lds + (bufoff) + ldsw + _i * 8192), 16, 0, 0); } while (0)
#define PG8_LDA(dst, b, h) do { _Pragma("unroll") for (int m = 0; m < 4; ++m) _Pragma("unroll") for (int k = 0; k < 2; ++k) dst[m][k] = *(const LAS bf16x8*)(lds + PG8_SA(b, h) + aoff + m * 2048 + k * 1024); } while (0)
#define PG8_LDB(dst, b, h) do { _Pragma("unroll") for (int n = 0; n < 2; ++n) _Pragma("unroll") for (int k = 0; k < 2; ++k) dst[n][k] = *(const LAS bf16x8*)(lds + PG8_SB(b, h) + boff + n * 2048 + k * 1024); } while (0)
#define PG8_MMA(ai, bj, At, Bt) do { __builtin_amdgcn_s_setprio(1); _Pragma("unroll") for (int m = 0; m < 4; ++m) _Pragma("unroll") for (int n = 0; n < 2; ++n) _Pragma("unroll") for (int k = 0; k < 2; ++k) \
        acc[ai][bj][m][n] = __builtin_amdgcn_mfma_f32_16x16x32_bf16(Bt[n][k], At[m][k], acc[ai][bj][m][n], 0, 0, 0); __builtin_amdgcn_s_setprio(0); } while (0)
#define PG8_WAIT_V(n) asm volatile("s_waitcnt vmcnt(" #n ")" ::: "memory")
#define PG8_WAIT_L(n) asm volatile("s_waitcnt lgkmcnt(" #n ")" ::: "memory")
#define PG8_BAR __builtin_amdgcn_s_barrier()
#define PG8_SCHED __builtin_amdgcn_sched_barrier(0)
    Unit cur, nxt; int ui = 0;
    if (!S.next(0, cur)) return;
    f32x4 acc[2][2][4][2];
#pragma unroll
    for (int a = 0; a < 2; ++a)
#pragma unroll
        for (int b = 0; b < 2; ++b)
#pragma unroll
            for (int m = 0; m < 4; ++m)
#pragma unroll
                for (int n = 0; n < 2; ++n) acc[a][b][m][n] = (f32x4){0.f, 0.f, 0.f, 0.f};
    bf16x8 At[4][2], B0[2][2], B1[2][2];
    const char* cA = (const char*)g.A + (size_t)cur.pm * tstep; const char* cB = (const char*)g.Bt + (size_t)cur.pn * tstep;
    S.a_ready(cur);
    PG8_STAGE(PG8_SB(0, 0), cB, voffB); PG8_STAGE(PG8_SA(0, 0), cA, voffA); PG8_STAGE(PG8_SB(0, 1), cB + hstep, voffB); PG8_STAGE(PG8_SA(0, 1), cA + hstep, voffA);
    if (wr == 1) PG8_BAR;
    PG8_WAIT_V(4); PG8_BAR;
    PG8_STAGE(PG8_SB(1, 0), cB + kstep, voffB); PG8_STAGE(PG8_SA(1, 0), cA + kstep, voffA); PG8_STAGE(PG8_SB(1, 1), cB + hstep + kstep, voffB);
    PG8_WAIT_V(6); PG8_BAR;
    for (;;) {
        const bool has_next = S.next(ui + 1, nxt);
        const char* nA = has_next ? (const char*)g.A + (size_t)nxt.pm * tstep : cA; const char* nB = has_next ? (const char*)g.Bt + (size_t)nxt.pn * tstep : cB;
        for (int t = 0; t < nt; t += 2) {
            const bool last = (t == nt - 2);
            const char* a1 = cA + (size_t)(t + 1) * kstep;
            const char* a2 = last ? nA : cA + (size_t)(t + 2) * kstep; const char* b2 = last ? nB : cB + (size_t)(t + 2) * kstep;
            const char* a3 = a2 + kstep; const char* b3 = b2 + kstep;
            if (last && has_next) S.a_ready(nxt);
            PG8_LDB(B0, 0, 0); PG8_SCHED; PG8_LDA(At, 0, 0); PG8_STAGE(PG8_SA(1, 1), a1 + hstep, voffA);
            PG8_WAIT_L(8); PG8_BAR; PG8_WAIT_L(0); PG8_MMA(0, 0, At, B0); PG8_BAR; PG8_SCHED;
            PG8_LDB(B1, 0, 1); PG8_STAGE(PG8_SB(0, 0), b2, voffB);
            PG8_BAR; PG8_WAIT_L(0); PG8_MMA(0, 1, At, B1); PG8_BAR;
            PG8_LDA(At, 0, 1); PG8_STAGE(PG8_SA(0, 0), a2, voffA);
            PG8_BAR; PG8_WAIT_L(0); PG8_MMA(1, 0, At, B0); PG8_BAR; PG8_SCHED;
            PG8_STAGE(PG8_SB(0, 1), b2 + hstep, voffB);
            PG8_WAIT_V(6); PG8_BAR; PG8_MMA(1, 1, At, B1); PG8_BAR;
            PG8_LDB(B0, 1, 0); PG8_SCHED; PG8_LDA(At, 1, 0); PG8_STAGE(PG8_SA(0, 1), a2 + hstep, voffA);
            PG8_WAIT_L(8); PG8_BAR; PG8_WAIT_L(0); PG8_MMA(0, 0, At, B0); PG8_BAR; PG8_SCHED;
            PG8_LDB(B1, 1, 1); PG8_STAGE(PG8_SB(1, 0), b3, voffB);
            PG8_BAR; PG8_WAIT_L(0); PG8_MMA(0, 1, At, B1); PG8_BAR;
            PG8_LDA(At, 1, 1); PG8_STAGE(PG8_SA(1, 0), a3, voffA);
            PG8_BAR; PG8_WAIT_L(0); PG8_MMA(1, 0, At, B0); PG8_BAR; PG8_SCHED;
            PG8_STAGE(PG8_SB(1, 1), b3 + hstep, voffB);
            PG8_WAIT_V(6); PG8_BAR; PG8_MMA(1, 1, At, B1); PG8_BAR;
        }
        E(acc, cur, wr, wc, fr, fq); S.done(cur);
        if (!has_next) break;
#pragma unroll
        for (int a = 0; a < 2; ++a)
#pragma unroll
            for (int b = 0; b < 2; ++b)
#pragma unroll
                for (int m = 0; m < 4; ++m)
#pragma unroll
                    for (int n = 0; n < 2; ++n) acc[a][b][m][n] = (f32x4){0.f, 0.f, 0.f, 0.f};
        cur = nxt; cA = nA; cB = nB; ++ui;
    }
    PG8_WAIT_V(0);
    if (wr == 0) PG8_BAR;
    PG8_BAR;
#undef PG8_SA
#undef PG8_SB
#undef PG8_STAGE
#undef PG8_LDA
#undef PG8_LDB
#undef PG8_MMA
#undef PG8_WAIT_V
#undef PG8_WAIT_L
#undef PG8_BAR
#undef PG8_SCHED
}
}

struct JobDesc { unsigned long long in_off, dst_off; int in_idx, gain_idx, gain_off, ldw, col0, ncols, K, nrows, mode, pad; };
constexpr int MAXJOBS = 32;
struct Params { const float* in[17]; float* out; unsigned char* ws; JobDesc jobs[MAXJOBS]; int njobs, pad; };
enum { I_X = 0, I_MEM, I_NORMG, I_AWIN, I_AWOUT, I_BWIN, I_BWOUT, I_MEMWKV, I_WGU, I_WDOWN, I_KVNG, I_KVW, I_PE, I_WK1, I_WK2, I_WV1, I_WV2 };

struct ConvJob { const float* W; const float* gain; bf16_t* dst; int ldw, col0, ncols, K, nrows, mode; };
__device__ __forceinline__ bool conv_get(const Params& p, int j, ConvJob& J) {
    if (j >= p.njobs) return false;
    const JobDesc& d = p.jobs[j];
    J.W = p.in[d.in_idx] + d.in_off; J.gain = d.gain_idx >= 0 ? p.in[d.gain_idx] + d.gain_off : nullptr; J.dst = (bf16_t*)(p.ws + d.dst_off);
    J.ldw = d.ldw; J.col0 = d.col0; J.ncols = d.ncols; J.K = d.K; J.nrows = d.nrows; J.mode = d.mode;
    return true;
}
__device__ __forceinline__ void conv_load(const ConvJob& J, int it, int nblk, int lane, f32x4 (&v)[16]) {
    const int kb = it / nblk, nb = it - kb * nblk, k0 = 64 * kb, n = 64 * nb + 4 * (lane & 15), kr = lane >> 4;
    const bool ok = n < J.ncols;
    const int sc = J.mode == 1 ? (((n >> 7) & 1) * 5632 + (n >> 8) * 128 + (n & 127)) : (J.col0 + n);
    const float* src = J.W + (size_t)(k0 + kr) * J.ldw + sc;
#pragma unroll
    for (int i = 0; i < 16; ++i) v[i] = ok ? *(const f32x4*)(src + (size_t)(4 * i) * J.ldw) : (f32x4){0.f, 0.f, 0.f, 0.f};
}
__device__ __forceinline__ void conv_emit(const ConvJob& J, LAS float* scr, int it, int nblk, int lane, const f32x4 (&cur)[16]) {
    const int c4 = lane & 15, kr = lane >> 4, nb8 = lane >> 3, c = lane & 7;
    const int kb = it / nblk, nb = it - kb * nblk, k0 = 64 * kb, n0 = 64 * nb;
#pragma unroll
    for (int i = 0; i < 16; ++i) *(LAS f32x4*)(scr + (kr + 4 * i) * 64 + ((c4 ^ (i >> 1)) << 2)) = cur[i];
    LDS_WAIT();
    f32x4 g0 = {1.f, 1.f, 1.f, 1.f}, g1 = {1.f, 1.f, 1.f, 1.f};
    if (J.gain) { g0 = *(const f32x4*)(J.gain + k0 + 8 * c); g1 = *(const f32x4*)(J.gain + k0 + 8 * c + 4); }
#pragma unroll
    for (int j = 0; j < 8; ++j) { const int n = nb8 + 8 * j; const LAS float* t = scr + (8 * c) * 64 + ((((n >> 2) ^ c) << 2) | (n & 3));
        u32x4 o; o.x = pk2(t[0 * 64] * g0[0], t[1 * 64] * g0[1]); o.y = pk2(t[2 * 64] * g0[2], t[3 * 64] * g0[3]); o.z = pk2(t[4 * 64] * g1[0], t[5 * 64] * g1[1]); o.w = pk2(t[6 * 64] * g1[2], t[7 * 64] * g1[3]);
        *(u32x4*)(J.dst + (size_t)(n0 + n) * J.K + k0 + 8 * c) = o; }
    LDS_WAIT();
}
__device__ __forceinline__ void conv_run(const ConvJob& J, LAS float* scr, int gw, int ngw, int lane) {
    const int nblk = J.nrows / 64, kblk = J.K / 64, items = nblk * kblk;
    f32x4 bufA[16], bufB[16];
    int it = gw;
    if (it < items) conv_load(J, it, nblk, lane, bufA);
    while (it < items) {
        if (it + ngw < items) conv_load(J, it + ngw, nblk, lane, bufB);
        conv_emit(J, scr, it, nblk, lane, bufA);
        it += ngw; if (it >= items) break;
        if (it + ngw < items) conv_load(J, it + ngw, nblk, lane, bufA);
        conv_emit(J, scr, it, nblk, lane, bufB);
        it += ngw;
    }
}

__device__ __forceinline__ void rms_row(const float* xrow, bf16_t* orow, float* scale_out, int lane) {
    const f32x4* xr = (const f32x4*)xrow + lane;
    f32x4 v[8]; float s = 0.f;
#pragma unroll
    for (int j = 0; j < 8; ++j) { v[j] = xr[64 * j]; s += (v[j].x * v[j].x + v[j].y * v[j].y) + (v[j].z * v[j].z + v[j].w * v[j].w); }
    const float ms = wave_sum(s) * (1.f / 2048.f) + 1e-6f, rs = rsqrtf(ms);
    u32x2* o8 = (u32x2*)orow + lane;
#pragma unroll
    for (int j = 0; j < 8; ++j) { u32x2 w; w.x = pk2(v[j].x * rs, v[j].y * rs); w.y = pk2(v[j].z * rs, v[j].w * rs); o8[64 * j] = w; }
    if (scale_out && lane == 0) *scale_out = sqrtf(ms);
}
__device__ __forceinline__ void rowop_row(bf16_t* hrow, float* scale, const bf16_t* orow, const float* gain, float* outrow, int lane) {
    const u32x2* o2 = (const u32x2*)orow + lane; u32x2* h2 = (u32x2*)hrow + lane; const f32x4* g4 = (const f32x4*)gain + lane;
    const float sc = *scale;
    f32x4 o[8]; float s = 0.f;
#pragma unroll
    for (int j = 0; j < 8; ++j) { const u32x2 w = o2[64 * j]; o[j] = (f32x4){bflo(w.x), bfhi(w.x), bflo(w.y), bfhi(w.y)}; s += (o[j].x * o[j].x + o[j].y * o[j].y) + (o[j].z * o[j].z + o[j].w * o[j].w); }
    const float rs = rsqrtf(wave_sum(s) * (1.f / 2048.f) + 1e-6f);
    float s2 = 0.f;
#pragma unroll
    for (int j = 0; j < 8; ++j) { const f32x4 g = g4[64 * j]; const u32x2 w = h2[64 * j]; f32x4 x = (f32x4){bflo(w.x), bfhi(w.x), bflo(w.y), bfhi(w.y)} * sc; x = x + o[j] * rs * g; o[j] = x; s2 += (x.x * x.x + x.y * x.y) + (x.z * x.z + x.w * x.w); }
    if (outrow) { f32x4* x4 = (f32x4*)outrow + lane;
#pragma unroll
        for (int j = 0; j < 8; ++j) x4[64 * j] = o[j];
        return; }
    const float ms2 = wave_sum(s2) * (1.f / 2048.f) + 1e-6f, rs2 = rsqrtf(ms2);
#pragma unroll
    for (int j = 0; j < 8; ++j) { u32x2 w; w.x = pk2(o[j].x * rs2, o[j].y * rs2); w.y = pk2(o[j].z * rs2, o[j].w * rs2); h2[64 * j] = w; }
    if (lane == 0) *scale = sqrtf(ms2);
}

typedef short s16x4 __attribute__((ext_vector_type(4)));
constexpr int AT_ROWB = 272, AT_TILEB = 64 * AT_ROWB, AT_STAGEB = 2 * AT_TILEB;
constexpr int AT_AUX = 2 * AT_STAGEB;
constexpr float SCALE2 = 0.12751743f;
constexpr float LOG2E = 1.4426950408889634f, LN2 = 0.6931471805599453f;
struct AttnArgs {
    const bf16_t* q; size_t qstride;
    const bf16_t* k; const bf16_t* v; size_t kvstride;
    unsigned tilemask;
    int nkeys, qpos0, kmul, maxdist;
    float slope2;
    int nrows;
};
__device__ __forceinline__ void at_gload(const AttnArgs& A, int kt, int tid, u32x4 (&kr)[2], u32x4 (&vr)[2]) {
#pragma unroll
    for (int i = 0; i < 2; ++i) { const int id = tid + 512 * i, row = id >> 4, c16 = id & 15; const size_t off = (size_t)(64 * kt + row) * A.kvstride + 8 * c16;
        kr[i] = *(const u32x4*)(A.k + off); vr[i] = *(const u32x4*)(A.v + off); }
}
__device__ __forceinline__ void at_lstore(LAS unsigned char* st, int tid, const u32x4 (&kr)[2], const u32x4 (&vr)[2]) {
#pragma unroll
    for (int i = 0; i < 2; ++i) { const int id = tid + 512 * i, row = id >> 4, c16 = id & 15;
        *(LAS u32x4*)(st + row * AT_ROWB + c16 * 16) = kr[i];
        const int prow = (row & ~12) | (((row >> 2) & 1) << 3) | (((row >> 3) & 1) << 2), swz = ((prow & 3) << 2) | ((prow >> 2) & 3);
        *(LAS u32x4*)(st + AT_TILEB + prow * 256 + ((c16 ^ swz) << 4)) = vr[i]; }
}
__device__ __forceinline__ bf16x8 pack8(const f32x4& a, const f32x4& b) {
    u32x4 w; w.x = pg8::cvt_pk_bf16(a[0], a[1]); w.y = pg8::cvt_pk_bf16(a[2], a[3]); w.z = pg8::cvt_pk_bf16(b[0], b[1]); w.w = pg8::cvt_pk_bf16(b[2], b[3]);
    return __builtin_bit_cast(bf16x8, w);
}
__device__ __forceinline__ bf16x8 tr_pair(const LAS unsigned char* p0, const LAS unsigned char* p1) {
    const s16x4 lo = __builtin_amdgcn_ds_read_tr16_b64_v4i16((LAS s16x4*)p0), hi = __builtin_amdgcn_ds_read_tr16_b64_v4i16((LAS s16x4*)p1);
    return __builtin_shufflevector(lo, hi, 0, 1, 2, 3, 4, 5, 6, 7);
}
struct AttnPre { bf16x8 qf[2][4]; u32x4 kA[2], vA[2], kB[2], vB[2]; };
__device__ __forceinline__ void attn_issue_q(const AttnArgs& A, int tid, AttnPre& P) {
    const int lane = tid & 63, wave = tid >> 6, fr = lane & 15, fq = lane >> 4;
#pragma unroll
    for (int rb = 0; rb < 2; ++rb) { const bf16_t* qp = A.q + (size_t)(wave * 32 + rb * 16 + fr) * A.qstride + 8 * fq;
#pragma unroll
        for (int dc = 0; dc < 4; ++dc) P.qf[rb][dc] = *(const bf16x8*)(qp + 32 * dc); }
}
__device__ __forceinline__ void attn_issue_kv(const AttnArgs& A, int tid, AttnPre& P) {
    unsigned tm = A.tilemask;
    if (tm == 0u) return;
    const int k0 = 31 - __builtin_clz(tm); tm &= ~(1u << k0);
    at_gload(A, k0, tid, P.kA, P.vA);
    if (tm) { const int k1 = 31 - __builtin_clz(tm); at_gload(A, k1, tid, P.kB, P.vB); }
}
template <bool USE_SEL>
__device__ __forceinline__ void attn_run(LAS unsigned char* lds, const AttnArgs& A, const unsigned (&selmask)[2], int tid, AttnPre& P, f32x4 (&o)[2][8], float (&m)[2], float (&l)[2]) {
    const int lane = tid & 63, wave = __builtin_amdgcn_readfirstlane(tid >> 6), fr = lane & 15, fq = lane >> 4;
    bf16x8 (&qf)[2][4] = P.qf;
#pragma unroll
    for (int rb = 0; rb < 2; ++rb) { m[rb] = -INFINITY; l[rb] = 0.f;
#pragma unroll
        for (int db = 0; db < 8; ++db) o[rb][db] = (f32x4){0.f, 0.f, 0.f, 0.f}; }
    unsigned tm = A.tilemask;
    if (tm == 0u) return;
    const int wr0 = 32 * wave, wq0 = A.qpos0 + wr0;
    const int qp0 = A.qpos0 + wr0 + fr;
    const bool nomask = A.kmul == 0;
    auto tile = [&](const int kt, const LAS unsigned char* st) {
        if (wr0 >= A.nrows) return;
        const int dlo = wq0 - 64 * kt - 63, dhi = wq0 + 31 - 64 * kt;
        bool tsel[2]; tsel[0] = USE_SEL ? (((selmask[0] >> kt) & 1u) != 0u) : true; tsel[1] = USE_SEL ? (((selmask[1] >> kt) & 1u) != 0u) : true;
        if (!nomask && (dhi < 0 || dlo > A.maxdist || (USE_SEL && !__any(tsel[0] || tsel[1])))) return;
        const bool interior = nomask || (dlo >= 0 && dhi <= A.maxdist && (!USE_SEL || __all(tsel[0] && tsel[1])));
        f32x4 s[2][4];
        { const LAS unsigned char* kbase = st + fr * AT_ROWB + fq * 16;
#pragma unroll
          for (int kb = 0; kb < 4; ++kb) { s[0][kb] = (f32x4){0.f, 0.f, 0.f, 0.f}; s[1][kb] = (f32x4){0.f, 0.f, 0.f, 0.f};
#pragma unroll
              for (int dc = 0; dc < 4; ++dc) { const bf16x8 kf = *(const LAS bf16x8*)(kbase + kb * 16 * AT_ROWB + dc * 64);
                  s[0][kb] = __builtin_amdgcn_mfma_f32_16x16x32_bf16(kf, qf[0][dc], s[0][kb], 0, 0, 0); s[1][kb] = __builtin_amdgcn_mfma_f32_16x16x32_bf16(kf, qf[1][dc], s[1][kb], 0, 0, 0); } } }
        float muse[2];
        bool moved = false;
#pragma unroll
        for (int rb = 0; rb < 2; ++rb) {
            const int D0r = qp0 + 16 * rb - 64 * kt - 4 * fq, D0 = (USE_SEL && !tsel[rb]) ? -(1 << 30) : D0r;
            const float B0 = nomask ? 0.f : -A.slope2 * (float)D0r;
            float tmax = -INFINITY;
            if (interior) {
#pragma unroll
                for (int kb = 0; kb < 4; ++kb)
#pragma unroll
                    for (int e = 0; e < 4; ++e) { const float x = fmaf(s[rb][kb][e], SCALE2, fmaf(A.slope2, (float)(16 * kb + e), B0)); s[rb][kb][e] = x; tmax = fmaxf(tmax, x); }
            } else {
#pragma unroll
                for (int kb = 0; kb < 4; ++kb)
#pragma unroll
                    for (int e = 0; e < 4; ++e) { const bool valid = (unsigned)(D0 - (16 * kb + e)) <= (unsigned)A.maxdist;
                        const float x = valid ? fmaf(s[rb][kb][e], SCALE2, fmaf(A.slope2, (float)(16 * kb + e), B0)) : -INFINITY; s[rb][kb][e] = x; tmax = fmaxf(tmax, x); }
            }
            tmax = fmaxf(tmax, __shfl_xor(tmax, 16)); tmax = fmaxf(tmax, __shfl_xor(tmax, 32));
            const float mnew = fmaxf(m[rb], tmax); muse[rb] = (mnew == -INFINITY) ? 0.f : mnew;
            moved = moved || (mnew != m[rb]);
            if (!__all(mnew == m[rb])) {
                const float alpha = __builtin_amdgcn_exp2f(m[rb] - muse[rb]);
                l[rb] *= alpha;
#pragma unroll
                for (int db = 0; db < 8; ++db) o[rb][db] *= alpha;
            }
            m[rb] = mnew;
#pragma unroll
            for (int kb = 0; kb < 4; ++kb)
#pragma unroll
                for (int e = 0; e < 4; ++e) { const float pv = __builtin_amdgcn_exp2f(s[rb][kb][e] - muse[rb]); s[rb][kb][e] = pv; l[rb] += pv; }
        }
        (void)moved;
        const int vq = fr >> 2, vp = fr & 3, vS = (vq << 2) | (2 * (fq & 1) + (fq >> 1)), vx0 = ((vp >> 1) ^ vS) & 1, vS14 = vS & 14;
        const LAS unsigned char* vbase = st + AT_TILEB + 256 * (8 * (fq & 1) + 4 * (fq >> 1) + vq) + 8 * (vp & 1);
#pragma unroll
        for (int c = 0; c < 2; ++c) { const bf16x8 pf0 = pack8(s[0][2 * c], s[0][2 * c + 1]), pf1 = pack8(s[1][2 * c], s[1][2 * c + 1]);
#pragma unroll
            for (int db = 0; db < 8; ++db) { const int co = (((2 * db) ^ vS14) | vx0) << 4; const bf16x8 vf = tr_pair(vbase + c * 32 * 256 + co, vbase + (c * 32 + 16) * 256 + co);
                o[0][db] = __builtin_amdgcn_mfma_f32_16x16x32_bf16(vf, pf0, o[0][db], 0, 0, 0); o[1][db] = __builtin_amdgcn_mfma_f32_16x16x32_bf16(vf, pf1, o[1][db], 0, 0, 0); } }
    };
    u32x4 (&krA)[2] = P.kA; u32x4 (&vrA)[2] = P.vA; u32x4 (&krB)[2] = P.kB; u32x4 (&vrB)[2] = P.vB;
    int k0 = 31 - __builtin_clz(tm); tm &= ~(1u << k0);
    int k1 = -1; if (tm) { k1 = 31 - __builtin_clz(tm); tm &= ~(1u << k1); }
    at_lstore(lds, tid, krA, vrA); __syncthreads();
    for (;;) {
        int k2 = -1; if (tm) { k2 = 31 - __builtin_clz(tm); tm &= ~(1u << k2); }
        if (k2 >= 0) at_gload(A, k2, tid, krA, vrA);
        tile(k0, lds);
        if (k1 >= 0) at_lstore(lds + AT_STAGEB, tid, krB, vrB);
        __syncthreads();
        if (k1 < 0) break;
        int k3 = -1; if (tm) { k3 = 31 - __builtin_clz(tm); tm &= ~(1u << k3); }
        if (k3 >= 0) at_gload(A, k3, tid, krB, vrB);
        tile(k1, lds + AT_STAGEB);
        if (k2 >= 0) at_lstore(lds, tid, krA, vrA);
        __syncthreads();
        if (k2 < 0) break;
        k0 = k2; k1 = k3;
    }
#pragma unroll
    for (int rb = 0; rb < 2; ++rb) { l[rb] += __shfl_xor(l[rb], 16); l[rb] += __shfl_xor(l[rb], 32); }
}
template <bool USE_SEL>
__device__ __forceinline__ void attn_core(LAS unsigned char* lds, const AttnArgs& A, const unsigned (&selmask)[2], int tid, f32x4 (&o)[2][8], float (&m)[2], float (&l)[2]) {
    AttnPre P; attn_issue_q(A, tid, P); attn_issue_kv(A, tid, P); attn_run<USE_SEL>(lds, A, selmask, tid, P, o, m, l);
}
__device__ __forceinline__ void at_store_o(bf16_t* orow, const f32x4 (&o)[8], float inv, int fq) {
#pragma unroll
    for (int db = 0; db < 8; ++db) { u32x2 w; w.x = pg8::cvt_pk_bf16(o[db][0] * inv, o[db][1] * inv); w.y = pg8::cvt_pk_bf16(o[db][2] * inv, o[db][3] * inv); *(u32x2*)(orow + 16 * db + 4 * fq) = w; }
}
__device__ __forceinline__ void mem_args(AttnArgs& A, const bf16_t* proj, int nh, int mq0, const bf16_t* memkv, int l, int b, int h, int qb) {
    A.q = proj + ((size_t)(b * nh + mq0 + h) * SEQ + qb * 256) * HD; A.qstride = HD; A.k = memkv + (size_t)(b * 32 + l * 8 + h) * 256 * HD; A.v = A.k + (size_t)4 * 256 * HD; A.kvstride = HD;
    A.tilemask = 0xFu; A.nkeys = 256; A.qpos0 = 1 << 20; A.kmul = 0; A.maxdist = 0x7fffffff; A.slope2 = 0.f; A.nrows = 256;
}
__device__ __forceinline__ void mem_attn_wg(LAS unsigned char* lds, const bf16_t* proj, int nh, int mq0, const bf16_t* memkv, int l, bf16_t* cat, int ldc, int memoff, int b, int h, int qb, int tid_) {
    int tid = tid_; asm volatile("" : "+v"(tid));
    AttnArgs A; mem_args(A, proj, nh, mq0, memkv, l, b, h, qb);
    const unsigned nosel[2] = {0u, 0u};
    f32x4 o[2][8]; float m[2], lsum[2]; attn_core<false>(lds, A, nosel, tid, o, m, lsum);
    const int lane = tid & 63, t0 = b * SEQ + qb * 256;
#pragma unroll
    for (int rb = 0; rb < 2; ++rb) { const int row = (tid >> 6) * 32 + rb * 16 + (lane & 15);
        at_store_o(cat + (size_t)(t0 + row) * ldc + memoff + h * HD, o[rb], 1.0f / fmaxf(lsum[rb], 1e-30f), lane >> 4); }
}
__device__ __forceinline__ void dil_attn_wg(LAS unsigned char* lds, const bf16_t* proj, bf16_t* og, float* lse, int b, int hh, int x, int tid_) {
    int tid = tid_; asm volatile("" : "+v"(tid));
    const int gi = hh >> 3, j = hh & 7, d = gi == 0 ? 1 : (gi == 1 ? 4 : 16), L = SEQ / d, nqb = gi == 0 ? 8 : (gi == 1 ? 2 : 1), r = x / nqb, qb = x % nqb, c0 = qb * 256;
    const float slope = exp2f(-8.0f * (float)(hh + 1) / 24.0f);
    AttnArgs A; A.q = proj + ((size_t)(b * 76 + hh) * SEQ + c0 * d + r) * HD; A.qstride = (size_t)d * HD;
    A.k = proj + ((size_t)(b * 76 + 24 + hh) * SEQ + r) * HD; A.v = A.k + (size_t)24 * SEQ * HD; A.kvstride = (size_t)d * HD;
    { const int ktc = c0 >> 6, k0 = ktc - 2 < 0 ? 0 : ktc - 2, kend = (ktc + 4 < L / 64 ? ktc + 4 : L / 64) - 1; A.tilemask = (0xffffffffu >> (31 - kend)) & (0xffffffffu << k0); }
    A.nkeys = L; A.qpos0 = c0; A.kmul = 1; A.maxdist = 128; A.slope2 = slope * (float)d * LOG2E; A.nrows = L - c0 < 256 ? L - c0 : 256;
    const unsigned nosel[2] = {0u, 0u};
    f32x4 o[2][8]; float m[2], lsum[2]; attn_core<false>(lds, A, nosel, tid, o, m, lsum);
    const int lane = tid & 63, fr = lane & 15, fq = lane >> 4;
#pragma unroll
    for (int rb = 0; rb < 2; ++rb) { const int row = (tid >> 6) * 32 + rb * 16 + fr;
        if (row < A.nrows) { const size_t t = (size_t)b * SEQ + (size_t)(c0 + row) * d + r;
            at_store_o(og + ((size_t)gi * NTOK + t) * 1024 + j * HD, o[rb], 1.0f / fmaxf(lsum[rb], 1e-30f), fq);
            if (fq == 0) lse[((size_t)gi * NTOK + t) * 8 + j] = m[rb] * LN2 + __logf(fmaxf(lsum[rb], 1e-30f)); } }
}
__device__ __forceinline__ void cmp_sel_wg(LAS unsigned char* lds, const bf16_t* proj, const bf16_t* kc, const bf16_t* vc, bf16_t* ocmp, unsigned* sel, unsigned* umw, int b, int g, int qb, int tid_) {
    int tid = tid_; asm volatile("" : "+v"(tid));
    const int lane = tid & 63, wave = tid >> 6, fr = lane & 15, fq = lane >> 4, row = wave * 16 + fr, t0 = b * SEQ + qb * 128, spos_ = qb * 128 + row, cur = spos_ >> 6;
    bf16x8 qf3[3][4];
#pragma unroll
    for (int r = 0; r < 3; ++r) { const bf16_t* qp = proj + ((size_t)(b * 18 + 3 * g + r) * SEQ + qb * 128 + row) * HD + 8 * fq;
#pragma unroll
        for (int dc = 0; dc < 4; ++dc) qf3[r][dc] = *(const bf16x8*)(qp + 32 * dc); }
#pragma unroll
    for (int i = 0; i < 4; ++i) { const int id = tid + 512 * i, n = id >> 4, c16 = id & 15; const size_t off = ((size_t)(b * NCMP + n) * 4 + g) * 256 + 8 * c16;
        *(LAS u32x4*)(lds + n * AT_ROWB + c16 * 16) = *(const u32x4*)(kc + off); *(LAS u32x4*)(lds + 2 * AT_TILEB + n * AT_ROWB + c16 * 16) = *(const u32x4*)(vc + off); }
    __syncthreads();
    float imp[8];
#pragma unroll
    for (int kb = 0; kb < 8; ++kb) imp[kb] = 0.f;
#pragma unroll
    for (int r = 0; r < 3; ++r) {
        const int h = 3 * g + r; const float slope2 = exp2f(-8.0f * (float)(h + 1) / 12.0f) * LOG2E;
        int z = 0; asm volatile("" : "+v"(z));
        const int spos = spos_ + z;
        const bf16x8 (&qf)[4] = qf3[r];
        f32x4 s[8];
        { const LAS unsigned char* kbase = lds + fr * AT_ROWB + fq * 16 + z;
#pragma unroll
          for (int kb = 0; kb < 8; ++kb) { s[kb] = (f32x4){0.f, 0.f, 0.f, 0.f};
#pragma unroll
              for (int dc = 0; dc < 4; ++dc) { const bf16x8 kf = *(const LAS bf16x8*)(kbase + kb * 16 * AT_ROWB + dc * 64); s[kb] = __builtin_amdgcn_mfma_f32_16x16x32_bf16(kf, qf[dc], s[kb], 0, 0, 0); } } }
        float tmax = -INFINITY;
#pragma unroll
        for (int kb = 0; kb < 8; ++kb)
#pragma unroll
            for (int e = 0; e < 4; ++e) { const int n = 16 * kb + 4 * fq + e, dist = spos - (16 * n + 31); const bool valid = (dist >= 0) && (n < NCMP);
                const float x = valid ? (s[kb][e] * SCALE2 - slope2 * (float)dist) : -INFINITY; s[kb][e] = x; tmax = fmaxf(tmax, x); }
        tmax = fmaxf(tmax, __shfl_xor(tmax, 16)); tmax = fmaxf(tmax, __shfl_xor(tmax, 32));
        const float muse = (tmax == -INFINITY) ? 0.f : tmax;
        float lsum = 0.f;
#pragma unroll
        for (int kb = 0; kb < 8; ++kb)
#pragma unroll
            for (int e = 0; e < 4; ++e) { const float pv = __builtin_amdgcn_exp2f(s[kb][e] - muse); s[kb][e] = pv; lsum += pv; }
        lsum += __shfl_xor(lsum, 16); lsum += __shfl_xor(lsum, 32);
        const float inv = 1.0f / fmaxf(lsum, 1e-30f);
#pragma unroll
        for (int kb = 0; kb < 8; ++kb) s[kb] *= inv;
#pragma unroll
        for (int kb = 0; kb < 8; ++kb) { const float t1 = __shfl(s[kb][3], (lane - 16) & 63); const float t0v = kb > 0 ? __shfl(s[kb > 0 ? kb - 1 : 0][3], (lane - 16) & 63) : 0.f;
            imp[kb] += s[kb][0] + s[kb][1] + s[kb][2] + 0.5f * s[kb][3] + 0.5f * (fq == 0 ? t0v : t1); }
        f32x4 o[8];
#pragma unroll
        for (int db = 0; db < 8; ++db) o[db] = (f32x4){0.f, 0.f, 0.f, 0.f};
        { const LAS unsigned char* vbase = lds + 2 * AT_TILEB + (4 * fq + (fr >> 2)) * AT_ROWB + 8 * (fr & 3);
#pragma unroll
          for (int c = 0; c < 4; ++c) { const bf16x8 pf = pack8(s[2 * c], s[2 * c + 1]);
#pragma unroll
              for (int db = 0; db < 8; ++db) { const bf16x8 vf = tr_pair(vbase + c * 32 * AT_ROWB + db * 32, vbase + c * 32 * AT_ROWB + 16 * AT_ROWB + db * 32);
                  o[db] = __builtin_amdgcn_mfma_f32_16x16x32_bf16(vf, pf, o[db], 0, 0, 0); } } }
        at_store_o(ocmp + (size_t)(t0 + row) * 1536 + h * HD, o, 1.0f, fq);
    }
    LAS float* rk = (LAS float*)(lds + AT_AUX + wave * 2048) + fr * 32;
    float mine[8];
#pragma unroll
    for (int kb = 0; kb < 8; ++kb) { const int j = 4 * kb + fq; const bool forced = (j == 0) || (j == cur) || (j == cur - 1);
        mine[kb] = forced ? 1e4f : (j > cur ? -1e4f : imp[kb]); rk[j] = mine[kb]; }
    LDS_WAIT();
    int rank[8];
#pragma unroll
    for (int kb = 0; kb < 8; ++kb) rank[kb] = 0;
#pragma unroll
    for (int j4 = 0; j4 < 8; ++j4) { const f32x4 v = *(const LAS f32x4*)(rk + 4 * j4);
#pragma unroll
        for (int e = 0; e < 4; ++e) { const int jj = 4 * j4 + e;
#pragma unroll
            for (int kb = 0; kb < 8; ++kb) { const int j = 4 * kb + fq; rank[kb] += (v[e] > mine[kb] || (v[e] == mine[kb] && jj < j)) ? 1 : 0; } } }
    unsigned bits = 0u;
#pragma unroll
    for (int kb = 0; kb < 8; ++kb) { const int j = 4 * kb + fq; if (rank[kb] < 16 && j <= cur) bits |= 1u << j; }
    bits |= __shfl_xor(bits, 16); bits |= __shfl_xor(bits, 32);
    if (fq == 0) sel[(size_t)(t0 + row) * 4 + g] = bits;
    { unsigned wb = bits;
#pragma unroll
      for (int o_ = 1; o_ < 16; o_ <<= 1) wb |= __shfl_xor(wb, o_);
      LAS unsigned* wgw = (LAS unsigned*)(lds + AT_AUX + 8 * 2048);
      if (lane == 0) wgw[wave] = wb;
      __syncthreads();
      if (tid == 0) umw[(b * 4 + g) * 16 + qb] = wgw[0] | wgw[1] | wgw[2] | wgw[3] | wgw[4] | wgw[5] | wgw[6] | wgw[7]; }
}
__device__ __forceinline__ void nsa_attn_wg(LAS unsigned char* lds, const bf16_t* proj, const bf16_t* kvs, const unsigned* sel, const unsigned* umw, const bf16_t* ocmp, bf16_t* cat, int b, int h, int qb, int tid_) {
    int tid = tid_; asm volatile("" : "+v"(tid));
    const int lane = tid & 63, wave = tid >> 6, fr = lane & 15, fq = lane >> 4, g = h / 3, t0 = b * SEQ + qb * 256;
    const float slope2 = exp2f(-8.0f * (float)(h + 1) / 12.0f) * LOG2E;
    const unsigned umv = __hip_atomic_load(umw + (b * 4 + g) * 16 + 2 * qb, __ATOMIC_RELAXED, __HIP_MEMORY_SCOPE_AGENT) | __hip_atomic_load(umw + (b * 4 + g) * 16 + 2 * qb + 1, __ATOMIC_RELAXED, __HIP_MEMORY_SCOPE_AGENT);
    unsigned selmask[2];
#pragma unroll
    for (int rb = 0; rb < 2; ++rb) selmask[rb] = sel[(size_t)(t0 + wave * 32 + rb * 16 + fr) * 4 + g];
    const bf16_t* kvb = kvs + (size_t)(b * 24 + g) * SEQ * HD;
    constexpr size_t KIND = (size_t)4 * SEQ * HD;
    AttnArgs Aw; Aw.q = proj + ((size_t)(b * 18 + h) * SEQ + qb * 256) * HD; Aw.qstride = HD; Aw.kvstride = HD; Aw.nkeys = SEQ; Aw.qpos0 = qb * 256; Aw.kmul = 1; Aw.slope2 = slope2; Aw.nrows = 256;
    Aw.k = kvb + 4 * KIND; Aw.v = kvb + 5 * KIND; Aw.maxdist = 511;
    { const int k0 = 4 * qb - 8 < 0 ? 0 : 4 * qb - 8, k1 = 4 * qb + 3; Aw.tilemask = (0xffffffffu >> (31 - k1)) & (0xffffffffu << k0); }
    AttnPre Pw; attn_issue_q(Aw, tid, Pw); attn_issue_kv(Aw, tid, Pw);
    const unsigned um = (unsigned)__builtin_amdgcn_readfirstlane((int)umv);
    AttnArgs As = Aw; As.k = kvb + 2 * KIND; As.v = kvb + 3 * KIND; As.maxdist = 0x7fffffff; As.tilemask = um & (0xffffffffu >> (31 - (4 * qb + 3)));
    f32x4 o[2][8]; float m[2], lsum[2];
    { const unsigned nosel[2] = {0u, 0u}; attn_run<false>(lds, Aw, nosel, tid, Pw, o, m, lsum); }
    AttnPre Ps; attn_issue_kv(As, tid, Ps);
#pragma unroll
    for (int rb = 0; rb < 2; ++rb) at_store_o(cat + (size_t)(t0 + wave * 32 + rb * 16 + fr) * 2048 + h * HD, o[rb], 1.0f / fmaxf(lsum[rb], 1e-30f), fq);
#pragma unroll
    for (int rb = 0; rb < 2; ++rb)
#pragma unroll
        for (int dc = 0; dc < 4; ++dc) Ps.qf[rb][dc] = Pw.qf[rb][dc];
    attn_run<true>(lds, As, selmask, tid, Ps, o, m, lsum);
#pragma unroll
    for (int rb = 0; rb < 2; ++rb) { const int row = wave * 32 + rb * 16 + fr;
        const bf16_t* gp = proj + ((size_t)(b * 18 + 16) * SEQ + qb * 256 + row) * HD + h * 3;
        const float g0 = 1.0f / (1.0f + __expf(-bflo((unsigned)gp[0]))), g1 = 1.0f / (fmaxf(lsum[rb], 1e-30f) * (1.0f + __expf(-bflo((unsigned)gp[1])))), g2 = 1.0f / (1.0f + __expf(-bflo((unsigned)gp[2])));
        bf16_t* orow = cat + (size_t)(t0 + row) * 2048 + h * HD + 4 * fq; const bf16_t* crow = ocmp + (size_t)(t0 + row) * 1536 + h * HD + 4 * fq;
#pragma unroll
        for (int db = 0; db < 8; ++db) { const u32x2 c = *(const u32x2*)(crow + 16 * db), wv = *(const u32x2*)(orow + 16 * db);
            const float r0 = g0 * bflo(c.x) + g1 * o[rb][db][0] + g2 * bflo(wv.x), r1 = g0 * bfhi(c.x) + g1 * o[rb][db][1] + g2 * bfhi(wv.x);
            const float r2 = g0 * bflo(c.y) + g1 * o[rb][db][2] + g2 * bflo(wv.y), r3 = g0 * bfhi(c.y) + g1 * o[rb][db][3] + g2 * bfhi(wv.y);
            u32x2 w; w.x = pg8::cvt_pk_bf16(r0, r1); w.y = pg8::cvt_pk_bf16(r2, r3); *(u32x2*)(orow + 16 * db) = w; } }
}
__device__ __forceinline__ int opq_tid() { int t = threadIdx.x; asm volatile("" : "+v"(t)); return t; }
__global__ void __launch_bounds__(NTHREADS, 2) mega_fwd(Params p) {
    extern __shared__ __attribute__((aligned(16))) unsigned char lds_raw[];
    LAS unsigned char* lds = (LAS unsigned char*)lds_raw;
    cg::grid_group grid = cg::this_grid();
    const int tid = threadIdx.x, lane = tid & 63, wave = __builtin_amdgcn_readfirstlane(tid >> 6);
    const int G = gridDim.x, bid = blockIdx.x;
    volatile LAS unsigned* bst = (volatile LAS unsigned*)(lds + LDS_MAIN);
    if (tid < 2) bst[tid] = 0u;
    __syncthreads();
    const XcdBarrier gbar = xcd_barrier_post((unsigned*)(p.ws + WS_BAR), bst);
    grid.sync();
    const int gw = bid * NWAVES + wave, ngw = G * NWAVES;
    unsigned char* ws = p.ws;
    float* X = p.out;
    bf16_t* XH = (bf16_t*)(ws + WS_XH); bf16_t* PROJ = (bf16_t*)(ws + WS_PROJ); float* OBUF = (float*)(ws + WS_OBUF);
    bf16_t* CAT = (bf16_t*)(ws + WS_CAT); bf16_t* KVS = (bf16_t*)(ws + WS_KVS); bf16_t* MEMKV = (bf16_t*)(ws + WS_MEMKV); bf16_t* MEMHAT = (bf16_t*)(ws + WS_MEMHAT);
    bf16_t* OG = (bf16_t*)(ws + WS_KVS); float* LSE = (float*)(ws + WS_HID); unsigned* SEL = (unsigned*)(ws + WS_SEL); unsigned* UMW = (unsigned*)(ws + WS_UM); float* XS = (float*)(ws + WS_XS);
    bf16_t* OCMP = (bf16_t*)(ws + WS_OBUF);
    bf16_t* OBF = (bf16_t*)(ws + WS_OBUF + (size_t)NTOK * 2048 * 2);
    bf16_t* HID = (bf16_t*)(ws + WS_HID); bf16_t* KCV = (bf16_t*)(ws + WS_KCV); bf16_t* BLK = (bf16_t*)(ws + WS_OBUF);
    LAS float* wscr = (LAS float*)(lds + wave * 16384);

    unsigned long long tacc = 0, tst = 0;
#define TB(k) do { if (TPROBE == (k)) tst = __builtin_amdgcn_s_memrealtime(); } while (0)
#define TE(k) do { if (TPROBE == (k)) tacc += __builtin_amdgcn_s_memrealtime() - tst; } while (0)
    TB(1);
    for (int rep_ = 0; rep_ < REP_P0; ++rep_) {
        ConvJob J;
        for (int j = 0; conv_get(p, j, J); ++j) conv_run(J, wscr, gw, ngw, lane);
        for (int m = gw; m < 1024; m += ngw) rms_row(p.in[I_MEM] + (size_t)m * 2048, MEMHAT + (size_t)m * 2048, nullptr, lane);
        for (int m = gw; m < NTOK; m += ngw) rms_row(p.in[I_X] + (size_t)m * 2048, XH + (size_t)m * 2048, XS + m, lane);
    }
    for (int rs_ = 0; rs_ < REP_SYNC; ++rs_) xcd_barrier(gbar);
    TE(1);

    for (int l = 0; l < 4; ++l) {
        const bool isA = l < 2;
        for (int jb = 0; jb < 3; ++jb) {
            pg8::Gemm g; bf16_t* O; int ldc; int c = bid; int hm = 0, ssh = 11, spn = 1 << 20, hm2 = 0; bf16_t* O2 = nullptr;
            if (jb == 0) { g.A = XH; g.M = NTOK; g.K = 2048;
                if (isA) { g.Bt = (const bf16_t*)(ws + WS_WAIN + l * SZ_WAIN); g.N = A_COLS; O = PROJ; ldc = A_COLS; hm = 76; }
                else { g.Bt = (const bf16_t*)(ws + (l == 2 ? WS_WBIN : WS_WBIN1)); g.N = l == 2 ? B_COLS + 3072 : B_COLS; O = PROJ; ldc = B_COLS; hm = 18; if (l == 2) { spn = 9; O2 = KVS; hm2 = 24; } } }
            else if (jb == 1) { if (l != 0) continue; g.A = MEMHAT; g.Bt = (const bf16_t*)(ws + WS_WMEM); g.M = 1024; g.N = 4096; g.K = 2048; O = MEMKV; ldc = 4096; c = (bid + 64) % G; hm = 32; ssh = 8; }
            else continue;
            pg8::StaticOrder S; S.init(g.M, g.N, G, c);
            pg8::EpiBf16<0> E{O, ldc, hm, ssh, spn, O2, hm2};
            TB(2); for (int rep_ = 0; rep_ < REP_GEMM; ++rep_) pg8::gemm_phase(lds, g, S, E); TE(2);
        }
        for (int rs_ = 0; rs_ < REP_SYNC; ++rs_) xcd_barrier(gbar);
        if (l == 2) {
            const int lane = opq_tid() & 63;
            for (int it = gw; it < 2 * 2048; it += ngw) {
                const int w = it >> 11, row = it & 2047; bf16_t* dst = BLK + ((size_t)w * 2048 + row) * 4096;
                if (row < NBATCH * NCMP * 4) { const int gg = row & 3, bn = row >> 2, bb = bn / NCMP, n = bn % NCMP;
                    const bf16_t* src = KVS + ((size_t)(bb * 24 + w * 4 + gg) * SEQ + 16 * n) * HD; const float* pe = p.in[I_PE] + w * 32 * HD;
                    for (int ll = 0; ll < 32; ++ll) { const unsigned v = *(const unsigned*)(src + (size_t)ll * HD + 2 * lane); const f32x2 e = *(const f32x2*)(pe + ll * HD + 2 * lane);
                        *(unsigned*)(dst + ll * HD + 2 * lane) = pk2(bflo(v) + e.x, bfhi(v) + e.y); } }
                else { for (int ll = 0; ll < 32; ++ll) *(unsigned*)(dst + ll * HD + 2 * lane) = 0u; }
            }
            for (int rs_ = 0; rs_ < REP_SYNC; ++rs_) xcd_barrier(gbar);
            for (int w = 0; w < 2; ++w) { pg8::Gemm g{BLK + (size_t)w * 2048 * 4096, (const bf16_t*)(ws + WS_WC1 + w * SZ_WC1), 2048, 512, 4096};
                pg8::StaticOrder S; S.init(2048, 512, G, (bid + 128 * w) % G); pg8::EpiBf16<1> E{HID + (size_t)w * 2048 * 512, 512, 0, 11, 1 << 20, nullptr, 0}; TB(2); for (int rep_ = 0; rep_ < REP_GEMM; ++rep_) pg8::gemm_phase(lds, g, S, E); TE(2); }
            for (int rs_ = 0; rs_ < REP_SYNC; ++rs_) xcd_barrier(gbar);
            for (int w = 0; w < 2; ++w) { pg8::Gemm g{HID + (size_t)w * 2048 * 512, (const bf16_t*)(ws + WS_WC2 + w * SZ_WC2), 2048, 256, 512};
                pg8::StaticOrder S; S.init(2048, 256, G, (bid + 128 * w) % G); pg8::EpiBf16<0> E{KCV + (size_t)w * 2048 * 256, 256, 0, 11, 1 << 20, nullptr, 0}; TB(2); for (int rep_ = 0; rep_ < REP_GEMM; ++rep_) pg8::gemm_phase(lds, g, S, E); TE(2); }
            for (int rs_ = 0; rs_ < REP_SYNC; ++rs_) xcd_barrier(gbar);
        }
        if (isA) {
            TB(3);
            for (int rep_ = 0; rep_ < REP_ATT; ++rep_)
            for (int it = bid; it < 1152; it += G) {
                if (it < 512) { const int gi = it >> 8, u = it & 255; dil_attn_wg(lds, PROJ, OG, LSE, u >> 6, gi * 8 + ((u >> 3) & 7), u & 7, opq_tid()); }
                else if (it < 640) { const int u = it - 512; mem_attn_wg(lds, PROJ, 76, 72, MEMKV, l, CAT, 1536, 1024, u >> 5, (u >> 3) & 3, u & 7, opq_tid()); }
                else { const int u = it - 640; dil_attn_wg(lds, PROJ, OG, LSE, u >> 7, 16 + ((u >> 4) & 7), u & 15, opq_tid()); }
            }
            for (int rs_ = 0; rs_ < REP_SYNC; ++rs_) xcd_barrier(gbar);
            TE(3); TB(4);
            for (int rep_ = 0; rep_ < REP_ATT; ++rep_)
            for (int it = bid * NTHREADS + opq_tid(); it < NTOK * 8 * 16; it += G * NTHREADS) { const int c8 = it & 15, tj = it >> 4;
                const float l0 = LSE[tj], l1 = LSE[(size_t)NTOK * 8 + tj], l2 = LSE[(size_t)2 * NTOK * 8 + tj], mx = fmaxf(l0, fmaxf(l1, l2));
                float e0 = __expf(l0 - mx), e1 = __expf(l1 - mx), e2 = __expf(l2 - mx); const float inv = 1.0f / (e0 + e1 + e2); e0 *= inv; e1 *= inv; e2 *= inv;
                const u32x4 a = *(const u32x4*)(OG + (size_t)tj * 128 + 8 * c8), bq = *(const u32x4*)(OG + ((size_t)NTOK * 8 + tj) * 128 + 8 * c8), cq = *(const u32x4*)(OG + ((size_t)2 * NTOK * 8 + tj) * 128 + 8 * c8);
                u32x4 w;
                w.x = pk2(e0 * bflo(a.x) + e1 * bflo(bq.x) + e2 * bflo(cq.x), e0 * bfhi(a.x) + e1 * bfhi(bq.x) + e2 * bfhi(cq.x));
                w.y = pk2(e0 * bflo(a.y) + e1 * bflo(bq.y) + e2 * bflo(cq.y), e0 * bfhi(a.y) + e1 * bfhi(bq.y) + e2 * bfhi(cq.y));
                w.z = pk2(e0 * bflo(a.z) + e1 * bflo(bq.z) + e2 * bflo(cq.z), e0 * bfhi(a.z) + e1 * bfhi(bq.z) + e2 * bfhi(cq.z));
                w.w = pk2(e0 * bflo(a.w) + e1 * bflo(bq.w) + e2 * bflo(cq.w), e0 * bfhi(a.w) + e1 * bfhi(bq.w) + e2 * bfhi(cq.w));
                const int t = tj >> 3, j = tj & 7;
                *(u32x4*)(CAT + (size_t)t * 1536 + j * HD + 8 * c8) = w; }
        } else {
            TB(5);
            for (int rep_ = 0; rep_ < REP_ATT * REP_B1; ++rep_)
            for (int it = bid; it < 256; it += G) cmp_sel_wg(lds, PROJ, KCV, KCV + (size_t)2048 * 256, OCMP, SEL, UMW, it >> 6, (it >> 4) & 3, it & 15, opq_tid());
            for (int rs_ = 0; rs_ < REP_SYNC; ++rs_) xcd_barrier(gbar);
            TE(5); TB(6);
            {
                unsigned* qctr = (unsigned*)(p.ws + WS_BAR) + 3584 + 64 * l;
                LAS unsigned* qslot = (LAS unsigned*)(lds + AT_AUX + 8 * 2048 + 64);
                for (;;) {
                    __syncthreads();
                    if (opq_tid() == 0) qslot[0] = __hip_atomic_fetch_add(qctr, 1u, __ATOMIC_RELAXED, __HIP_MEMORY_SCOPE_AGENT);
                    __syncthreads();
                    const int it = (int)qslot[0];
                    if (it >= 512) break;
                    if (it < 384) { const int qb = 7 - it / 48, j = it % 48; nsa_attn_wg(lds, PROJ, KVS, SEL, UMW, OCMP, CAT, j / 12, j % 12, qb, opq_tid()); }
                    else { const int u = it - 384; mem_attn_wg(lds, PROJ, 18, 12, MEMKV, l, CAT, 2048, 1536, u >> 5, (u >> 3) & 3, u & 7, opq_tid()); }
                }
            }
        }
        for (int rs_ = 0; rs_ < REP_SYNC; ++rs_) xcd_barrier(gbar);
        if (isA) TE(4); else TE(6);
        for (int hf = 0; hf < 2; ++hf) {
            if (hf == 1) { pg8::Gemm g{XH, (const bf16_t*)(ws + WS_WGU + l * SZ_WGU), NTOK, 11264, 2048}; pg8::StaticOrder S; S.init(NTOK, 11264, G, bid);
                pg8::EpiSwiGLU E{PROJ, DFF};
                if (STAGGER_US > 0 && bid >= 128) { const unsigned long long t0 = __builtin_amdgcn_s_memrealtime(); while (__builtin_amdgcn_s_memrealtime() - t0 < (unsigned long long)STAGGER_US * 100ull) __builtin_amdgcn_s_sleep(16); } TB(2); for (int rep_ = 0; rep_ < REP_GEMM; ++rep_) pg8::gemm_phase(lds, g, S, E); TE(2); for (int rs_ = 0; rs_ < REP_SYNC; ++rs_) xcd_barrier(gbar); }
            { pg8::Gemm g; g.M = NTOK; g.N = 2048;
              if (hf == 0) { g.A = CAT; g.K = isA ? 1536 : 2048; g.Bt = isA ? (const bf16_t*)(ws + WS_WAOUT + l * SZ_WAOUT) : (const bf16_t*)(ws + WS_WBOUT + (l - 2) * SZ_WBOUT); }
              else { g.A = PROJ; g.K = DFF; g.Bt = (const bf16_t*)(ws + WS_WDOWN + l * SZ_WDOWN); }
              pg8::StaticOrder S; S.init(NTOK, 2048, G, bid); pg8::EpiBf16<0> E{OBF, 2048, 0, 11, 1 << 20, nullptr, 0}; TB(2); for (int rep_ = 0; rep_ < REP_GEMM; ++rep_) pg8::gemm_phase(lds, g, S, E); TE(2); }
            for (int rs_ = 0; rs_ < REP_SYNC; ++rs_) xcd_barrier(gbar);
            const float* gain = p.in[I_NORMG] + (l * 5 + (hf == 0 ? 1 : 3)) * 2048;
            const bool fin = (l == 3 && hf == 1);
            for (int m = gw; m < NTOK; m += ngw) rowop_row(XH + (size_t)m * 2048, XS + m, OBF + (size_t)m * 2048, gain, fin ? X + (size_t)m * 2048 : nullptr, opq_tid() & 63);
            for (int rs_ = 0; rs_ < REP_SYNC; ++rs_) xcd_barrier(gbar);
        }
    }
    if (TPROBE && bid == 0) { const unsigned long long dt = tacc * 8ull, t0 = __builtin_amdgcn_s_memrealtime(); while (__builtin_amdgcn_s_memrealtime() - t0 < dt) __builtin_amdgcn_s_sleep(8); }
}

extern "C" void kernel_launch(void* const* d_in, const int* in_sizes, int n_in, void* d_out, int out_size, void* d_ws, size_t ws_size, hipStream_t stream) {
    static int grid_blocks = 0;
    if (grid_blocks == 0) {
        if (n_in != 17 || ws_size < WS_END) { fprintf(stderr, "kernel_launch: unexpected n_in %d or ws_size %zu (< %zu)\n", n_in, ws_size, (size_t)WS_END); grid_blocks = -1; return; }
        int dev = 0, cus = 0, per_cu = 0;
        hipGetDevice(&dev);
        hipDeviceGetAttribute(&cus, hipDeviceAttributeMultiprocessorCount, dev);
        hipFuncSetAttribute((const void*)mega_fwd, hipFuncAttributeMaxDynamicSharedMemorySize, LDS_BYTES);
        hipOccupancyMaxActiveBlocksPerMultiprocessor(&per_cu, (const void*)mega_fwd, NTHREADS, LDS_BYTES);
        if (per_cu < 1) per_cu = 1;
        if (per_cu > 1) per_cu = 1;
        grid_blocks = cus * per_cu;
        (void)hipGetLastError();
    }
    if (grid_blocks < 0) return;
    static Params p;
    memset(&p, 0, sizeof(p));
    for (int i = 0; i < 17; ++i) p.in[i] = (const float*)d_in[i];
    p.out = (float*)d_out; p.ws = (unsigned char*)d_ws;
    {
        int n = 0;
        auto add = [&](int in_idx, size_t in_off, int gain_idx, int gain_off, size_t dst_off, int ldw, int col0, int ncols, int K, int nrows, int mode) {
            JobDesc& d = p.jobs[n++]; d.in_idx = in_idx; d.in_off = in_off; d.gain_idx = gain_idx; d.gain_off = gain_off; d.dst_off = dst_off; d.ldw = ldw; d.col0 = col0; d.ncols = ncols; d.K = K; d.nrows = nrows; d.mode = mode; d.pad = 0; };
        for (int l = 0; l < 4; ++l) add(I_WGU, (size_t)l * 2048 * 11264, I_NORMG, (l * 5 + 2) * 2048, WS_WGU + l * SZ_WGU, 11264, 0, 11264, 2048, 11264, 1);
        for (int l = 0; l < 4; ++l) add(I_WDOWN, (size_t)l * 5632 * 2048, -1, 0, WS_WDOWN + l * SZ_WDOWN, 2048, 0, 2048, 5632, 2048, 0);
        for (int l = 0; l < 2; ++l) add(I_AWIN, (size_t)l * 2048 * A_COLS, I_NORMG, (l * 5 + 0) * 2048, WS_WAIN + l * SZ_WAIN, A_COLS, 0, A_COLS, 2048, A_COLS, 0);
        for (int l = 0; l < 2; ++l) add(I_AWOUT, (size_t)l * 1536 * 2048, -1, 0, WS_WAOUT + l * SZ_WAOUT, 2048, 0, 2048, 1536, 2048, 0);
        for (int lb = 0; lb < 2; ++lb) {
            const size_t src = (size_t)lb * 2048 * B_COLS_SRC, dst = lb == 0 ? WS_WBIN : WS_WBIN1; const int go = ((2 + lb) * 5 + 0) * 2048;
            add(I_BWIN, src, I_NORMG, go, dst, B_COLS_SRC, 0, 1536, 2048, 1536, 0);
            add(I_BWIN, src, I_NORMG, go, dst + (size_t)1536 * 2048 * 2, B_COLS_SRC, 1572, 512, 2048, 512, 0);
            add(I_BWIN, src, I_NORMG, go, dst + (size_t)2048 * 2048 * 2, B_COLS_SRC, 1536, 36, 2048, 256, 0);
        }
        for (int lb = 0; lb < 2; ++lb) add(I_BWOUT, (size_t)lb * 2048 * 2048, -1, 0, WS_WBOUT + lb * SZ_WBOUT, 2048, 0, 2048, 2048, 2048, 0);
        for (int l = 0; l < 4; ++l) add(I_MEMWKV, (size_t)l * 2048 * 1024, I_NORMG, (l * 5 + 4) * 2048, WS_WMEM + (size_t)l * 1024 * 2048 * 2, 1024, 0, 1024, 2048, 1024, 0);
        add(I_KVW, 0, I_KVNG, 0, WS_WKV, 3072, 0, 3072, 2048, 3072, 0);
        add(I_WK1, 0, -1, 0, WS_WC1, 512, 0, 512, 4096, 512, 0);
        add(I_WV1, 0, -1, 0, WS_WC1 + SZ_WC1, 512, 0, 512, 4096, 512, 0);
        add(I_WK2, 0, -1, 0, WS_WC2, 128, 0, 128, 512, 256, 0);
        add(I_WV2, 0, -1, 0, WS_WC2 + SZ_WC2, 128, 0, 128, 512, 256, 0);
        p.njobs = n;
    }
    (void)hipMemsetAsync((char*)d_ws + WS_BAR, 0, WS_BAR_BYTES, stream);
    void* args[] = {&p};
    hipError_t e = hipLaunchCooperativeKernel((const void*)mega_fwd, dim3(grid_blocks), dim3(NTHREADS), args, LDS_BYTES, stream);
    if (e != hipSuccess) fprintf(stderr, "cooperative launch failed: %s (grid %d)\n", hipGetErrorString(e), grid_blocks);
}
```

```cpp
#include <hip/hip_runtime.h>
#include <hip/hip_cooperative_groups.h>
#include <cstdio>
#include <cstring>
namespace cg = cooperative_groups;
#define REP_P0 1
#define REP_GEMM 1
#define REP_ATT 1
#define REP_ATTA 1
#define REP_B1 1
#define REP_B2 1
#define REP_SYNC 1
#define PROBE_ATT 0
#define TPROBE 0
#define STAGGER_US 0

#define LAS __attribute__((address_space(3)))
typedef unsigned short bf16_t;
typedef short bf16x8 __attribute__((ext_vector_type(8)));
typedef float f32x4 __attribute__((ext_vector_type(4)));
typedef float f32x2 __attribute__((ext_vector_type(2)));
typedef unsigned u32x4 __attribute__((ext_vector_type(4)));
typedef unsigned u32x2 __attribute__((ext_vector_type(2)));
typedef __bf16 bf16x2_t __attribute__((ext_vector_type(2)));

constexpr int D_MODEL = 2048, NTOK = 8192, SEQ = 2048, NBATCH = 4, DFF = 5632, HD = 128;
constexpr int A_COLS = 9728, B_COLS_SRC = 2084, B_COLS = 2304, NCMP = 127;
constexpr int NWAVES = 8, NTHREADS = 512;
constexpr int LDS_MAIN = 131072; constexpr int LDS_BYTES = LDS_MAIN + 64;

constexpr size_t SZ_WAIN = (size_t)A_COLS * 2048 * 2, SZ_WAOUT = (size_t)2048 * 1536 * 2, SZ_WBIN = (size_t)B_COLS * 2048 * 2, SZ_WBOUT = (size_t)2048 * 2048 * 2;
constexpr size_t SZ_WGU = (size_t)11264 * 2048 * 2, SZ_WDOWN = (size_t)2048 * 5632 * 2, SZ_WC1 = (size_t)512 * 4096 * 2, SZ_WC2 = (size_t)256 * 512 * 2;
constexpr size_t WS_WAIN = 0;
constexpr size_t WS_WAOUT = WS_WAIN + 2 * SZ_WAIN;
constexpr size_t WS_WBIN = WS_WAOUT + 2 * SZ_WAOUT;
constexpr size_t SZ_WKV = (size_t)3072 * 2048 * 2;
constexpr size_t WS_WKV = WS_WBIN + SZ_WBIN;
constexpr size_t WS_WBIN1 = WS_WKV + SZ_WKV;
constexpr size_t WS_WBOUT = WS_WBIN1 + SZ_WBIN;
constexpr size_t WS_WMEM = WS_WBOUT + 2 * SZ_WBOUT;
constexpr size_t WS_WGU = WS_WMEM + (size_t)4096 * 2048 * 2;
constexpr size_t WS_WDOWN = WS_WGU + 4 * SZ_WGU;
constexpr size_t WS_WC1 = WS_WDOWN + 4 * SZ_WDOWN;
constexpr size_t WS_WC2 = WS_WC1 + 2 * SZ_WC1;
constexpr size_t WS_PROJ = WS_WC2 + 2 * SZ_WC2;
constexpr size_t WS_OBUF = WS_PROJ + (size_t)NTOK * A_COLS * 2;
constexpr size_t WS_XH = WS_OBUF + (size_t)NTOK * 2048 * 4;
constexpr size_t WS_CAT = WS_XH + (size_t)NTOK * 2048 * 2;
constexpr size_t WS_KVS = WS_CAT + (size_t)NTOK * 2048 * 2;
constexpr size_t WS_MEMKV = WS_KVS + (size_t)NTOK * 3072 * 2;
constexpr size_t WS_MEMHAT = WS_MEMKV + (size_t)1024 * 4096 * 2;
constexpr size_t WS_HID = WS_MEMHAT + (size_t)1024 * 2048 * 2;
constexpr size_t WS_KCV = WS_HID + (size_t)2 * 2048 * 512 * 2;
constexpr size_t WS_SEL = WS_KCV + (size_t)2 * 2048 * 256 * 2;
constexpr size_t WS_XS = WS_SEL + (size_t)NTOK * 4 * 4;
constexpr size_t WS_UM = WS_XS + (size_t)NTOK * 4;
constexpr size_t WS_BAR = WS_UM + 4096;
constexpr size_t WS_BAR_BYTES = 16384;
constexpr size_t WS_END = WS_BAR + WS_BAR_BYTES;

#define LDS_WAIT() asm volatile("s_waitcnt lgkmcnt(0)" ::: "memory")
__device__ __forceinline__ unsigned f2bf(float f) { unsigned u = __builtin_bit_cast(unsigned, f); return (u + 0x7fffu + ((u >> 16) & 1u)) >> 16; }
__device__ __forceinline__ unsigned pk2(float lo, float hi) { const f32x2 v = {lo, hi}; return __builtin_bit_cast(unsigned, __builtin_convertvector(v, bf16x2_t)); }
__device__ __forceinline__ float bflo(unsigned w) { return __builtin_bit_cast(float, w << 16); }
__device__ __forceinline__ float bfhi(unsigned w) { return __builtin_bit_cast(float, w & 0xffff0000u); }
__device__ __forceinline__ float wave_sum(float v) {
#pragma unroll
    for (int o = 1; o < 64; o <<= 1) v += __shfl_xor(v, o);
    return v;
}
__device__ __forceinline__ float wave_max(float v) {
#pragma unroll
    for (int o = 1; o < 64; o <<= 1) v = fmaxf(v, __shfl_xor(v, o));
    return v;
}


#define XB_TMO      128
#define XB_XCNT(j)  (256  + 64 * (j))
#define XB_XSUB(j)  (1280 + 64 * (j))
#define XB_XGEN(j)  (2304 + 64 * (j))
#define XB_TOP      3328
#define XB_TOPGEN   3392
#define XCD_BAR_WORDS 3456
#define XB_SPIN_CAP (1u << 18)
__device__ __forceinline__ unsigned xb_ld(unsigned* p)              { return __hip_atomic_load(p, __ATOMIC_RELAXED, __HIP_MEMORY_SCOPE_AGENT); }
__device__ __forceinline__ unsigned xb_add(unsigned* p, unsigned v) { return __hip_atomic_fetch_add(p, v, __ATOMIC_RELAXED, __HIP_MEMORY_SCOPE_AGENT); }
__device__ __forceinline__ unsigned xb_xcc_id() { return (unsigned)__builtin_amdgcn_s_getreg((3 << 11) | 20) & 0xFu; }
#define XB_SPIN(cond, bar) do { unsigned _sp = 0; while (cond) { __builtin_amdgcn_s_sleep(1); \
    if ((++_sp & 255u) == 0u) { if (xb_ld(&(bar)[XB_TMO])) break; if (_sp > XB_SPIN_CAP) { atomicAdd(&(bar)[XB_TMO], 1u); break; } } } } while (0)
struct XcdBarrier { unsigned* bar; unsigned x; volatile LAS unsigned* st; };
__device__ __forceinline__ XcdBarrier xcd_barrier_post(unsigned* bar, volatile LAS unsigned* st) {
    XcdBarrier b; b.bar = bar; b.x = xb_xcc_id(); b.st = st;
    if (threadIdx.x == 0) (void)xb_add(&bar[XB_XCNT(b.x)], 1u);
    return b;
}
__device__ __forceinline__ void xcd_barrier_complete(unsigned* bar, unsigned x, unsigned& nloc, unsigned& nx) {
    const unsigned G = gridDim.x * gridDim.y * gridDim.z;
    unsigned sum, cnt, mine, sp = 0u;
    for (;;) {
        sum = 0u; cnt = 0u; mine = 0u;
#pragma unroll
        for (unsigned j = 0; j < 16; ++j) { const unsigned c = xb_ld(&bar[XB_XCNT(j)]); sum += c; cnt += (c > 0u) ? 1u : 0u; mine = (j == x) ? c : mine; }
        if (sum == G) break;
        __builtin_amdgcn_s_sleep(1);
        if ((++sp & 255u) == 0u) { if (xb_ld(&bar[XB_TMO])) break; if (sp > XB_SPIN_CAP) { atomicAdd(&bar[XB_TMO], 1u); break; } }
    }
    nloc = mine > 0u ? mine : 1u; nx = cnt > 0u ? cnt : 1u;
}
__device__ __forceinline__ void xcd_barrier(const XcdBarrier& b) {
    asm volatile("s_waitcnt vmcnt(0)" ::: "memory");
    __syncthreads();
    if (threadIdx.x == 0) {
        unsigned* bar = b.bar;
        __builtin_amdgcn_s_waitcnt(0);
        unsigned nloc = b.st[0], nx = b.st[1];
        if (nloc == 0u) { xcd_barrier_complete(bar, b.x, nloc, nx); b.st[0] = nloc; b.st[1] = nx; }
        const unsigned old = xb_add(&bar[XB_XSUB(b.x)], 1u);
        const unsigned gen = old / nloc;
        if (old + 1u == (gen + 1u) * nloc) {
            __builtin_amdgcn_fence(__ATOMIC_RELEASE, "agent");
            asm volatile("s_waitcnt vmcnt(0)" ::: "memory");
            const unsigned og = xb_add(&bar[XB_TOP], 1u);
            const unsigned tg = og / nx;
            if (og + 1u == (tg + 1u) * nx) xb_add(&bar[XB_TOPGEN], 1u);
            else XB_SPIN(xb_ld(&bar[XB_TOPGEN]) == tg, bar);
            __builtin_amdgcn_fence(__ATOMIC_ACQUIRE, "agent");
            xb_add(&bar[XB_XGEN(b.x)], 1u);
            asm volatile("s_waitcnt vmcnt(0)" ::: "memory");
        } else {
            XB_SPIN(xb_ld(&bar[XB_XGEN(b.x)]) == gen, bar);
            __builtin_amdgcn_fence(__ATOMIC_ACQUIRE, "agent");
            asm volatile("s_waitcnt vmcnt(0)" ::: "memory");
        }
    }
    __syncthreads();
}

namespace pg8 {
constexpr int BM = 256, BK = 64, HALF = 128, HTB = HALF * BK * 2, STAGE_BYTES = 8 * HTB, NXCD = 8, WGM = 8;
__device__ __forceinline__ int lds_byte(int r, int c) { const int st = (r >> 4) * 2 + (c >> 5), rr = r & 15, cc = c & 31, ob = rr * 64 + cc * 2; return st * 1024 + (ob ^ (((ob >> 9) & 1) << 5)); }
__device__ __forceinline__ void stage_rc(int b, int& R, int& C) { const int st = b / 1024, sb = b % 1024, swz = sb ^ (((sb >> 9) & 1) << 5); R = (st >> 1) * 16 + swz / 64; C = (st & 1) * 32 + (swz % 64) / 2; }
__device__ __forceinline__ int perm32(int rho) { const int n = rho >> 4, i = rho & 15; return 8 * (i >> 2) + 4 * n + (i & 3); }
struct Unit { int pm, pn; };
struct Gemm { const bf16_t* A; const bf16_t* Bt; int M, N, K; };
struct StaticOrder {
    int nM, nN, nwg, G, c;
    __device__ void init(int M, int N, int G_, int c_) { nM = M / BM; nN = N / BM; nwg = nM * nN; G = G_; c = c_; }
    __device__ bool next(int i, Unit& u) const {
        const long L = (long)i * G + c; if (L >= nwg) return false;
        int wgid = (int)L; { const int q = nwg / NXCD, r = nwg % NXCD, xcd = wgid % NXCD, off = wgid / NXCD; wgid = (xcd < r ? xcd * (q + 1) : r * (q + 1) + (xcd - r) * q) + off; }
        const int nig = WGM * nN, gid = wgid / nig, fm = gid * WGM, gsz = (nM - fm) < WGM ? (nM - fm) : WGM;
        u.pm = fm + ((wgid % nig) % gsz); u.pn = (wgid % nig) / gsz; return true;
    }
    __device__ __forceinline__ void a_ready(const Unit&) const {}
    __device__ __forceinline__ void done(const Unit&) const {}
};
__device__ __forceinline__ unsigned cvt_pk_bf16(float lo, float hi) { const f32x2 v = {lo, hi}; return __builtin_bit_cast(unsigned, __builtin_convertvector(v, bf16x2_t)); }

struct EpiF32 {
    static constexpr bool PERM = false;
    float* C; int ldc;
    __device__ __forceinline__ void operator()(const f32x4 (&acc)[2][2][4][2], const Unit& u, int wr, int wc, int fr, int fq) const {
        const int row0 = u.pm * BM + wr * 64 + fr, col0 = u.pn * BM + wc * 32 + 4 * fq;
#pragma unroll
        for (int ai = 0; ai < 2; ++ai)
#pragma unroll
            for (int m = 0; m < 4; ++m) { float* rowp = C + (size_t)(row0 + ai * HALF + m * 16) * ldc + col0;
#pragma unroll
                for (int bj = 0; bj < 2; ++bj)
#pragma unroll
                    for (int n = 0; n < 2; ++n) *(f32x4*)(rowp + bj * HALF + n * 16) = acc[ai][bj][m][n]; }
    }
};
__device__ __forceinline__ float gelu_tanh(float x) { const float t = 1.5957691216f * (x + 0.044715f * x * x * x); return x / (1.0f + __expf(-t)); }
template <int ACT  > struct EpiBf16 {
    static constexpr bool PERM = true;
    bf16_t* O; int ldc;
    int hm_heads, seq_shift; int split_pn; bf16_t* O2; int hm2;
    __device__ __forceinline__ void operator()(const f32x4 (&acc)[2][2][4][2], const Unit& u, int wr, int wc, int fr, int fq) const {
        const int row0 = u.pm * BM + wr * 64 + fr, col0 = u.pn * BM + wc * 32 + 8 * fq;
#pragma unroll
        for (int ai = 0; ai < 2; ++ai)
#pragma unroll
            for (int m = 0; m < 4; ++m) { const int row = row0 + ai * HALF + m * 16;
#pragma unroll
                for (int bj = 0; bj < 2; ++bj) { f32x4 v0 = acc[ai][bj][m][0], v1 = acc[ai][bj][m][1];
                    if (ACT == 1) {
#pragma unroll
                        for (int j = 0; j < 4; ++j) { v0[j] = gelu_tanh(v0[j]); v1[j] = gelu_tanh(v1[j]); } }
                    u32x4 w; w.x = cvt_pk_bf16(v0[0], v0[1]); w.y = cvt_pk_bf16(v0[2], v0[3]); w.z = cvt_pk_bf16(v1[0], v1[1]); w.w = cvt_pk_bf16(v1[2], v1[3]);
                    bf16_t* dst;
                    if (hm_heads > 0) { const bool second = u.pn >= split_pn; bf16_t* base = second ? O2 : O; const int nh = second ? hm2 : hm_heads;
                        const int col = col0 + bj * HALF - (second ? split_pn * BM : 0), b = row >> seq_shift, sq = row & ((1 << seq_shift) - 1);
                        dst = base + ((((size_t)(b * nh + (col >> 7))) << seq_shift) + sq) * 128 + (col & 127); }
                    else dst = O + (size_t)row * ldc + col0 + bj * HALF;
                    *(u32x4*)dst = w; } }
    }
};
struct EpiSwiGLU {
    static constexpr bool PERM = true;
    bf16_t* O; int ldc;
    __device__ __forceinline__ void operator()(const f32x4 (&acc)[2][2][4][2], const Unit& u, int wr, int wc, int fr, int fq) const {
        const int row0 = u.pm * BM + wr * 64 + fr, col0 = u.pn * HALF + wc * 32 + 8 * fq;
#pragma unroll
        for (int ai = 0; ai < 2; ++ai)
#pragma unroll
            for (int m = 0; m < 4; ++m) { bf16_t* rowp = O + (size_t)(row0 + ai * HALF + m * 16) * ldc + col0;
                f32x4 v0, v1;
#pragma unroll
                for (int j = 0; j < 4; ++j) { const float g0 = acc[ai][0][m][0][j], g1 = acc[ai][0][m][1][j];
                    v0[j] = g0 / (1.0f + __expf(-g0)) * acc[ai][1][m][0][j]; v1[j] = g1 / (1.0f + __expf(-g1)) * acc[ai][1][m][1][j]; }
                u32x4 w; w.x = cvt_pk_bf16(v0[0], v0[1]); w.y = cvt_pk_bf16(v0[2], v0[3]); w.z = cvt_pk_bf16(v1[0], v1[1]); w.w = cvt_pk_bf16(v1[2], v1[3]);
                *(u32x4*)rowp = w; }
    }
};

template <class Epi, class Sched>
__device__ __forceinline__ void gemm_phase(LAS unsigned char* lds, const Gemm g, const Sched& S, const Epi& E) {
    int tid_ = threadIdx.x; asm volatile("" : "+v"(tid_));
    const int tid = tid_, wid = __builtin_amdgcn_readfirstlane(tid >> 6), lane = tid & 63, wr = wid >> 2, wc = wid & 3, fr = lane & 15, fq = lane >> 4;
    const int K = g.K, nt = K / BK;
    unsigned voffA[2], voffB[2];
#pragma unroll
    for (int i = 0; i < 2; ++i) { int R, C; stage_rc(tid * 16 + i * 8192, R, C); const int Rb = Epi::PERM ? ((R & ~31) + perm32(R & 31)) : R;
        voffA[i] = (unsigned)(R * K + C) * 2u; voffB[i] = (unsigned)(Rb * K + C) * 2u; }
    const size_t kstep = (size_t)(BK * 2);
    const size_t hstep = (size_t)HALF * K * 2;
    const size_t tstep = 2 * hstep;
    const unsigned ldsw = (unsigned)wid * 1024u;
    const int aoff = lds_byte(wr * 64 + fr, fq * 8), boff = lds_byte(wc * 32 + fr, fq * 8);
#define PG8_SA(b, h) (((b) * 2 + (h)) * HTB)
#define PG8_SB(b, h) ((4 + (b) * 2 + (h)) * HTB)
#define PG8_STAGE(bufoff, gbase, voff) do { _Pragma("unroll") for (int _i = 0; _i < 2; ++_i) \
        __builtin_amdgcn_global_load_lds((const unsigned*)((const char*)(gbase) + (voff)[_i]), (LAS unsigned*)(lds + (bufoff) + ldsw + _i * 8192), 16, 0, 0); } while (0)
#define PG8_LDA(dst, b, h) do { _Pragma("unroll") for (int m = 0; m < 4; ++m) _Pragma("unroll") for (int k = 0; k < 2; ++k) dst[m][k] = *(const LAS bf16x8*)(lds + PG8_SA(b, h) + aoff + m * 2048 + k * 1024); } while (0)
#define PG8_LDB(dst, b, h) do { _Pragma("unroll") for (int n = 0; n < 2; ++n) _Pragma("unroll") for (int k = 0; k < 2; ++k) dst[n][k] = *(const LAS bf16x8*)(lds + PG8_SB(b, h) + boff + n * 2048 + k * 1024); } while (0)
#define PG8_MMA(ai, bj, At, Bt) do { __builtin_amdgcn_s_setprio(1); _Pragma("unroll") for (int m = 0; m < 4; ++m) _Pragma("unroll") for (int n = 0; n < 2; ++n) _Pragma("unroll") for (int k = 0; k < 2; ++k) \
        acc[ai][bj][m][n] = __builtin_amdgcn_mfma_f32_16x16x32_bf16(Bt[n][k], At[m][k], acc[ai][bj][m][n], 0, 0, 0); __builtin_amdgcn_s_setprio(0); } while (0)
#define PG8_WAIT_V(n) asm volatile("s_waitcnt vmcnt(" #n ")" ::: "memory")
#define PG8_WAIT_L(n) asm volatile("s_waitcnt lgkmcnt(" #n ")" ::: "memory")
#define PG8_BAR __builtin_amdgcn_s_barrier()
#define PG8_SCHED __builtin_amdgcn_sched_barrier(0)
    Unit cur, nxt; int ui = 0;
    if (!S.next(0, cur)) return;
    f32x4 acc[2][2][4][2];
#pragma unroll
    for (int a = 0; a < 2; ++a)
#pragma unroll
        for (int b = 0; b < 2; ++b)
#pragma unroll
            for (int m = 0; m < 4; ++m)
#pragma unroll
                for (int n = 0; n < 2; ++n) acc[a][b][m][n] = (f32x4){0.f, 0.f, 0.f, 0.f};
    bf16x8 At[4][2], B0[2][2], B1[2][2];
    const char* cA = (const char*)g.A + (size_t)cur.pm * tstep; const char* cB = (const char*)g.Bt + (size_t)cur.pn * tstep;
    S.a_ready(cur);
    PG8_STAGE(PG8_SB(0, 0), cB, voffB); PG8_STAGE(PG8_SA(0, 0), cA, voffA); PG8_STAGE(PG8_SB(0, 1), cB + hstep, voffB); PG8_STAGE(PG8_SA(0, 1), cA + hstep, voffA);
    if (wr == 1) PG8_BAR;
    PG8_WAIT_V(4); PG8_BAR;
    PG8_STAGE(PG8_SB(1, 0), cB + kstep, voffB); PG8_STAGE(PG8_SA(1, 0), cA + kstep, voffA); PG8_STAGE(PG8_SB(1, 1), cB + hstep + kstep, voffB);
    PG8_WAIT_V(6); PG8_BAR;
    for (;;) {
        const bool has_next = S.next(ui + 1, nxt);
        const char* nA = has_next ? (const char*)g.A + (size_t)nxt.pm * tstep : cA; const char* nB = has_next ? (const char*)g.Bt + (size_t)nxt.pn * tstep : cB;
        for (int t = 0; t < nt; t += 2) {
            const bool last = (t == nt - 2);
            const char* a1 = cA + (size_t)(t + 1) * kstep;
            const char* a2 = last ? nA : cA + (size_t)(t + 2) * kstep; const char* b2 = last ? nB : cB + (size_t)(t + 2) * kstep;
            const char* a3 = a2 + kstep; const char* b3 = b2 + kstep;
            if (last && has_next) S.a_ready(nxt);
            PG8_LDB(B0, 0, 0); PG8_SCHED; PG8_LDA(At, 0, 0); PG8_STAGE(PG8_SA(1, 1), a1 + hstep, voffA);
            PG8_WAIT_L(8); PG8_BAR; PG8_WAIT_L(0); PG8_MMA(0, 0, At, B0); PG8_BAR; PG8_SCHED;
            PG8_LDB(B1, 0, 1); PG8_STAGE(PG8_SB(0, 0), b2, voffB);
            PG8_BAR; PG8_WAIT_L(0); PG8_MMA(0, 1, At, B1); PG8_BAR;
            PG8_LDA(At, 0, 1); PG8_STAGE(PG8_SA(0, 0), a2, voffA);
            PG8_BAR; PG8_WAIT_L(0); PG8_MMA(1, 0, At, B0); PG8_BAR; PG8_SCHED;
            PG8_STAGE(PG8_SB(0, 1), b2 + hstep, voffB);
            PG8_WAIT_V(6); PG8_BAR; PG8_MMA(1, 1, At, B1); PG8_BAR;
            PG8_LDB(B0, 1, 0); PG8_SCHED; PG8_LDA(At, 1, 0); PG8_STAGE(PG8_SA(0, 1), a2 + hstep, voffA);
            PG8_WAIT_L(8); PG8_BAR; PG8_WAIT_L(0); PG8_MMA(0, 0, At, B0); PG8_BAR; PG8_SCHED;
            PG8_LDB(B1, 1, 1); PG8_STAGE(PG8_SB(1, 0), b3, voffB);
            PG8_BAR; PG8_WAIT_L(0); PG8_MMA(0, 1, At, B1); PG8_BAR;
            PG8_LDA(At, 1, 1); PG8_STAGE(PG8_SA(1, 0), a3, voffA);
            PG8_BAR; PG8_WAIT_L(0); PG8_MMA(1, 0, At, B0); PG8_BAR; PG8_SCHED;
            PG8_STAGE(PG8_SB(1, 1), b3 + hstep, voffB);
            PG8_WAIT_V(6); PG8_BAR; PG8_MMA(1, 1, At, B1); PG8_BAR;
        }
        E(acc, cur, wr, wc, fr, fq); S.done(cur);
        if (!has_next) break;
#pragma unroll
        for (int a = 0; a < 2; ++a)
#pragma unroll
            for (int b = 0; b < 2; ++b)
#pragma unroll
                for (int m = 0; m < 4; ++m)
#pragma unroll
                    for (int n = 0; n < 2; ++n) acc[a][b][m][n] = (f32x4){0.f, 0.f, 0.f, 0.f};
        cur = nxt; cA = nA; cB = nB; ++ui;
    }
    PG8_WAIT_V(0);
    if (wr == 0) PG8_BAR;
    PG8_BAR;
#undef PG8_SA
#undef PG8_SB
#undef PG8_STAGE
#undef PG8_LDA
#undef PG8_LDB
#undef PG8_MMA
#undef PG8_WAIT_V
#undef PG8_WAIT_L
#undef PG8_BAR
#undef PG8_SCHED
}
}

struct JobDesc { unsigned long long in_off, dst_off; int in_idx, gain_idx, gain_off, ldw, col0, ncols, K, nrows, mode, pad; };
constexpr int MAXJOBS = 32;
struct Params { const float* in[17]; float* out; unsigned char* ws; JobDesc jobs[MAXJOBS]; int njobs, pad; };
enum { I_X = 0, I_MEM, I_NORMG, I_AWIN, I_AWOUT, I_BWIN, I_BWOUT, I_MEMWKV, I_WGU, I_WDOWN, I_KVNG, I_KVW, I_PE, I_WK1, I_WK2, I_WV1, I_WV2 };

struct ConvJob { const float* W; const float* gain; bf16_t* dst; int ldw, col0, ncols, K, nrows, mode; };
__device__ __forceinline__ bool conv_get(const Params& p, int j, ConvJob& J) {
    if (j >= p.njobs) return false;
    const JobDesc& d = p.jobs[j];
    J.W = p.in[d.in_idx] + d.in_off; J.gain = d.gain_idx >= 0 ? p.in[d.gain_idx] + d.gain_off : nullptr; J.dst = (bf16_t*)(p.ws + d.dst_off);
    J.ldw = d.ldw; J.col0 = d.col0; J.ncols = d.ncols; J.K = d.K; J.nrows = d.nrows; J.mode = d.mode;
    return true;
}
__device__ __forceinline__ void conv_load(const ConvJob& J, int it, int nblk, int lane, f32x4 (&v)[16]) {
    const int kb = it / nblk, nb = it - kb * nblk, k0 = 64 * kb, n = 64 * nb + 4 * (lane & 15), kr = lane >> 4;
    const bool ok = n < J.ncols;
    const int sc = J.mode == 1 ? (((n >> 7) & 1) * 5632 + (n >> 8) * 128 + (n & 127)) : (J.col0 + n);
    const float* src = J.W + (size_t)(k0 + kr) * J.ldw + sc;
#pragma unroll
    for (int i = 0; i < 16; ++i) v[i] = ok ? __builtin_nontemporal_load((const f32x4*)(src + (size_t)(4 * i) * J.ldw)) : (f32x4){0.f, 0.f, 0.f, 0.f};
}
__device__ __forceinline__ void conv_emit(const ConvJob& J, LAS float* scr, int it, int nblk, int lane, const f32x4 (&cur)[16]) {
    const int c4 = lane & 15, kr = lane >> 4, nb8 = lane >> 3, c = lane & 7;
    const int kb = it / nblk, nb = it - kb * nblk, k0 = 64 * kb, n0 = 64 * nb;
#pragma unroll
    for (int i = 0; i < 16; ++i) *(LAS f32x4*)(scr + (kr + 4 * i) * 64 + ((c4 ^ (i >> 1)) << 2)) = cur[i];
    LDS_WAIT();
    f32x4 g0 = {1.f, 1.f, 1.f, 1.f}, g1 = {1.f, 1.f, 1.f, 1.f};
    if (J.gain) { g0 = *(const f32x4*)(J.gain + k0 + 8 * c); g1 = *(const f32x4*)(J.gain + k0 + 8 * c + 4); }
#pragma unroll
    for (int j = 0; j < 8; ++j) { const int n = nb8 + 8 * j; const LAS float* t = scr + (8 * c) * 64 + ((((n >> 2) ^ c) << 2) | (n & 3));
        u32x4 o; o.x = pk2(t[0 * 64] * g0[0], t[1 * 64] * g0[1]); o.y = pk2(t[2 * 64] * g0[2], t[3 * 64] * g0[3]); o.z = pk2(t[4 * 64] * g1[0], t[5 * 64] * g1[1]); o.w = pk2(t[6 * 64] * g1[2], t[7 * 64] * g1[3]);
        *(u32x4*)(J.dst + (size_t)(n0 + n) * J.K + k0 + 8 * c) = o; }
    LDS_WAIT();
}
__device__ __forceinline__ void conv_run(const ConvJob& J, LAS float* scr, int gw, int ngw, int lane) {
    const int nblk = J.nrows / 64, kblk = J.K / 64, items = nblk * kblk;
    f32x4 bufA[16], bufB[16];
    int it = gw;
    if (it < items) conv_load(J, it, nblk, lane, bufA);
    while (it < items) {
        if (it + ngw < items) conv_load(J, it + ngw, nblk, lane, bufB);
        conv_emit(J, scr, it, nblk, lane, bufA);
        it += ngw; if (it >= items) break;
        if (it + ngw < items) conv_load(J, it + ngw, nblk, lane, bufA);
        conv_emit(J, scr, it, nblk, lane, bufB);
        it += ngw;
    }
}

__device__ __forceinline__ void rms_row(const float* xrow, bf16_t* orow, float* scale_out, int lane) {
    const f32x4* xr = (const f32x4*)xrow + lane;
    f32x4 v[8]; float s = 0.f;
#pragma unroll
    for (int j = 0; j < 8; ++j) { v[j] = xr[64 * j]; s += (v[j].x * v[j].x + v[j].y * v[j].y) + (v[j].z * v[j].z + v[j].w * v[j].w); }
    const float ms = wave_sum(s) * (1.f / 2048.f) + 1e-6f, rs = rsqrtf(ms);
    u32x2* o8 = (u32x2*)orow + lane;
#pragma unroll
    for (int j = 0; j < 8; ++j) { u32x2 w; w.x = pk2(v[j].x * rs, v[j].y * rs); w.y = pk2(v[j].z * rs, v[j].w * rs); o8[64 * j] = w; }
    if (scale_out && lane == 0) *scale_out = sqrtf(ms);
}
__device__ __forceinline__ void rowop_row(bf16_t* hrow, float* scale, const bf16_t* orow, const float* gain, float* outrow, int lane) {
    const u32x2* o2 = (const u32x2*)orow + lane; u32x2* h2 = (u32x2*)hrow + lane; const f32x4* g4 = (const f32x4*)gain + lane;
    const float sc = *scale;
    f32x4 o[8]; float s = 0.f;
#pragma unroll
    for (int j = 0; j < 8; ++j) { const u32x2 w = o2[64 * j]; o[j] = (f32x4){bflo(w.x), bfhi(w.x), bflo(w.y), bfhi(w.y)}; s += (o[j].x * o[j].x + o[j].y * o[j].y) + (o[j].z * o[j].z + o[j].w * o[j].w); }
    const float rs = rsqrtf(wave_sum(s) * (1.f / 2048.f) + 1e-6f);
    float s2 = 0.f;
#pragma unroll
    for (int j = 0; j < 8; ++j) { const f32x4 g = g4[64 * j]; const u32x2 w = h2[64 * j]; f32x4 x = (f32x4){bflo(w.x), bfhi(w.x), bflo(w.y), bfhi(w.y)} * sc; x = x + o[j] * rs * g; o[j] = x; s2 += (x.x * x.x + x.y * x.y) + (x.z * x.z + x.w * x.w); }
    if (outrow) { f32x4* x4 = (f32x4*)outrow + lane;
#pragma unroll
        for (int j = 0; j < 8; ++j) x4[64 * j] = o[j];
        return; }
    const float ms2 = wave_sum(s2) * (1.f / 2048.f) + 1e-6f, rs2 = rsqrtf(ms2);
#pragma unroll
    for (int j = 0; j < 8; ++j) { u32x2 w; w.x = pk2(o[j].x * rs2, o[j].y * rs2); w.y = pk2(o[j].z * rs2, o[j].w * rs2); h2[64 * j] = w; }
    if (lane == 0) *scale = sqrtf(ms2);
}

typedef short s16x4 __attribute__((ext_vector_type(4)));
constexpr int AT_ROWB = 272, AT_TILEB = 64 * AT_ROWB, AT_STAGEB = 2 * AT_TILEB;
constexpr int AT_AUX = 2 * AT_STAGEB;
constexpr float SCALE2 = 0.12751743f;
constexpr float LOG2E = 1.4426950408889634f, LN2 = 0.6931471805599453f;
struct AttnArgs {
    const bf16_t* q; size_t qstride;
    const bf16_t* k; const bf16_t* v; size_t kvstride;
    unsigned tilemask;
    int nkeys, qpos0, kmul, maxdist;
    float slope2;
    int nrows;
};
__device__ __forceinline__ void at_gload(const AttnArgs& A, int kt, int tid, u32x4 (&kr)[2], u32x4 (&vr)[2]) {
#pragma unroll
    for (int i = 0; i < 2; ++i) { const int id = tid + 512 * i, row = id >> 4, c16 = id & 15; const size_t off = (size_t)(64 * kt + row) * A.kvstride + 8 * c16;
        kr[i] = *(const u32x4*)(A.k + off); vr[i] = *(const u32x4*)(A.v + off); }
}
__device__ __forceinline__ void at_lstore(LAS unsigned char* st, int tid, const u32x4 (&kr)[2], const u32x4 (&vr)[2]) {
#pragma unroll
    for (int i = 0; i < 2; ++i) { const int id = tid + 512 * i, row = id >> 4, c16 = id & 15;
        *(LAS u32x4*)(st + row * AT_ROWB + c16 * 16) = kr[i];
        const int prow = (row & ~12) | (((row >> 2) & 1) << 3) | (((row >> 3) & 1) << 2), swz = ((prow & 3) << 2) | ((prow >> 2) & 3);
        *(LAS u32x4*)(st + AT_TILEB + prow * 256 + ((c16 ^ swz) << 4)) = vr[i]; }
}
__device__ __forceinline__ bf16x8 pack8(const f32x4& a, const f32x4& b) {
    u32x4 w; w.x = pg8::cvt_pk_bf16(a[0], a[1]); w.y = pg8::cvt_pk_bf16(a[2], a[3]); w.z = pg8::cvt_pk_bf16(b[0], b[1]); w.w = pg8::cvt_pk_bf16(b[2], b[3]);
    return __builtin_bit_cast(bf16x8, w);
}
__device__ __forceinline__ bf16x8 tr_pair(const LAS unsigned char* p0, const LAS unsigned char* p1) {
    const s16x4 lo = __builtin_amdgcn_ds_read_tr16_b64_v4i16((LAS s16x4*)p0), hi = __builtin_amdgcn_ds_read_tr16_b64_v4i16((LAS s16x4*)p1);
    return __builtin_shufflevector(lo, hi, 0, 1, 2, 3, 4, 5, 6, 7);
}
struct AttnPre { bf16x8 qf[2][4]; u32x4 kA[2], vA[2], kB[2], vB[2]; };
__device__ __forceinline__ void attn_issue_q(const AttnArgs& A, int tid, AttnPre& P) {
    const int lane = tid & 63, wave = tid >> 6, fr = lane & 15, fq = lane >> 4;
#pragma unroll
    for (int rb = 0; rb < 2; ++rb) { const bf16_t* qp = A.q + (size_t)(wave * 32 + rb * 16 + fr) * A.qstride + 8 * fq;
#pragma unroll
        for (int dc = 0; dc < 4; ++dc) P.qf[rb][dc] = *(const bf16x8*)(qp + 32 * dc); }
}
__device__ __forceinline__ void attn_issue_kv(const AttnArgs& A, int tid, AttnPre& P) {
    unsigned tm = A.tilemask;
    if (tm == 0u) return;
    const int k0 = 31 - __builtin_clz(tm); tm &= ~(1u << k0);
    at_gload(A, k0, tid, P.kA, P.vA);
    if (tm) { const int k1 = 31 - __builtin_clz(tm); at_gload(A, k1, tid, P.kB, P.vB); }
}
template <bool USE_SEL>
__device__ __forceinline__ void attn_run(LAS unsigned char* lds, const AttnArgs& A, const unsigned (&selmask)[2], int tid, AttnPre& P, f32x4 (&o)[2][8], float (&m)[2], float (&l)[2]) {
    const int lane = tid & 63, wave = __builtin_amdgcn_readfirstlane(tid >> 6), fr = lane & 15, fq = lane >> 4;
    bf16x8 (&qf)[2][4] = P.qf;
#pragma unroll
    for (int rb = 0; rb < 2; ++rb) { m[rb] = -INFINITY; l[rb] = 0.f;
#pragma unroll
        for (int db = 0; db < 8; ++db) o[rb][db] = (f32x4){0.f, 0.f, 0.f, 0.f}; }
    unsigned tm = A.tilemask;
    if (tm == 0u) return;
    const int wr0 = 32 * wave, wq0 = A.qpos0 + wr0;
    const int qp0 = A.qpos0 + wr0 + fr;
    const bool nomask = A.kmul == 0;
    auto tile = [&](const int kt, const LAS unsigned char* st) {
        if (wr0 >= A.nrows) return;
        const int dlo = wq0 - 64 * kt - 63, dhi = wq0 + 31 - 64 * kt;
        bool tsel[2]; tsel[0] = USE_SEL ? (((selmask[0] >> kt) & 1u) != 0u) : true; tsel[1] = USE_SEL ? (((selmask[1] >> kt) & 1u) != 0u) : true;
        if (!nomask && (dhi < 0 || dlo > A.maxdist || (USE_SEL && !__any(tsel[0] || tsel[1])))) return;
        const bool interior = nomask || (dlo >= 0 && dhi <= A.maxdist && (!USE_SEL || __all(tsel[0] && tsel[1])));
        f32x4 s[2][4];
        { const LAS unsigned char* kbase = st + fr * AT_ROWB + fq * 16;
#pragma unroll
          for (int kb = 0; kb < 4; ++kb) { s[0][kb] = (f32x4){0.f, 0.f, 0.f, 0.f}; s[1][kb] = (f32x4){0.f, 0.f, 0.f, 0.f};
#pragma unroll
              for (int dc = 0; dc < 4; ++dc) { const bf16x8 kf = *(const LAS bf16x8*)(kbase + kb * 16 * AT_ROWB + dc * 64);
                  s[0][kb] = __builtin_amdgcn_mfma_f32_16x16x32_bf16(kf, qf[0][dc], s[0][kb], 0, 0, 0); s[1][kb] = __builtin_amdgcn_mfma_f32_16x16x32_bf16(kf, qf[1][dc], s[1][kb], 0, 0, 0); } } }
        float muse[2];
        bool moved = false;
#pragma unroll
        for (int rb = 0; rb < 2; ++rb) {
            const int D0r = qp0 + 16 * rb - 64 * kt - 4 * fq, D0 = (USE_SEL && !tsel[rb]) ? -(1 << 30) : D0r;
            const float B0 = nomask ? 0.f : -A.slope2 * (float)D0r;
            float tmax = -INFINITY;
            if (interior) {
#pragma unroll
                for (int kb = 0; kb < 4; ++kb)
#pragma unroll
                    for (int e = 0; e < 4; ++e) { const float x = fmaf(s[rb][kb][e], SCALE2, fmaf(A.slope2, (float)(16 * kb + e), B0)); s[rb][kb][e] = x; tmax = fmaxf(tmax, x); }
            } else {
#pragma unroll
                for (int kb = 0; kb < 4; ++kb)
#pragma unroll
                    for (int e = 0; e < 4; ++e) { const bool valid = (unsigned)(D0 - (16 * kb + e)) <= (unsigned)A.maxdist;
                        const float x = valid ? fmaf(s[rb][kb][e], SCALE2, fmaf(A.slope2, (float)(16 * kb + e), B0)) : -INFINITY; s[rb][kb][e] = x; tmax = fmaxf(tmax, x); }
            }
            tmax = fmaxf(tmax, __shfl_xor(tmax, 16)); tmax = fmaxf(tmax, __shfl_xor(tmax, 32));
            const float mnew = fmaxf(m[rb], tmax); muse[rb] = (mnew == -INFINITY) ? 0.f : mnew;
            moved = moved || (mnew != m[rb]);
            if (!__all(mnew == m[rb])) {
                const float alpha = __builtin_amdgcn_exp2f(m[rb] - muse[rb]);
                l[rb] *= alpha;
#pragma unroll
                for (int db = 0; db < 8; ++db) o[rb][db] *= alpha;
            }
            m[rb] = mnew;
#pragma unroll
            for (int kb = 0; kb < 4; ++kb)
#pragma unroll
                for (int e = 0; e < 4; ++e) { const float pv = __builtin_amdgcn_exp2f(s[rb][kb][e] - muse[rb]); s[rb][kb][e] = pv; l[rb] += pv; }
        }
        (void)moved;
        const int vq = fr >> 2, vp = fr & 3, vS = (vq << 2) | (2 * (fq & 1) + (fq >> 1)), vx0 = ((vp >> 1) ^ vS) & 1, vS14 = vS & 14;
        const LAS unsigned char* vbase = st + AT_TILEB + 256 * (8 * (fq & 1) + 4 * (fq >> 1) + vq) + 8 * (vp & 1);
#pragma unroll
        for (int c = 0; c < 2; ++c) { const bf16x8 pf0 = pack8(s[0][2 * c], s[0][2 * c + 1]), pf1 = pack8(s[1][2 * c], s[1][2 * c + 1]);
#pragma unroll
            for (int db = 0; db < 8; ++db) { const int co = (((2 * db) ^ vS14) | vx0) << 4; const bf16x8 vf = tr_pair(vbase + c * 32 * 256 + co, vbase + (c * 32 + 16) * 256 + co);
                o[0][db] = __builtin_amdgcn_mfma_f32_16x16x32_bf16(vf, pf0, o[0][db], 0, 0, 0); o[1][db] = __builtin_amdgcn_mfma_f32_16x16x32_bf16(vf, pf1, o[1][db], 0, 0, 0); } }
    };
    u32x4 (&krA)[2] = P.kA; u32x4 (&vrA)[2] = P.vA; u32x4 (&krB)[2] = P.kB; u32x4 (&vrB)[2] = P.vB;
    int k0 = 31 - __builtin_clz(tm); tm &= ~(1u << k0);
    int k1 = -1; if (tm) { k1 = 31 - __builtin_clz(tm); tm &= ~(1u << k1); }
    at_lstore(lds, tid, krA, vrA); __syncthreads();
    for (;;) {
        int k2 = -1; if (tm) { k2 = 31 - __builtin_clz(tm); tm &= ~(1u << k2); }
        if (k2 >= 0) at_gload(A, k2, tid, krA, vrA);
        tile(k0, lds);
        if (k1 >= 0) at_lstore(lds + AT_STAGEB, tid, krB, vrB);
        __syncthreads();
        if (k1 < 0) break;
        int k3 = -1; if (tm) { k3 = 31 - __builtin_clz(tm); tm &= ~(1u << k3); }
        if (k3 >= 0) at_gload(A, k3, tid, krB, vrB);
        tile(k1, lds + AT_STAGEB);
        if (k2 >= 0) at_lstore(lds, tid, krA, vrA);
        __syncthreads();
        if (k2 < 0) break;
        k0 = k2; k1 = k3;
    }
#pragma unroll
    for (int rb = 0; rb < 2; ++rb) { l[rb] += __shfl_xor(l[rb], 16); l[rb] += __shfl_xor(l[rb], 32); }
}
template <bool USE_SEL>
__device__ __forceinline__ void attn_core(LAS unsigned char* lds, const AttnArgs& A, const unsigned (&selmask)[2], int tid, f32x4 (&o)[2][8], float (&m)[2], float (&l)[2]) {
    AttnPre P; attn_issue_q(A, tid, P); attn_issue_kv(A, tid, P); attn_run<USE_SEL>(lds, A, selmask, tid, P, o, m, l);
}
__device__ __forceinline__ void at_store_o(bf16_t* orow, const f32x4 (&o)[8], float inv, int fq) {
#pragma unroll
    for (int db = 0; db < 8; ++db) { u32x2 w; w.x = pg8::cvt_pk_bf16(o[db][0] * inv, o[db][1] * inv); w.y = pg8::cvt_pk_bf16(o[db][2] * inv, o[db][3] * inv); *(u32x2*)(orow + 16 * db + 4 * fq) = w; }
}
__device__ __forceinline__ void mem_args(AttnArgs& A, const bf16_t* proj, int nh, int mq0, const bf16_t* memkv, int l, int b, int h, int qb) {
    A.q = proj + ((size_t)(b * nh + mq0 + h) * SEQ + qb * 256) * HD; A.qstride = HD; A.k = memkv + (size_t)(b * 32 + l * 8 + h) * 256 * HD; A.v = A.k + (size_t)4 * 256 * HD; A.kvstride = HD;
    A.tilemask = 0xFu; A.nkeys = 256; A.qpos0 = 1 << 20; A.kmul = 0; A.maxdist = 0x7fffffff; A.slope2 = 0.f; A.nrows = 256;
}
__device__ __forceinline__ void mem_attn_wg(LAS unsigned char* lds, const bf16_t* proj, int nh, int mq0, const bf16_t* memkv, int l, bf16_t* cat, int ldc, int memoff, int b, int h, int qb, int tid_) {
    int tid = tid_; asm volatile("" : "+v"(tid));
    AttnArgs A; mem_args(A, proj, nh, mq0, memkv, l, b, h, qb);
    const unsigned nosel[2] = {0u, 0u};
    f32x4 o[2][8]; float m[2], lsum[2]; attn_core<false>(lds, A, nosel, tid, o, m, lsum);
    const int lane = tid & 63, t0 = b * SEQ + qb * 256;
#pragma unroll
    for (int rb = 0; rb < 2; ++rb) { const int row = (tid >> 6) * 32 + rb * 16 + (lane & 15);
        at_store_o(cat + (size_t)(t0 + row) * ldc + memoff + h * HD, o[rb], 1.0f / fmaxf(lsum[rb], 1e-30f), lane >> 4); }
}
__device__ __forceinline__ void dil_attn_wg(LAS unsigned char* lds, const bf16_t* proj, bf16_t* og, float* lse, int b, int hh, int x, int tid_) {
    int tid = tid_; asm volatile("" : "+v"(tid));
    const int gi = hh >> 3, j = hh & 7, d = gi == 0 ? 1 : (gi == 1 ? 4 : 16), L = SEQ / d, nqb = gi == 0 ? 8 : (gi == 1 ? 2 : 1), r = x / nqb, qb = x % nqb, c0 = qb * 256;
    const float slope = exp2f(-8.0f * (float)(hh + 1) / 24.0f);
    AttnArgs A; A.q = proj + ((size_t)(b * 76 + hh) * SEQ + c0 * d + r) * HD; A.qstride = (size_t)d * HD;
    A.k = proj + ((size_t)(b * 76 + 24 + hh) * SEQ + r) * HD; A.v = A.k + (size_t)24 * SEQ * HD; A.kvstride = (size_t)d * HD;
    { const int ktc = c0 >> 6, k0 = ktc - 2 < 0 ? 0 : ktc - 2, kend = (ktc + 4 < L / 64 ? ktc + 4 : L / 64) - 1; A.tilemask = (0xffffffffu >> (31 - kend)) & (0xffffffffu << k0); }
    A.nkeys = L; A.qpos0 = c0; A.kmul = 1; A.maxdist = 128; A.slope2 = slope * (float)d * LOG2E; A.nrows = L - c0 < 256 ? L - c0 : 256;
    const unsigned nosel[2] = {0u, 0u};
    f32x4 o[2][8]; float m[2], lsum[2]; attn_core<false>(lds, A, nosel, tid, o, m, lsum);
    const int lane = tid & 63, fr = lane & 15, fq = lane >> 4;
#pragma unroll
    for (int rb = 0; rb < 2; ++rb) { const int row = (tid >> 6) * 32 + rb * 16 + fr;
        if (row < A.nrows) { const size_t t = (size_t)b * SEQ + (size_t)(c0 + row) * d + r;
            at_store_o(og + ((size_t)gi * NTOK + t) * 1024 + j * HD, o[rb], 1.0f / fmaxf(lsum[rb], 1e-30f), fq);
            if (fq == 0) lse[((size_t)gi * NTOK + t) * 8 + j] = m[rb] * LN2 + __logf(fmaxf(lsum[rb], 1e-30f)); } }
}
__device__ __forceinline__ void cmp_sel_wg(LAS unsigned char* lds, const bf16_t* proj, const bf16_t* kc, const bf16_t* vc, bf16_t* ocmp, unsigned* sel, unsigned* umw, int b, int g, int qb, int tid_) {
    int tid = tid_; asm volatile("" : "+v"(tid));
    const int lane = tid & 63, wave = tid >> 6, fr = lane & 15, fq = lane >> 4, row = wave * 16 + fr, t0 = b * SEQ + qb * 128, spos_ = qb * 128 + row, cur = spos_ >> 6;
    bf16x8 qf3[3][4];
#pragma unroll
    for (int r = 0; r < 3; ++r) { const bf16_t* qp = proj + ((size_t)(b * 18 + 3 * g + r) * SEQ + qb * 128 + row) * HD + 8 * fq;
#pragma unroll
        for (int dc = 0; dc < 4; ++dc) qf3[r][dc] = *(const bf16x8*)(qp + 32 * dc); }
#pragma unroll
    for (int i = 0; i < 4; ++i) { const int id = tid + 512 * i, n = id >> 4, c16 = id & 15; const size_t off = ((size_t)(b * NCMP + n) * 4 + g) * 256 + 8 * c16;
        *(LAS u32x4*)(lds + n * AT_ROWB + c16 * 16) = *(const u32x4*)(kc + off); *(LAS u32x4*)(lds + 2 * AT_TILEB + n * AT_ROWB + c16 * 16) = *(const u32x4*)(vc + off); }
    __syncthreads();
    float imp[8];
#pragma unroll
    for (int kb = 0; kb < 8; ++kb) imp[kb] = 0.f;
#pragma unroll
    for (int r = 0; r < 3; ++r) {
        const int h = 3 * g + r; const float slope2 = exp2f(-8.0f * (float)(h + 1) / 12.0f) * LOG2E;
        int z = 0; asm volatile("" : "+v"(z));
        const int spos = spos_ + z;
        const bf16x8 (&qf)[4] = qf3[r];
        f32x4 s[8];
        { const LAS unsigned char* kbase = lds + fr * AT_ROWB + fq * 16 + z;
#pragma unroll
          for (int kb = 0; kb < 8; ++kb) { s[kb] = (f32x4){0.f, 0.f, 0.f, 0.f};
#pragma unroll
              for (int dc = 0; dc < 4; ++dc) { const bf16x8 kf = *(const LAS bf16x8*)(kbase + kb * 16 * AT_ROWB + dc * 64); s[kb] = __builtin_amdgcn_mfma_f32_16x16x32_bf16(kf, qf[dc], s[kb], 0, 0, 0); } } }
        float tmax = -INFINITY;
#pragma unroll
        for (int kb = 0; kb < 8; ++kb)
#pragma unroll
            for (int e = 0; e < 4; ++e) { const int n = 16 * kb + 4 * fq + e, dist = spos - (16 * n + 31); const bool valid = (dist >= 0) && (n < NCMP);
                const float x = valid ? (s[kb][e] * SCALE2 - slope2 * (float)dist) : -INFINITY; s[kb][e] = x; tmax = fmaxf(tmax, x); }
        tmax = fmaxf(tmax, __shfl_xor(tmax, 16)); tmax = fmaxf(tmax, __shfl_xor(tmax, 32));
        const float muse = (tmax == -INFINITY) ? 0.f : tmax;
        float lsum = 0.f;
#pragma unroll
        for (int kb = 0; kb < 8; ++kb)
#pragma unroll
            for (int e = 0; e < 4; ++e) { const float pv = __builtin_amdgcn_exp2f(s[kb][e] - muse); s[kb][e] = pv; lsum += pv; }
        lsum += __shfl_xor(lsum, 16); lsum += __shfl_xor(lsum, 32);
        const float inv = 1.0f / fmaxf(lsum, 1e-30f);
#pragma unroll
        for (int kb = 0; kb < 8; ++kb) s[kb] *= inv;
#pragma unroll
        for (int kb = 0; kb < 8; ++kb) { const float t1 = __shfl(s[kb][3], (lane - 16) & 63); const float t0v = kb > 0 ? __shfl(s[kb > 0 ? kb - 1 : 0][3], (lane - 16) & 63) : 0.f;
            imp[kb] += s[kb][0] + s[kb][1] + s[kb][2] + 0.5f * s[kb][3] + 0.5f * (fq == 0 ? t0v : t1); }
        f32x4 o[8];
#pragma unroll
        for (int db = 0; db < 8; ++db) o[db] = (f32x4){0.f, 0.f, 0.f, 0.f};
        { const LAS unsigned char* vbase = lds + 2 * AT_TILEB + (4 * fq + (fr >> 2)) * AT_ROWB + 8 * (fr & 3);
#pragma unroll
          for (int c = 0; c < 4; ++c) { const bf16x8 pf = pack8(s[2 * c], s[2 * c + 1]);
#pragma unroll
              for (int db = 0; db < 8; ++db) { const bf16x8 vf = tr_pair(vbase + c * 32 * AT_ROWB + db * 32, vbase + c * 32 * AT_ROWB + 16 * AT_ROWB + db * 32);
                  o[db] = __builtin_amdgcn_mfma_f32_16x16x32_bf16(vf, pf, o[db], 0, 0, 0); } } }
        at_store_o(ocmp + (size_t)(t0 + row) * 1536 + h * HD, o, 1.0f, fq);
    }
    LAS float* rk = (LAS float*)(lds + AT_AUX + wave * 2048) + fr * 32;
    float mine[8];
#pragma unroll
    for (int kb = 0; kb < 8; ++kb) { const int j = 4 * kb + fq; const bool forced = (j == 0) || (j == cur) || (j == cur - 1);
        mine[kb] = forced ? 1e4f : (j > cur ? -1e4f : imp[kb]); rk[j] = mine[kb]; }
    LDS_WAIT();
    int rank[8];
#pragma unroll
    for (int kb = 0; kb < 8; ++kb) rank[kb] = 0;
#pragma unroll
    for (int j4 = 0; j4 < 8; ++j4) { const f32x4 v = *(const LAS f32x4*)(rk + 4 * j4);
#pragma unroll
        for (int e = 0; e < 4; ++e) { const int jj = 4 * j4 + e;
#pragma unroll
            for (int kb = 0; kb < 8; ++kb) { const int j = 4 * kb + fq; rank[kb] += (v[e] > mine[kb] || (v[e] == mine[kb] && jj < j)) ? 1 : 0; } } }
    unsigned bits = 0u;
#pragma unroll
    for (int kb = 0; kb < 8; ++kb) { const int j = 4 * kb + fq; if (rank[kb] < 16 && j <= cur) bits |= 1u << j; }
    bits |= __shfl_xor(bits, 16); bits |= __shfl_xor(bits, 32);
    if (fq == 0) sel[(size_t)(t0 + row) * 4 + g] = bits;
    { unsigned wb = bits;
#pragma unroll
      for (int o_ = 1; o_ < 16; o_ <<= 1) wb |= __shfl_xor(wb, o_);
      LAS unsigned* wgw = (LAS unsigned*)(lds + AT_AUX + 8 * 2048);
      if (lane == 0) wgw[wave] = wb;
      __syncthreads();
      if (tid == 0) umw[(b * 4 + g) * 16 + qb] = wgw[0] | wgw[1] | wgw[2] | wgw[3] | wgw[4] | wgw[5] | wgw[6] | wgw[7]; }
}
__device__ __forceinline__ void nsa_attn_wg(LAS unsigned char* lds, const bf16_t* proj, const bf16_t* kvs, const unsigned* sel, const unsigned* umw, const bf16_t* ocmp, bf16_t* cat, int b, int h, int qb, int tid_) {
    int tid = tid_; asm volatile("" : "+v"(tid));
    const int lane = tid & 63, wave = tid >> 6, fr = lane & 15, fq = lane >> 4, g = h / 3, t0 = b * SEQ + qb * 256;
    const float slope2 = exp2f(-8.0f * (float)(h + 1) / 12.0f) * LOG2E;
    const unsigned umv = __hip_atomic_load(umw + (b * 4 + g) * 16 + 2 * qb, __ATOMIC_RELAXED, __HIP_MEMORY_SCOPE_AGENT) | __hip_atomic_load(umw + (b * 4 + g) * 16 + 2 * qb + 1, __ATOMIC_RELAXED, __HIP_MEMORY_SCOPE_AGENT);
    unsigned selmask[2];
#pragma unroll
    for (int rb = 0; rb < 2; ++rb) selmask[rb] = sel[(size_t)(t0 + wave * 32 + rb * 16 + fr) * 4 + g];
    const bf16_t* kvb = kvs + (size_t)(b * 24 + g) * SEQ * HD;
    constexpr size_t KIND = (size_t)4 * SEQ * HD;
    AttnArgs Aw; Aw.q = proj + ((size_t)(b * 18 + h) * SEQ + qb * 256) * HD; Aw.qstride = HD; Aw.kvstride = HD; Aw.nkeys = SEQ; Aw.qpos0 = qb * 256; Aw.kmul = 1; Aw.slope2 = slope2; Aw.nrows = 256;
    Aw.k = kvb + 4 * KIND; Aw.v = kvb + 5 * KIND; Aw.maxdist = 511;
    { const int k0 = 4 * qb - 8 < 0 ? 0 : 4 * qb - 8, k1 = 4 * qb + 3; Aw.tilemask = (0xffffffffu >> (31 - k1)) & (0xffffffffu << k0); }
    AttnPre Pw; attn_issue_q(Aw, tid, Pw); attn_issue_kv(Aw, tid, Pw);
    const unsigned um = (unsigned)__builtin_amdgcn_readfirstlane((int)umv);
    AttnArgs As = Aw; As.k = kvb + 2 * KIND; As.v = kvb + 3 * KIND; As.maxdist = 0x7fffffff; As.tilemask = um & (0xffffffffu >> (31 - (4 * qb + 3)));
    f32x4 o[2][8]; float m[2], lsum[2];
    { const unsigned nosel[2] = {0u, 0u}; attn_run<false>(lds, Aw, nosel, tid, Pw, o, m, lsum); }
    AttnPre Ps; attn_issue_kv(As, tid, Ps);
#pragma unroll
    for (int rb = 0; rb < 2; ++rb) at_store_o(cat + (size_t)(t0 + wave * 32 + rb * 16 + fr) * 2048 + h * HD, o[rb], 1.0f / fmaxf(lsum[rb], 1e-30f), fq);
#pragma unroll
    for (int rb = 0; rb < 2; ++rb)
#pragma unroll
        for (int dc = 0; dc < 4; ++dc) Ps.qf[rb][dc] = Pw.qf[rb][dc];
    attn_run<true>(lds, As, selmask, tid, Ps, o, m, lsum);
#pragma unroll
    for (int rb = 0; rb < 2; ++rb) { const int row = wave * 32 + rb * 16 + fr;
        const bf16_t* gp = proj + ((size_t)(b * 18 + 16) * SEQ + qb * 256 + row) * HD + h * 3;
        const float g0 = 1.0f / (1.0f + __expf(-bflo((unsigned)gp[0]))), g1 = 1.0f / (fmaxf(lsum[rb], 1e-30f) * (1.0f + __expf(-bflo((unsigned)gp[1])))), g2 = 1.0f / (1.0f + __expf(-bflo((unsigned)gp[2])));
        bf16_t* orow = cat + (size_t)(t0 + row) * 2048 + h * HD + 4 * fq; const bf16_t* crow = ocmp + (size_t)(t0 + row) * 1536 + h * HD + 4 * fq;
#pragma unroll
        for (int db = 0; db < 8; ++db) { const u32x2 c = *(const u32x2*)(crow + 16 * db), wv = *(const u32x2*)(orow + 16 * db);
            const float r0 = g0 * bflo(c.x) + g1 * o[rb][db][0] + g2 * bflo(wv.x), r1 = g0 * bfhi(c.x) + g1 * o[rb][db][1] + g2 * bfhi(wv.x);
            const float r2 = g0 * bflo(c.y) + g1 * o[rb][db][2] + g2 * bflo(wv.y), r3 = g0 * bfhi(c.y) + g1 * o[rb][db][3] + g2 * bfhi(wv.y);
            u32x2 w; w.x = pg8::cvt_pk_bf16(r0, r1); w.y = pg8::cvt_pk_bf16(r2, r3); *(u32x2*)(orow + 16 * db) = w; } }
}
__device__ __forceinline__ int opq_tid() { int t = threadIdx.x; asm volatile("" : "+v"(t)); return t; }
__global__ void __launch_bounds__(NTHREADS, 2) mega_fwd(Params p) {
    extern __shared__ __attribute__((aligned(16))) unsigned char lds_raw[];
    LAS unsigned char* lds = (LAS unsigned char*)lds_raw;
    cg::grid_group grid = cg::this_grid();
    const int tid = threadIdx.x, lane = tid & 63, wave = __builtin_amdgcn_readfirstlane(tid >> 6);
    const int G = gridDim.x, bid = blockIdx.x;
    volatile LAS unsigned* bst = (volatile LAS unsigned*)(lds + LDS_MAIN);
    if (tid < 2) bst[tid] = 0u;
    __syncthreads();
    const XcdBarrier gbar = xcd_barrier_post((unsigned*)(p.ws + WS_BAR), bst);
    grid.sync();
    const int gw = bid * NWAVES + wave, ngw = G * NWAVES;
    unsigned char* ws = p.ws;
    float* X = p.out;
    bf16_t* XH = (bf16_t*)(ws + WS_XH); bf16_t* PROJ = (bf16_t*)(ws + WS_PROJ); float* OBUF = (float*)(ws + WS_OBUF);
    bf16_t* CAT = (bf16_t*)(ws + WS_CAT); bf16_t* KVS = (bf16_t*)(ws + WS_KVS); bf16_t* MEMKV = (bf16_t*)(ws + WS_MEMKV); bf16_t* MEMHAT = (bf16_t*)(ws + WS_MEMHAT);
    bf16_t* OG = (bf16_t*)(ws + WS_KVS); float* LSE = (float*)(ws + WS_HID); unsigned* SEL = (unsigned*)(ws + WS_SEL); unsigned* UMW = (unsigned*)(ws + WS_UM); float* XS = (float*)(ws + WS_XS);
    bf16_t* OCMP = (bf16_t*)(ws + WS_OBUF);
    bf16_t* OBF = (bf16_t*)(ws + WS_OBUF + (size_t)NTOK * 2048 * 2);
    bf16_t* HID = (bf16_t*)(ws + WS_HID); bf16_t* KCV = (bf16_t*)(ws + WS_KCV); bf16_t* BLK = (bf16_t*)(ws + WS_OBUF);
    LAS float* wscr = (LAS float*)(lds + wave * 16384);

    unsigned long long tacc = 0, tst = 0;
#define TB(k) do { if (TPROBE == (k)) tst = __builtin_amdgcn_s_memrealtime(); } while (0)
#define TE(k) do { if (TPROBE == (k)) tacc += __builtin_amdgcn_s_memrealtime() - tst; } while (0)
    TB(1);
    for (int rep_ = 0; rep_ < REP_P0; ++rep_) {
        ConvJob J;
        for (int j = 0; conv_get(p, j, J); ++j) conv_run(J, wscr, gw, ngw, lane);
        for (int m = gw; m < 1024; m += ngw) rms_row(p.in[I_MEM] + (size_t)m * 2048, MEMHAT + (size_t)m * 2048, nullptr, lane);
        for (int m = gw; m < NTOK; m += ngw) rms_row(p.in[I_X] + (size_t)m * 2048, XH + (size_t)m * 2048, XS + m, lane);
    }
    for (int rs_ = 0; rs_ < REP_SYNC; ++rs_) xcd_barrier(gbar);
    TE(1);

    for (int l = 0; l < 4; ++l) {
        const bool isA = l < 2;
        for (int jb = 0; jb < 3; ++jb) {
            pg8::Gemm g; bf16_t* O; int ldc; int c = bid; int hm = 0, ssh = 11, spn = 1 << 20, hm2 = 0; bf16_t* O2 = nullptr;
            if (jb == 0) { g.A = XH; g.M = NTOK; g.K = 2048;
                if (isA) { g.Bt = (const bf16_t*)(ws + WS_WAIN + l * SZ_WAIN); g.N = A_COLS; O = PROJ; ldc = A_COLS; hm = 76; }
                else { g.Bt = (const bf16_t*)(ws + (l == 2 ? WS_WBIN : WS_WBIN1)); g.N = l == 2 ? B_COLS + 3072 : B_COLS; O = PROJ; ldc = B_COLS; hm = 18; if (l == 2) { spn = 9; O2 = KVS; hm2 = 24; } } }
            else if (jb == 1) { if (l != 0) continue; g.A = MEMHAT; g.Bt = (const bf16_t*)(ws + WS_WMEM); g.M = 1024; g.N = 4096; g.K = 2048; O = MEMKV; ldc = 4096; c = (bid + 64) % G; hm = 32; ssh = 8; }
            else continue;
            pg8::StaticOrder S; S.init(g.M, g.N, G, c);
            pg8::EpiBf16<0> E{O, ldc, hm, ssh, spn, O2, hm2};
            TB(2); for (int rep_ = 0; rep_ < REP_GEMM; ++rep_) pg8::gemm_phase(lds, g, S, E); TE(2);
        }
        for (int rs_ = 0; rs_ < REP_SYNC; ++rs_) xcd_barrier(gbar);
        if (l == 2) {
            const int lane = opq_tid() & 63;
            for (int it = gw; it < 2 * 2048; it += ngw) {
                const int w = it >> 11, row = it & 2047; bf16_t* dst = BLK + ((size_t)w * 2048 + row) * 4096;
                if (row < NBATCH * NCMP * 4) { const int gg = row & 3, bn = row >> 2, bb = bn / NCMP, n = bn % NCMP;
                    const bf16_t* src = KVS + ((size_t)(bb * 24 + w * 4 + gg) * SEQ + 16 * n) * HD; const float* pe = p.in[I_PE] + w * 32 * HD;
                    for (int ll = 0; ll < 32; ++ll) { const unsigned v = *(const unsigned*)(src + (size_t)ll * HD + 2 * lane); const f32x2 e = *(const f32x2*)(pe + ll * HD + 2 * lane);
                        *(unsigned*)(dst + ll * HD + 2 * lane) = pk2(bflo(v) + e.x, bfhi(v) + e.y); } }
                else { for (int ll = 0; ll < 32; ++ll) *(unsigned*)(dst + ll * HD + 2 * lane) = 0u; }
            }
            for (int rs_ = 0; rs_ < REP_SYNC; ++rs_) xcd_barrier(gbar);
            for (int w = 0; w < 2; ++w) { pg8::Gemm g{BLK + (size_t)w * 2048 * 4096, (const bf16_t*)(ws + WS_WC1 + w * SZ_WC1), 2048, 512, 4096};
                pg8::StaticOrder S; S.init(2048, 512, G, (bid + 128 * w) % G); pg8::EpiBf16<1> E{HID + (size_t)w * 2048 * 512, 512, 0, 11, 1 << 20, nullptr, 0}; TB(2); for (int rep_ = 0; rep_ < REP_GEMM; ++rep_) pg8::gemm_phase(lds, g, S, E); TE(2); }
            for (int rs_ = 0; rs_ < REP_SYNC; ++rs_) xcd_barrier(gbar);
            for (int w = 0; w < 2; ++w) { pg8::Gemm g{HID + (size_t)w * 2048 * 512, (const bf16_t*)(ws + WS_WC2 + w * SZ_WC2), 2048, 256, 512};
                pg8::StaticOrder S; S.init(2048, 256, G, (bid + 128 * w) % G); pg8::EpiBf16<0> E{KCV + (size_t)w * 2048 * 256, 256, 0, 11, 1 << 20, nullptr, 0}; TB(2); for (int rep_ = 0; rep_ < REP_GEMM; ++rep_) pg8::gemm_phase(lds, g, S, E); TE(2); }
            for (int rs_ = 0; rs_ < REP_SYNC; ++rs_) xcd_barrier(gbar);
        }
        if (isA) {
            {
                unsigned* qctr = (unsigned*)(p.ws + WS_BAR) + 3584 + 64 * l;
                LAS unsigned* qslot = (LAS unsigned*)(lds + AT_AUX + 8 * 2048 + 64);
                for (;;) {
                    __syncthreads();
                    if (opq_tid() == 0) qslot[0] = __hip_atomic_fetch_add(qctr, 1u, __ATOMIC_RELAXED, __HIP_MEMORY_SCOPE_AGENT);
                    __syncthreads();
                    const int it = (int)qslot[0];
                    if (it >= 1152) break;
                    if (it < 512) { const int gi = it >> 8, u = it & 255; dil_attn_wg(lds, PROJ, OG, LSE, u >> 6, gi * 8 + ((u >> 3) & 7), u & 7, opq_tid()); }
                    else if (it < 640) { const int u = it - 512; mem_attn_wg(lds, PROJ, 76, 72, MEMKV, l, CAT, 1536, 1024, u >> 5, (u >> 3) & 3, u & 7, opq_tid()); }
                    else { const int u = it - 640; dil_attn_wg(lds, PROJ, OG, LSE, u >> 7, 16 + ((u >> 4) & 7), u & 15, opq_tid()); }
                }
            }
            for (int rs_ = 0; rs_ < REP_SYNC; ++rs_) xcd_barrier(gbar);
            TE(3); TB(4);
            for (int rep_ = 0; rep_ < REP_ATT; ++rep_)
            for (int it = bid * NTHREADS + opq_tid(); it < NTOK * 8 * 16; it += G * NTHREADS) { const int c8 = it & 15, tj = it >> 4;
                const float l0 = LSE[tj], l1 = LSE[(size_t)NTOK * 8 + tj], l2 = LSE[(size_t)2 * NTOK * 8 + tj], mx = fmaxf(l0, fmaxf(l1, l2));
                float e0 = __expf(l0 - mx), e1 = __expf(l1 - mx), e2 = __expf(l2 - mx); const float inv = 1.0f / (e0 + e1 + e2); e0 *= inv; e1 *= inv; e2 *= inv;
                const u32x4 a = *(const u32x4*)(OG + (size_t)tj * 128 + 8 * c8), bq = *(const u32x4*)(OG + ((size_t)NTOK * 8 + tj) * 128 + 8 * c8), cq = *(const u32x4*)(OG + ((size_t)2 * NTOK * 8 + tj) * 128 + 8 * c8);
                u32x4 w;
                w.x = pk2(e0 * bflo(a.x) + e1 * bflo(bq.x) + e2 * bflo(cq.x), e0 * bfhi(a.x) + e1 * bfhi(bq.x) + e2 * bfhi(cq.x));
                w.y = pk2(e0 * bflo(a.y) + e1 * bflo(bq.y) + e2 * bflo(cq.y), e0 * bfhi(a.y) + e1 * bfhi(bq.y) + e2 * bfhi(cq.y));
                w.z = pk2(e0 * bflo(a.z) + e1 * bflo(bq.z) + e2 * bflo(cq.z), e0 * bfhi(a.z) + e1 * bfhi(bq.z) + e2 * bfhi(cq.z));
                w.w = pk2(e0 * bflo(a.w) + e1 * bflo(bq.w) + e2 * bflo(cq.w), e0 * bfhi(a.w) + e1 * bfhi(bq.w) + e2 * bfhi(cq.w));
                const int t = tj >> 3, j = tj & 7;
                *(u32x4*)(CAT + (size_t)t * 1536 + j * HD + 8 * c8) = w; }
        } else {
            TB(5);
            for (int rep_ = 0; rep_ < REP_ATT * REP_B1; ++rep_)
            for (int it = bid; it < 256; it += G) cmp_sel_wg(lds, PROJ, KCV, KCV + (size_t)2048 * 256, OCMP, SEL, UMW, it >> 6, (it >> 4) & 3, it & 15, opq_tid());
            for (int rs_ = 0; rs_ < REP_SYNC; ++rs_) xcd_barrier(gbar);
            TE(5); TB(6);
            {
                unsigned* qctr = (unsigned*)(p.ws + WS_BAR) + 3584 + 64 * l;
                LAS unsigned* qslot = (LAS unsigned*)(lds + AT_AUX + 8 * 2048 + 64);
                for (;;) {
                    __syncthreads();
                    if (opq_tid() == 0) qslot[0] = __hip_atomic_fetch_add(qctr, 1u, __ATOMIC_RELAXED, __HIP_MEMORY_SCOPE_AGENT);
                    __syncthreads();
                    const int it = (int)qslot[0];
                    if (it >= 512) break;
                    if (it < 384) { const int qb = 7 - it / 48, j = it % 48; nsa_attn_wg(lds, PROJ, KVS, SEL, UMW, OCMP, CAT, j / 12, j % 12, qb, opq_tid()); }
                    else { const int u = it - 384; mem_attn_wg(lds, PROJ, 18, 12, MEMKV, l, CAT, 2048, 1536, u >> 5, (u >> 3) & 3, u & 7, opq_tid()); }
                }
            }
        }
        for (int rs_ = 0; rs_ < REP_SYNC; ++rs_) xcd_barrier(gbar);
        if (isA) TE(4); else TE(6);
        for (int hf = 0; hf < 2; ++hf) {
            if (hf == 1) { pg8::Gemm g{XH, (const bf16_t*)(ws + WS_WGU + l * SZ_WGU), NTOK, 11264, 2048}; pg8::StaticOrder S; S.init(NTOK, 11264, G, bid);
                pg8::EpiSwiGLU E{PROJ, DFF};
                if (STAGGER_US > 0 && bid >= 128) { const unsigned long long t0 = __builtin_amdgcn_s_memrealtime(); while (__builtin_amdgcn_s_memrealtime() - t0 < (unsigned long long)STAGGER_US * 100ull) __builtin_amdgcn_s_sleep(16); } TB(2); for (int rep_ = 0; rep_ < REP_GEMM; ++rep_) pg8::gemm_phase(lds, g, S, E); TE(2); for (int rs_ = 0; rs_ < REP_SYNC; ++rs_) xcd_barrier(gbar); }
            { pg8::Gemm g; g.M = NTOK; g.N = 2048;
              if (hf == 0) { g.A = CAT; g.K = isA ? 1536 : 2048; g.Bt = isA ? (const bf16_t*)(ws + WS_WAOUT + l * SZ_WAOUT) : (const bf16_t*)(ws + WS_WBOUT + (l - 2) * SZ_WBOUT); }
              else { g.A = PROJ; g.K = DFF; g.Bt = (const bf16_t*)(ws + WS_WDOWN + l * SZ_WDOWN); }
              pg8::StaticOrder S; S.init(NTOK, 2048, G, bid); pg8::EpiBf16<0> E{OBF, 2048, 0, 11, 1 << 20, nullptr, 0}; TB(2); for (int rep_ = 0; rep_ < REP_GEMM; ++rep_) pg8::gemm_phase(lds, g, S, E); TE(2); }
            for (int rs_ = 0; rs_ < REP_SYNC; ++rs_) xcd_barrier(gbar);
            const float* gain = p.in[I_NORMG] + (l * 5 + (hf == 0 ? 1 : 3)) * 2048;
            const bool fin = (l == 3 && hf == 1);
            for (int m = gw; m < NTOK; m += ngw) rowop_row(XH + (size_t)m * 2048, XS + m, OBF + (size_t)m * 2048, gain, fin ? X + (size_t)m * 2048 : nullptr, opq_tid() & 63);
            for (int rs_ = 0; rs_ < REP_SYNC; ++rs_) xcd_barrier(gbar);
        }
    }
    if (TPROBE && bid == 0) { const unsigned long long dt = tacc * 8ull, t0 = __builtin_amdgcn_s_memrealtime(); while (__builtin_amdgcn_s_memrealtime() - t0 < dt) __builtin_amdgcn_s_sleep(8); }
}

extern "C" void kernel_launch(void* const* d_in, const int* in_sizes, int n_in, void* d_out, int out_size, void* d_ws, size_t ws_size, hipStream_t stream) {
    static int grid_blocks = 0;
    if (grid_blocks == 0) {
        if (n_in != 17 || ws_size < WS_END) { fprintf(stderr, "kernel_launch: unexpected n_in %d or ws_size %zu (< %zu)\n", n_in, ws_size, (size_t)WS_END); grid_blocks = -1; return; }
        int dev = 0, cus = 0, per_cu = 0;
        hipGetDevice(&dev);
        hipDeviceGetAttribute(&cus, hipDeviceAttributeMultiprocessorCount, dev);
        hipFuncSetAttribute((const void*)mega_fwd, hipFuncAttributeMaxDynamicSharedMemorySize, LDS_BYTES);
        hipOccupancyMaxActiveBlocksPerMultiprocessor(&per_cu, (const void*)mega_fwd, NTHREADS, LDS_BYTES);
        if (per_cu < 1) per_cu = 1;
        if (per_cu > 1) per_cu = 1;
        grid_blocks = cus * per_cu;
        (void)hipGetLastError();
    }
    if (grid_blocks < 0) return;
    static Params p;
    memset(&p, 0, sizeof(p));
    for (int i = 0; i < 17; ++i) p.in[i] = (const float*)d_in[i];
    p.out = (float*)d_out; p.ws = (unsigned char*)d_ws;
    {
        int n = 0;
        auto add = [&](int in_idx, size_t in_off, int gain_idx, int gain_off, size_t dst_off, int ldw, int col0, int ncols, int K, int nrows, int mode) {
            JobDesc& d = p.jobs[n++]; d.in_idx = in_idx; d.in_off = in_off; d.gain_idx = gain_idx; d.gain_off = gain_off; d.dst_off = dst_off; d.ldw = ldw; d.col0 = col0; d.ncols = ncols; d.K = K; d.nrows = nrows; d.mode = mode; d.pad = 0; };
        for (int l = 0; l < 4; ++l) add(I_WGU, (size_t)l * 2048 * 11264, I_NORMG, (l * 5 + 2) * 2048, WS_WGU + l * SZ_WGU, 11264, 0, 11264, 2048, 11264, 1);
        for (int l = 0; l < 4; ++l) add(I_WDOWN, (size_t)l * 5632 * 2048, -1, 0, WS_WDOWN + l * SZ_WDOWN, 2048, 0, 2048, 5632, 2048, 0);
        for (int l = 0; l < 2; ++l) add(I_AWIN, (size_t)l * 2048 * A_COLS, I_NORMG, (l * 5 + 0) * 2048, WS_WAIN + l * SZ_WAIN, A_COLS, 0, A_COLS, 2048, A_COLS, 0);
        for (int l = 0; l < 2; ++l) add(I_AWOUT, (size_t)l * 1536 * 2048, -1, 0, WS_WAOUT + l * SZ_WAOUT, 2048, 0, 2048, 1536, 2048, 0);
        for (int lb = 0; lb < 2; ++lb) {
            const size_t src = (size_t)lb * 2048 * B_COLS_SRC, dst = lb == 0 ? WS_WBIN : WS_WBIN1; const int go = ((2 + lb) * 5 + 0) * 2048;
            add(I_BWIN, src, I_NORMG, go, dst, B_COLS_SRC, 0, 1536, 2048, 1536, 0);
            add(I_BWIN, src, I_NORMG, go, dst + (size_t)1536 * 2048 * 2, B_COLS_SRC, 1572, 512, 2048, 512, 0);
            add(I_BWIN, src, I_NORMG, go, dst + (size_t)2048 * 2048 * 2, B_COLS_SRC, 1536, 36, 2048, 256, 0);
        }
        for (int lb = 0; lb < 2; ++lb) add(I_BWOUT, (size_t)lb * 2048 * 2048, -1, 0, WS_WBOUT + lb * SZ_WBOUT, 2048, 0, 2048, 2048, 2048, 0);
        for (int l = 0; l < 4; ++l) add(I_MEMWKV, (size_t)l * 2048 * 1024, I_NORMG, (l * 5 + 4) * 2048, WS_WMEM + (size_t)l * 1024 * 2048 * 2, 1024, 0, 1024, 2048, 1024, 0);
        add(I_KVW, 0, I_KVNG, 0, WS_WKV, 3072, 0, 3072, 2048, 3072, 0);
        add(I_WK1, 0, -1, 0, WS_WC1, 512, 0, 512, 4096, 512, 0);
        add(I_WV1, 0, -1, 0, WS_WC1 + SZ_WC1, 512, 0, 512, 4096, 512, 0);
        add(I_WK2, 0, -1, 0, WS_WC2, 128, 0, 128, 512, 256, 0);
        add(I_WV2, 0, -1, 0, WS_WC2 + SZ_WC2, 128, 0, 128, 512, 256, 0);
        p.njobs = n;
    }
    (void)hipMemsetAsync((char*)d_ws + WS_BAR, 0, WS_BAR_BYTES, stream);
    void* args[] = {&p};
    hipError_t e = hipLaunchCooperativeKernel((const void*)mega_fwd, dim3(grid_blocks), dim3(NTHREADS), args, LDS_BYTES, stream);
    if (e != hipSuccess) fprintf(stderr, "cooperative launch failed: %s (grid %d)\n", hipGetErrorString(e), grid_blocks);
}
```

```cpp
#include <hip/hip_runtime.h>
#include <hip/hip_cooperative_groups.h>
#include <cstdio>
#include <cstring>
namespace cg = cooperative_groups;
#define REP_P0 1
#define REP_GEMM 1
#define REP_ATT 1
#define REP_ATTA 1
#define REP_B1 1
#define REP_B2 1
#define REP_SYNC 1
#define PROBE_ATT 0
#define TPROBE 0
#define STAGGER_US 0

#define LAS __attribute__((address_space(3)))
typedef unsigned short bf16_t;
typedef short bf16x8 __attribute__((ext_vector_type(8)));
typedef float f32x4 __attribute__((ext_vector_type(4)));
typedef float f32x2 __attribute__((ext_vector_type(2)));
typedef unsigned u32x4 __attribute__((ext_vector_type(4)));
typedef unsigned u32x2 __attribute__((ext_vector_type(2)));
typedef __bf16 bf16x2_t __attribute__((ext_vector_type(2)));

constexpr int D_MODEL = 2048, NTOK = 8192, SEQ = 2048, NBATCH = 4, DFF = 5632, HD = 128;
constexpr int A_COLS = 9728, B_COLS_SRC = 2084, B_COLS = 2304, NCMP = 127;
constexpr int NWAVES = 8, NTHREADS = 512;
constexpr int LDS_MAIN = 131072; constexpr int LDS_BYTES = LDS_MAIN + 64;

constexpr size_t SZ_WAIN = (size_t)A_COLS * 2048 * 2, SZ_WAOUT = (size_t)2048 * 1536 * 2, SZ_WBIN = (size_t)B_COLS * 2048 * 2, SZ_WBOUT = (size_t)2048 * 2048 * 2;
constexpr size_t SZ_WGU = (size_t)11264 * 2048 * 2, SZ_WDOWN = (size_t)2048 * 5632 * 2, SZ_WC1 = (size_t)512 * 4096 * 2, SZ_WC2 = (size_t)256 * 512 * 2;
constexpr size_t WS_WAIN = 0;
constexpr size_t WS_WAOUT = WS_WAIN + 2 * SZ_WAIN;
constexpr size_t WS_WBIN = WS_WAOUT + 2 * SZ_WAOUT;
constexpr size_t SZ_WKV = (size_t)3072 * 2048 * 2;
constexpr size_t WS_WKV = WS_WBIN + SZ_WBIN;
constexpr size_t WS_WBIN1 = WS_WKV + SZ_WKV;
constexpr size_t WS_WBOUT = WS_WBIN1 + SZ_WBIN;
constexpr size_t WS_WMEM = WS_WBOUT + 2 * SZ_WBOUT;
constexpr size_t WS_WGU = WS_WMEM + (size_t)4096 * 2048 * 2;
constexpr size_t WS_WDOWN = WS_WGU + 4 * SZ_WGU;
constexpr size_t WS_WC1 = WS_WDOWN + 4 * SZ_WDOWN;
constexpr size_t WS_WC2 = WS_WC1 + 2 * SZ_WC1;
constexpr size_t WS_PROJ = WS_WC2 + 2 * SZ_WC2;
constexpr size_t WS_OBUF = WS_PROJ + (size_t)NTOK * A_COLS * 2;
constexpr size_t WS_XH = WS_OBUF + (size_t)NTOK * 2048 * 4;
constexpr size_t WS_CAT = WS_XH + (size_t)NTOK * 2048 * 2;
constexpr size_t WS_KVS = WS_CAT + (size_t)NTOK * 2048 * 2;
constexpr size_t WS_MEMKV = WS_KVS + (size_t)NTOK * 3072 * 2;
constexpr size_t WS_MEMHAT = WS_MEMKV + (size_t)1024 * 4096 * 2;
constexpr size_t WS_HID = WS_MEMHAT + (size_t)1024 * 2048 * 2;
constexpr size_t WS_KCV = WS_HID + (size_t)2 * 2048 * 512 * 2;
constexpr size_t WS_SEL = WS_KCV + (size_t)2 * 2048 * 256 * 2;
constexpr size_t WS_XS = WS_SEL + (size_t)NTOK * 4 * 4;
constexpr size_t WS_UM = WS_XS + (size_t)NTOK * 4;
constexpr size_t WS_BAR = WS_UM + 4096;
constexpr size_t WS_BAR_BYTES = 16384;
constexpr size_t WS_END = WS_BAR + WS_BAR_BYTES;

#define LDS_WAIT() asm volatile("s_waitcnt lgkmcnt(0)" ::: "memory")
__device__ __forceinline__ unsigned f2bf(float f) { unsigned u = __builtin_bit_cast(unsigned, f); return (u + 0x7fffu + ((u >> 16) & 1u)) >> 16; }
__device__ __forceinline__ unsigned pk2(float lo, float hi) { const f32x2 v = {lo, hi}; return __builtin_bit_cast(unsigned, __builtin_convertvector(v, bf16x2_t)); }
__device__ __forceinline__ float bflo(unsigned w) { return __builtin_bit_cast(float, w << 16); }
__device__ __forceinline__ float bfhi(unsigned w) { return __builtin_bit_cast(float, w & 0xffff0000u); }
__device__ __forceinline__ float wave_sum(float v) {
#pragma unroll
    for (int o = 1; o < 64; o <<= 1) v += __shfl_xor(v, o);
    return v;
}
__device__ __forceinline__ float wave_max(float v) {
#pragma unroll
    for (int o = 1; o < 64; o <<= 1) v = fmaxf(v, __shfl_xor(v, o));
    return v;
}


#define XB_TMO      128
#define XB_XCNT(j)  (256  + 64 * (j))
#define XB_XSUB(j)  (1280 + 64 * (j))
#define XB_XGEN(j)  (2304 + 64 * (j))
#define XB_TOP      3328
#define XB_TOPGEN   3392
#define XCD_BAR_WORDS 3456
#define XB_SPIN_CAP (1u << 18)
__device__ __forceinline__ unsigned xb_ld(unsigned* p)              { return __hip_atomic_load(p, __ATOMIC_RELAXED, __HIP_MEMORY_SCOPE_AGENT); }
__device__ __forceinline__ unsigned xb_add(unsigned* p, unsigned v) { return __hip_atomic_fetch_add(p, v, __ATOMIC_RELAXED, __HIP_MEMORY_SCOPE_AGENT); }
__device__ __forceinline__ unsigned xb_xcc_id() { return (unsigned)__builtin_amdgcn_s_getreg((3 << 11) | 20) & 0xFu; }
#define XB_SPIN(cond, bar) do { unsigned _sp = 0; while (cond) { __builtin_amdgcn_s_sleep(1); \
    if ((++_sp & 255u) == 0u) { if (xb_ld(&(bar)[XB_TMO])) break; if (_sp > XB_SPIN_CAP) { atomicAdd(&(bar)[XB_TMO], 1u); break; } } } } while (0)
struct XcdBarrier { unsigned* bar; unsigned x; volatile LAS unsigned* st; };
__device__ __forceinline__ XcdBarrier xcd_barrier_post(unsigned* bar, volatile LAS unsigned* st) {
    XcdBarrier b; b.bar = bar; b.x = xb_xcc_id(); b.st = st;
    if (threadIdx.x == 0) (void)xb_add(&bar[XB_XCNT(b.x)], 1u);
    return b;
}
__device__ __forceinline__ void xcd_barrier_complete(unsigned* bar, unsigned x, unsigned& nloc, unsigned& nx) {
    const unsigned G = gridDim.x * gridDim.y * gridDim.z;
    unsigned sum, cnt, mine, sp = 0u;
    for (;;) {
        sum = 0u; cnt = 0u; mine = 0u;
#pragma unroll
        for (unsigned j = 0; j < 16; ++j) { const unsigned c = xb_ld(&bar[XB_XCNT(j)]); sum += c; cnt += (c > 0u) ? 1u : 0u; mine = (j == x) ? c : mine; }
        if (sum == G) break;
        __builtin_amdgcn_s_sleep(1);
        if ((++sp & 255u) == 0u) { if (xb_ld(&bar[XB_TMO])) break; if (sp > XB_SPIN_CAP) { atomicAdd(&bar[XB_TMO], 1u); break; } }
    }
    nloc = mine > 0u ? mine : 1u; nx = cnt > 0u ? cnt : 1u;
}
__device__ __forceinline__ void xcd_barrier(const XcdBarrier& b) {
    asm volatile("s_waitcnt vmcnt(0)" ::: "memory");
    __syncthreads();
    if (threadIdx.x == 0) {
        unsigned* bar = b.bar;
        __builtin_amdgcn_s_waitcnt(0);
        unsigned nloc = b.st[0], nx = b.st[1];
        if (nloc == 0u) { xcd_barrier_complete(bar, b.x, nloc, nx); b.st[0] = nloc; b.st[1] = nx; }
        const unsigned old = xb_add(&bar[XB_XSUB(b.x)], 1u);
        const unsigned gen = old / nloc;
        if (old + 1u == (gen + 1u) * nloc) {
            __builtin_amdgcn_fence(__ATOMIC_RELEASE, "agent");
            asm volatile("s_waitcnt vmcnt(0)" ::: "memory");
            const unsigned og = xb_add(&bar[XB_TOP], 1u);
            const unsigned tg = og / nx;
            if (og + 1u == (tg + 1u) * nx) xb_add(&bar[XB_TOPGEN], 1u);
            else XB_SPIN(xb_ld(&bar[XB_TOPGEN]) == tg, bar);
            __builtin_amdgcn_fence(__ATOMIC_ACQUIRE, "agent");
            xb_add(&bar[XB_XGEN(b.x)], 1u);
            asm volatile("s_waitcnt vmcnt(0)" ::: "memory");
        } else {
            XB_SPIN(xb_ld(&bar[XB_XGEN(b.x)]) == gen, bar);
            __builtin_amdgcn_fence(__ATOMIC_ACQUIRE, "agent");
            asm volatile("s_waitcnt vmcnt(0)" ::: "memory");
        }
    }
    __syncthreads();
}

namespace pg8 {
constexpr int BM = 256, BK = 64, HALF = 128, HTB = HALF * BK * 2, STAGE_BYTES = 8 * HTB, NXCD = 8, WGM = 8;
__device__ __forceinline__ int lds_byte(int r, int c) { const int st = (r >> 4) * 2 + (c >> 5), rr = r & 15, cc = c & 31, ob = rr * 64 + cc * 2; return st * 1024 + (ob ^ (((ob >> 9) & 1) << 5)); }
__device__ __forceinline__ void stage_rc(int b, int& R, int& C) { const int st = b / 1024, sb = b % 1024, swz = sb ^ (((sb >> 9) & 1) << 5); R = (st >> 1) * 16 + swz / 64; C = (st & 1) * 32 + (swz % 64) / 2; }
__device__ __forceinline__ int perm32(int rho) { const int n = rho >> 4, i = rho & 15; return 8 * (i >> 2) + 4 * n + (i & 3); }
struct Unit { int pm, pn; };
struct Gemm { const bf16_t* A; const bf16_t* Bt; int M, N, K; };
struct StaticOrder {
    int nM, nN, nwg, G, c;
    __device__ void init(int M, int N, int G_, int c_) { nM = M / BM; nN = N / BM; nwg = nM * nN; G = G_; c = c_; }
    __device__ bool next(int i, Unit& u) const {
        const long L = (long)i * G + c; if (L >= nwg) return false;
        int wgid = (int)L; { const int q = nwg / NXCD, r = nwg % NXCD, xcd = wgid % NXCD, off = wgid / NXCD; wgid = (xcd < r ? xcd * (q + 1) : r * (q + 1) + (xcd - r) * q) + off; }
        const int nig = WGM * nN, gid = wgid / nig, fm = gid * WGM, gsz = (nM - fm) < WGM ? (nM - fm) : WGM;
        u.pm = fm + ((wgid % nig) % gsz); u.pn = (wgid % nig) / gsz; return true;
    }
    __device__ __forceinline__ void a_ready(const Unit&) const {}
    __device__ __forceinline__ void done(const Unit&) const {}
};
__device__ __forceinline__ unsigned cvt_pk_bf16(float lo, float hi) { const f32x2 v = {lo, hi}; return __builtin_bit_cast(unsigned, __builtin_convertvector(v, bf16x2_t)); }

struct EpiF32 {
    static constexpr bool PERM = false;
    float* C; int ldc;
    __device__ __forceinline__ void operator()(const f32x4 (&acc)[2][2][4][2], const Unit& u, int wr, int wc, int fr, int fq) const {
        const int row0 = u.pm * BM + wr * 64 + fr, col0 = u.pn * BM + wc * 32 + 4 * fq;
#pragma unroll
        for (int ai = 0; ai < 2; ++ai)
#pragma unroll
            for (int m = 0; m < 4; ++m) { float* rowp = C + (size_t)(row0 + ai * HALF + m * 16) * ldc + col0;
#pragma unroll
                for (int bj = 0; bj < 2; ++bj)
#pragma unroll
                    for (int n = 0; n < 2; ++n) *(f32x4*)(rowp + bj * HALF + n * 16) = acc[ai][bj][m][n]; }
    }
};
__device__ __forceinline__ float gelu_tanh(float x) { const float t = 1.5957691216f * (x + 0.044715f * x * x * x); return x / (1.0f + __expf(-t)); }
template <int ACT  > struct EpiBf16 {
    static constexpr bool PERM = true;
    bf16_t* O; int ldc;
    int hm_heads, seq_shift; int split_pn; bf16_t* O2; int hm2;
    __device__ __forceinline__ void operator()(const f32x4 (&acc)[2][2][4][2], const Unit& u, int wr, int wc, int fr, int fq) const {
        const int row0 = u.pm * BM + wr * 64 + fr, col0 = u.pn * BM + wc * 32 + 8 * fq;
#pragma unroll
        for (int ai = 0; ai < 2; ++ai)
#pragma unroll
            for (int m = 0; m < 4; ++m) { const int row = row0 + ai * HALF + m * 16;
#pragma unroll
                for (int bj = 0; bj < 2; ++bj) { f32x4 v0 = acc[ai][bj][m][0], v1 = acc[ai][bj][m][1];
                    if (ACT == 1) {
#pragma unroll
                        for (int j = 0; j < 4; ++j) { v0[j] = gelu_tanh(v0[j]); v1[j] = gelu_tanh(v1[j]); } }
                    u32x4 w; w.x = cvt_pk_bf16(v0[0], v0[1]); w.y = cvt_pk_bf16(v0[2], v0[3]); w.z = cvt_pk_bf16(v1[0], v1[1]); w.w = cvt_pk_bf16(v1[2], v1[3]);
                    bf16_t* dst;
                    if (hm_heads > 0) { const bool second = u.pn >= split_pn; bf16_t* base = second ? O2 : O; const int nh = second ? hm2 : hm_heads;
                        const int col = col0 + bj * HALF - (second ? split_pn * BM : 0), b = row >> seq_shift, sq = row & ((1 << seq_shift) - 1);
                        dst = base + ((((size_t)(b * nh + (col >> 7))) << seq_shift) + sq) * 128 + (col & 127); }
                    else dst = O + (size_t)row * ldc + col0 + bj * HALF;
                    *(u32x4*)dst = w; } }
    }
};
struct EpiSwiGLU {
    static constexpr bool PERM = true;
    bf16_t* O; int ldc;
    __device__ __forceinline__ void operator()(const f32x4 (&acc)[2][2][4][2], const Unit& u, int wr, int wc, int fr, int fq) const {
        const int row0 = u.pm * BM + wr * 64 + fr, col0 = u.pn * HALF + wc * 32 + 8 * fq;
#pragma unroll
        for (int ai = 0; ai < 2; ++ai)
#pragma unroll
            for (int m = 0; m < 4; ++m) { bf16_t* rowp = O + (size_t)(row0 + ai * HALF + m * 16) * ldc + col0;
                f32x4 v0, v1;
#pragma unroll
                for (int j = 0; j < 4; ++j) { const float g0 = acc[ai][0][m][0][j], g1 = acc[ai][0][m][1][j];
                    v0[j] = g0 / (1.0f + __expf(-g0)) * acc[ai][1][m][0][j]; v1[j] = g1 / (1.0f + __expf(-g1)) * acc[ai][1][m][1][j]; }
                u32x4 w; w.x = cvt_pk_bf16(v0[0], v0[1]); w.y = cvt_pk_bf16(v0[2], v0[3]); w.z = cvt_pk_bf16(v1[0], v1[1]); w.w = cvt_pk_bf16(v1[2], v1[3]);
                *(u32x4*)rowp = w; }
    }
};

template <class Epi, class Sched>
__device__ __forceinline__ void gemm_phase(LAS unsigned char* lds, const Gemm g, const Sched& S, const Epi& E) {
    int tid_ = threadIdx.x; asm volatile("" : "+v"(tid_));
    const int tid = tid_, wid = __builtin_amdgcn_readfirstlane(tid >> 6), lane = tid & 63, wr = wid >> 2, wc = wid & 3, fr = lane & 15, fq = lane >> 4;
    const int K = g.K, nt = K / BK;
    unsigned voffA[2], voffB[2];
#pragma unroll
    for (int i = 0; i < 2; ++i) { int R, C; stage_rc(tid * 16 + i * 8192, R, C); const int Rb = Epi::PERM ? ((R & ~31) + perm32(R & 31)) : R;
        voffA[i] = (unsigned)(R * K + C) * 2u; voffB[i] = (unsigned)(Rb * K + C) * 2u; }
    const size_t kstep = (size_t)(BK * 2);
    const size_t hstep = (size_t)HALF * K * 2;
    const size_t tstep = 2 * hstep;
    const unsigned ldsw = (unsigned)wid * 1024u;
    const int aoff = lds_byte(wr * 64 + fr, fq * 8), boff = lds_byte(wc * 32 + fr, fq * 8);
#define PG8_SA(b, h) (((b) * 2 + (h)) * HTB)
#define PG8_SB(b, h) ((4 + (b) * 2 + (h)) * HTB)
#define PG8_STAGE(bufoff, gbase, voff) do { _Pragma("unroll") for (int _i = 0; _i < 2; ++_i) \
        __builtin_amdgcn_global_load_lds((const unsigned*)((const char*)(gbase) + (voff)[_i]), (LAS unsigned*)(lds + (bufoff) + ldsw + _i * 8192), 16, 0, 0); } while (0)
#define PG8_LDA(dst, b, h) do { _Pragma("unroll") for (int m = 0; m < 4; ++m) _Pragma("unroll") for (int k = 0; k < 2; ++k) dst[m][k] = *(const LAS bf16x8*)(lds + PG8_SA(b, h) + aoff + m * 2048 + k * 1024); } while (0)
#define PG8_LDB(dst, b, h) do { _Pragma("unroll") for (int n = 0; n < 2; ++n) _Pragma("unroll") for (int k = 0; k < 2; ++k) dst[n][k] = *(const LAS bf16x8*)(lds + PG8_SB(b, h) + boff + n * 2048 + k * 1024); } while (0)
#define PG8_MMA(ai, bj, At, Bt) do { __builtin_amdgcn_s_setprio(1); _Pragma("unroll") for (int m = 0; m < 4; ++m) _Pragma("unroll") for (int n = 0; n < 2; ++n) _Pragma("unroll") for (int k = 0; k < 2; ++k) \
        acc[ai][bj][m][n] = __builtin_amdgcn_mfma_f32_16x16x32_bf16(Bt[n][k], At[m][k], acc[ai][bj][m][n], 0, 0, 0); __builtin_amdgcn_s_setprio(0); } while (0)
#define PG8_WAIT_V(n) asm volatile("s_waitcnt vmcnt(" #n ")" ::: "memory")
#define PG8_WAIT_L(n) asm volatile("s_waitcnt lgkmcnt(" #n ")" ::: "memory")
#define PG8_BAR __builtin_amdgcn_s_barrier()
#define PG8_SCHED __builtin_amdgcn_sched_barrier(0)
    Unit cur, nxt; int ui = 0;
    if (!S.next(0, cur)) return;
    f32x4 acc[2][2][4][2];
#pragma unroll
    for (int a = 0; a < 2; ++a)
#pragma unroll
        for (int b = 0; b < 2; ++b)
#pragma unroll
            for (int m = 0; m < 4; ++m)
#pragma unroll
                for (int n = 0; n < 2; ++n) acc[a][b][m][n] = (f32x4){0.f, 0.f, 0.f, 0.f};
    bf16x8 At[4][2], B0[2][2], B1[2][2];
    const char* cA = (const char*)g.A + (size_t)cur.pm * tstep; const char* cB = (const char*)g.Bt + (size_t)cur.pn * tstep;
    S.a_ready(cur);
    PG8_STAGE(PG8_SB(0, 0), cB, voffB); PG8_STAGE(PG8_SA(0, 0), cA, voffA); PG8_STAGE(PG8_SB(0, 1), cB + hstep, voffB); PG8_STAGE(PG8_SA(0, 1), cA + hstep, voffA);
    if (wr == 1) PG8_BAR;
    PG8_WAIT_V(4); PG8_BAR;
    PG8_STAGE(PG8_SB(1, 0), cB + kstep, voffB); PG8_STAGE(PG8_SA(1, 0), cA + kstep, voffA); PG8_STAGE(PG8_SB(1, 1), cB + hstep + kstep, voffB);
    PG8_WAIT_V(6); PG8_BAR;
    for (;;) {
        const bool has_next = S.next(ui + 1, nxt);
        const char* nA = has_next ? (const char*)g.A + (size_t)nxt.pm * tstep : cA; const char* nB = has_next ? (const char*)g.Bt + (size_t)nxt.pn * tstep : cB;
        for (int t = 0; t < nt; t += 2) {
            const bool last = (t == nt - 2);
            const char* a1 = cA + (size_t)(t + 1) * kstep;
            const char* a2 = last ? nA : cA + (size_t)(t + 2) * kstep; const char* b2 = last ? nB : cB + (size_t)(t + 2) * kstep;
            const char* a3 = a2 + kstep; const char* b3 = b2 + kstep;
            if (last && has_next) S.a_ready(nxt);
            PG8_LDB(B0, 0, 0); PG8_SCHED; PG8_LDA(At, 0, 0); PG8_STAGE(PG8_SA(1, 1), a1 + hstep, voffA);
            PG8_WAIT_L(8); PG8_BAR; PG8_WAIT_L(0); PG8_MMA(0, 0, At, B0); PG8_BAR; PG8_SCHED;
            PG8_LDB(B1, 0, 1); PG8_STAGE(PG8_SB(0, 0), b2, voffB);
            PG8_BAR; PG8_WAIT_L(0); PG8_MMA(0, 1, At, B1); PG8_BAR;
            PG8_LDA(At, 0, 1); PG8_STAGE(PG8_SA(0, 0), a2, voffA);
            PG8_BAR; PG8_WAIT_L(0); PG8_MMA(1, 0, At, B0); PG8_BAR; PG8_SCHED;
            PG8_STAGE(PG8_SB(0, 1), b2 + hstep, voffB);
            PG8_WAIT_V(6); PG8_BAR; PG8_MMA(1, 1, At, B1); PG8_BAR;
            PG8_LDB(B0, 1, 0); PG8_SCHED; PG8_LDA(At, 1, 0); PG8_STAGE(PG8_SA(0, 1), a2 + hstep, voffA);
            PG8_WAIT_L(8); PG8_BAR; PG8_WAIT_L(0); PG8_MMA(0, 0, At, B0); PG8_BAR; PG8_SCHED;
            PG8_LDB(B1, 1, 1); PG8_STAGE(PG8_SB(1, 0), b3, voffB);
            PG8_BAR; PG8_WAIT_L(0); PG8_MMA(0, 1, At, B1); PG8_BAR;
            PG8_LDA(At, 1, 1); PG8_STAGE(PG8_SA(1, 0), a3, voffA);
            PG8_BAR; PG8_WAIT_L(0); PG8_MMA(1, 0, At, B0); PG8_BAR; PG8_SCHED;
            PG8_STAGE(PG8_SB(1, 1), b3 + hstep, voffB);
            PG8_WAIT_V(6); PG8_BAR; PG8_MMA(1, 1, At, B1); PG8_BAR;
        }
        E(acc, cur, wr, wc, fr, fq); S.done(cur);
        if (!has_next) break;
#pragma unroll
        for (int a = 0; a < 2; ++a)
#pragma unroll
            for (int b = 0; b < 2; ++b)
#pragma unroll
                for (int m = 0; m < 4; ++m)
#pragma unroll
                    for (int n = 0; n < 2; ++n) acc[a][b][m][n] = (f32x4){0.f, 0.f, 0.f, 0.f};
        cur = nxt; cA = nA; cB = nB; ++ui;
    }
    PG8_WAIT_V(0);
    if (wr == 0) PG8_BAR;
    PG8_BAR;
#undef PG8_SA
#undef PG8_SB
#undef PG8_STAGE
#undef PG8_LDA
#undef PG8_LDB
#undef PG8_MMA
#undef PG8_WAIT_V
#undef PG8_WAIT_L
#undef PG8_BAR
#undef PG8_SCHED
}
}

struct JobDesc { unsigned long long in_off, dst_off; int in_idx, gain_idx, gain_off, ldw, col0, ncols, K, nrows, mode, pad; };
constexpr int MAXJOBS = 32;
struct Params { const float* in[17]; float* out; unsigned char* ws; JobDesc jobs[MAXJOBS]; int njobs, pad; };
enum { I_X = 0, I_MEM, I_NORMG, I_AWIN, I_AWOUT, I_BWIN, I_BWOUT, I_MEMWKV, I_WGU, I_WDOWN, I_KVNG, I_KVW, I_PE, I_WK1, I_WK2, I_WV1, I_WV2 };

struct ConvJob { const float* W; const float* gain; bf16_t* dst; int ldw, col0, ncols, K, nrows, mode; };
__device__ __forceinline__ bool conv_get(const Params& p, int j, ConvJob& J) {
    if (j >= p.njobs) return false;
    const JobDesc& d = p.jobs[j];
    J.W = p.in[d.in_idx] + d.in_off; J.gain = d.gain_idx >= 0 ? p.in[d.gain_idx] + d.gain_off : nullptr; J.dst = (bf16_t*)(p.ws + d.dst_off);
    J.ldw = d.ldw; J.col0 = d.col0; J.ncols = d.ncols; J.K = d.K; J.nrows = d.nrows; J.mode = d.mode;
    return true;
}
__device__ __forceinline__ void conv_load(const ConvJob& J, int it, int nblk, int lane, f32x4 (&v)[16]) {
    const int kb = it / nblk, nb = it - kb * nblk, k0 = 64 * kb, n = 64 * nb + 4 * (lane & 15), kr = lane >> 4;
    const bool ok = n < J.ncols;
    const int sc = J.mode == 1 ? (((n >> 7) & 1) * 5632 + (n >> 8) * 128 + (n & 127)) : (J.col0 + n);
    const float* src = J.W + (size_t)(k0 + kr) * J.ldw + sc;
#pragma unroll
    for (int i = 0; i < 16; ++i) v[i] = ok ? __builtin_nontemporal_load((const f32x4*)(src + (size_t)(4 * i) * J.ldw)) : (f32x4){0.f, 0.f, 0.f, 0.f};
}
__device__ __forceinline__ void conv_emit(const ConvJob& J, LAS float* scr, int it, int nblk, int lane, const f32x4 (&cur)[16]) {
    const int c4 = lane & 15, kr = lane >> 4, nb8 = lane >> 3, c = lane & 7;
    const int kb = it / nblk, nb = it - kb * nblk, k0 = 64 * kb, n0 = 64 * nb;
#pragma unroll
    for (int i = 0; i < 16; ++i) *(LAS f32x4*)(scr + (kr + 4 * i) * 64 + ((c4 ^ (i >> 1)) << 2)) = cur[i];
    LDS_WAIT();
    f32x4 g0 = {1.f, 1.f, 1.f, 1.f}, g1 = {1.f, 1.f, 1.f, 1.f};
    if (J.gain) { g0 = *(const f32x4*)(J.gain + k0 + 8 * c); g1 = *(const f32x4*)(J.gain + k0 + 8 * c + 4); }
#pragma unroll
    for (int j = 0; j < 8; ++j) { const int n = nb8 + 8 * j; const LAS float* t = scr + (8 * c) * 64 + ((((n >> 2) ^ c) << 2) | (n & 3));
        u32x4 o; o.x = pk2(t[0 * 64] * g0[0], t[1 * 64] * g0[1]); o.y = pk2(t[2 * 64] * g0[2], t[3 * 64] * g0[3]); o.z = pk2(t[4 * 64] * g1[0], t[5 * 64] * g1[1]); o.w = pk2(t[6 * 64] * g1[2], t[7 * 64] * g1[3]);
        *(u32x4*)(J.dst + (size_t)(n0 + n) * J.K + k0 + 8 * c) = o; }
    LDS_WAIT();
}
__device__ __forceinline__ void conv_run(const ConvJob& J, LAS float* scr, int gw, int ngw, int lane) {
    const int nblk = J.nrows / 64, kblk = J.K / 64, items = nblk * kblk;
    f32x4 bufA[16], bufB[16];
    int it = gw;
    if (it < items) conv_load(J, it, nblk, lane, bufA);
    while (it < items) {
        if (it + ngw < items) conv_load(J, it + ngw, nblk, lane, bufB);
        conv_emit(J, scr, it, nblk, lane, bufA);
        it += ngw; if (it >= items) break;
        if (it + ngw < items) conv_load(J, it + ngw, nblk, lane, bufA);
        conv_emit(J, scr, it, nblk, lane, bufB);
        it += ngw;
    }
}

__device__ __forceinline__ void rms_row(const float* xrow, bf16_t* orow, float* scale_out, int lane) {
    const f32x4* xr = (const f32x4*)xrow + lane;
    f32x4 v[8]; float s = 0.f;
#pragma unroll
    for (int j = 0; j < 8; ++j) { v[j] = xr[64 * j]; s += (v[j].x * v[j].x + v[j].y * v[j].y) + (v[j].z * v[j].z + v[j].w * v[j].w); }
    const float ms = wave_sum(s) * (1.f / 2048.f) + 1e-6f, rs = rsqrtf(ms);
    u32x2* o8 = (u32x2*)orow + lane;
#pragma unroll
    for (int j = 0; j < 8; ++j) { u32x2 w; w.x = pk2(v[j].x * rs, v[j].y * rs); w.y = pk2(v[j].z * rs, v[j].w * rs); o8[64 * j] = w; }
    if (scale_out && lane == 0) *scale_out = sqrtf(ms);
}
__device__ __forceinline__ void rowop_row(bf16_t* hrow, float* scale, const bf16_t* orow, const float* gain, float* outrow, int lane) {
    const u32x2* o2 = (const u32x2*)orow + lane; u32x2* h2 = (u32x2*)hrow + lane; const f32x4* g4 = (const f32x4*)gain + lane;
    const float sc = *scale;
    f32x4 o[8]; float s = 0.f;
#pragma unroll
    for (int j = 0; j < 8; ++j) { const u32x2 w = o2[64 * j]; o[j] = (f32x4){bflo(w.x), bfhi(w.x), bflo(w.y), bfhi(w.y)}; s += (o[j].x * o[j].x + o[j].y * o[j].y) + (o[j].z * o[j].z + o[j].w * o[j].w); }
    const float rs = rsqrtf(wave_sum(s) * (1.f / 2048.f) + 1e-6f);
    float s2 = 0.f;
#pragma unroll
    for (int j = 0; j < 8; ++j) { const f32x4 g = g4[64 * j]; const u32x2 w = h2[64 * j]; f32x4 x = (f32x4){bflo(w.x), bfhi(w.x), bflo(w.y), bfhi(w.y)} * sc; x = x + o[j] * rs * g; o[j] = x; s2 += (x.x * x.x + x.y * x.y) + (x.z * x.z + x.w * x.w); }
    if (outrow) { f32x4* x4 = (f32x4*)outrow + lane;
#pragma unroll
        for (int j = 0; j < 8; ++j) x4[64 * j] = o[j];
        return; }
    const float ms2 = wave_sum(s2) * (1.f / 2048.f) + 1e-6f, rs2 = rsqrtf(ms2);
#pragma unroll
    for (int j = 0; j < 8; ++j) { u32x2 w; w.x = pk2(o[j].x * rs2, o[j].y * rs2); w.y = pk2(o[j].z * rs2, o[j].w * rs2); h2[64 * j] = w; }
    if (lane == 0) *scale = sqrtf(ms2);
}

typedef short s16x4 __attribute__((ext_vector_type(4)));
constexpr int AT_ROWB = 272, AT_TILEB = 64 * AT_ROWB, AT_STAGEB = 2 * AT_TILEB;
constexpr int AT_AUX = 2 * AT_STAGEB;
constexpr float SCALE2 = 0.12751743f;
constexpr float LOG2E = 1.4426950408889634f, LN2 = 0.6931471805599453f;
struct AttnArgs {
    const bf16_t* q; size_t qstride;
    const bf16_t* k; const bf16_t* v; size_t kvstride;
    unsigned tilemask;
    int nkeys, qpos0, kmul, maxdist;
    float slope2;
    int nrows;
};
__device__ __forceinline__ void at_gload(const AttnArgs& A, int kt, int tid, u32x4 (&kr)[2], u32x4 (&vr)[2]) {
#pragma unroll
    for (int i = 0; i < 2; ++i) { const int id = tid + 512 * i, row = id >> 4, c16 = id & 15; const size_t off = (size_t)(64 * kt + row) * A.kvstride + 8 * c16;
        kr[i] = *(const u32x4*)(A.k + off); vr[i] = *(const u32x4*)(A.v + off); }
}
__device__ __forceinline__ void at_lstore(LAS unsigned char* st, int tid, const u32x4 (&kr)[2], const u32x4 (&vr)[2]) {
#pragma unroll
    for (int i = 0; i < 2; ++i) { const int id = tid + 512 * i, row = id >> 4, c16 = id & 15;
        *(LAS u32x4*)(st + row * AT_ROWB + c16 * 16) = kr[i];
        const int prow = (row & ~12) | (((row >> 2) & 1) << 3) | (((row >> 3) & 1) << 2), swz = ((prow & 3) << 2) | ((prow >> 2) & 3);
        *(LAS u32x4*)(st + AT_TILEB + prow * 256 + ((c16 ^ swz) << 4)) = vr[i]; }
}
__device__ __forceinline__ bf16x8 pack8(const f32x4& a, const f32x4& b) {
    u32x4 w; w.x = pg8::cvt_pk_bf16(a[0], a[1]); w.y = pg8::cvt_pk_bf16(a[2], a[3]); w.z = pg8::cvt_pk_bf16(b[0], b[1]); w.w = pg8::cvt_pk_bf16(b[2], b[3]);
    return __builtin_bit_cast(bf16x8, w);
}
__device__ __forceinline__ bf16x8 tr_pair(const LAS unsigned char* p0, const LAS unsigned char* p1) {
    const s16x4 lo = __builtin_amdgcn_ds_read_tr16_b64_v4i16((LAS s16x4*)p0), hi = __builtin_amdgcn_ds_read_tr16_b64_v4i16((LAS s16x4*)p1);
    return __builtin_shufflevector(lo, hi, 0, 1, 2, 3, 4, 5, 6, 7);
}
struct AttnPre { bf16x8 qf[2][4]; u32x4 kA[2], vA[2], kB[2], vB[2]; };
__device__ __forceinline__ void attn_issue_q(const AttnArgs& A, int tid, AttnPre& P) {
    const int lane = tid & 63, wave = tid >> 6, fr = lane & 15, fq = lane >> 4;
#pragma unroll
    for (int rb = 0; rb < 2; ++rb) { const bf16_t* qp = A.q + (size_t)(wave * 32 + rb * 16 + fr) * A.qstride + 8 * fq;
#pragma unroll
        for (int dc = 0; dc < 4; ++dc) P.qf[rb][dc] = *(const bf16x8*)(qp + 32 * dc); }
}
__device__ __forceinline__ void attn_issue_kv(const AttnArgs& A, int tid, AttnPre& P) {
    unsigned tm = A.tilemask;
    if (tm == 0u) return;
    const int k0 = 31 - __builtin_clz(tm); tm &= ~(1u << k0);
    at_gload(A, k0, tid, P.kA, P.vA);
    if (tm) { const int k1 = 31 - __builtin_clz(tm); at_gload(A, k1, tid, P.kB, P.vB); }
}
template <bool USE_SEL>
__device__ __forceinline__ void attn_run(LAS unsigned char* lds, const AttnArgs& A, const unsigned (&selmask)[2], int tid, AttnPre& P, f32x4 (&o)[2][8], float (&m)[2], float (&l)[2]) {
    const int lane = tid & 63, wave = __builtin_amdgcn_readfirstlane(tid >> 6), fr = lane & 15, fq = lane >> 4;
    bf16x8 (&qf)[2][4] = P.qf;
#pragma unroll
    for (int rb = 0; rb < 2; ++rb) { m[rb] = -INFINITY; l[rb] = 0.f;
#pragma unroll
        for (int db = 0; db < 8; ++db) o[rb][db] = (f32x4){0.f, 0.f, 0.f, 0.f}; }
    unsigned tm = A.tilemask;
    if (tm == 0u) return;
    const int wr0 = 32 * wave, wq0 = A.qpos0 + wr0;
    const int qp0 = A.qpos0 + wr0 + fr;
    const bool nomask = A.kmul == 0;
    auto tile = [&](const int kt, const LAS unsigned char* st) {
        if (wr0 >= A.nrows) return;
        const int dlo = wq0 - 64 * kt - 63, dhi = wq0 + 31 - 64 * kt;
        bool tsel[2]; tsel[0] = USE_SEL ? (((selmask[0] >> kt) & 1u) != 0u) : true; tsel[1] = USE_SEL ? (((selmask[1] >> kt) & 1u) != 0u) : true;
        if (!nomask && (dhi < 0 || dlo > A.maxdist || (USE_SEL && !__any(tsel[0] || tsel[1])))) return;
        const bool interior = nomask || (dlo >= 0 && dhi <= A.maxdist && (!USE_SEL || __all(tsel[0] && tsel[1])));
        f32x4 s[2][4];
        { const LAS unsigned char* kbase = st + fr * AT_ROWB + fq * 16;
#pragma unroll
          for (int kb = 0; kb < 4; ++kb) { s[0][kb] = (f32x4){0.f, 0.f, 0.f, 0.f}; s[1][kb] = (f32x4){0.f, 0.f, 0.f, 0.f};
#pragma unroll
              for (int dc = 0; dc < 4; ++dc) { const bf16x8 kf = *(const LAS bf16x8*)(kbase + kb * 16 * AT_ROWB + dc * 64);
                  s[0][kb] = __builtin_amdgcn_mfma_f32_16x16x32_bf16(kf, qf[0][dc], s[0][kb], 0, 0, 0); s[1][kb] = __builtin_amdgcn_mfma_f32_16x16x32_bf16(kf, qf[1][dc], s[1][kb], 0, 0, 0); } } }
        float muse[2];
        bool moved = false;
#pragma unroll
        for (int rb = 0; rb < 2; ++rb) {
            const int D0r = qp0 + 16 * rb - 64 * kt - 4 * fq, D0 = (USE_SEL && !tsel[rb]) ? -(1 << 30) : D0r;
            const float B0 = nomask ? 0.f : -A.slope2 * (float)D0r;
            float tmax = -INFINITY;
            if (interior) {
#pragma unroll
                for (int kb = 0; kb < 4; ++kb)
#pragma unroll
                    for (int e = 0; e < 4; ++e) { const float x = fmaf(s[rb][kb][e], SCALE2, fmaf(A.slope2, (float)(16 * kb + e), B0)); s[rb][kb][e] = x; tmax = fmaxf(tmax, x); }
            } else {
#pragma unroll
                for (int kb = 0; kb < 4; ++kb)
#pragma unroll
                    for (int e = 0; e < 4; ++e) { const bool valid = (unsigned)(D0 - (16 * kb + e)) <= (unsigned)A.maxdist;
                        const float x = valid ? fmaf(s[rb][kb][e], SCALE2, fmaf(A.slope2, (float)(16 * kb + e), B0)) : -INFINITY; s[rb][kb][e] = x; tmax = fmaxf(tmax, x); }
            }
            tmax = fmaxf(tmax, __shfl_xor(tmax, 16)); tmax = fmaxf(tmax, __shfl_xor(tmax, 32));
            const float mnew = fmaxf(m[rb], tmax); muse[rb] = (mnew == -INFINITY) ? 0.f : mnew;
            moved = moved || (mnew != m[rb]);
            if (!__all(mnew == m[rb])) {
                const float alpha = __builtin_amdgcn_exp2f(m[rb] - muse[rb]);
                l[rb] *= alpha;
#pragma unroll
                for (int db = 0; db < 8; ++db) o[rb][db] *= alpha;
            }
            m[rb] = mnew;
#pragma unroll
            for (int kb = 0; kb < 4; ++kb)
#pragma unroll
                for (int e = 0; e < 4; ++e) { const float pv = __builtin_amdgcn_exp2f(s[rb][kb][e] - muse[rb]); s[rb][kb][e] = pv; l[rb] += pv; }
        }
        (void)moved;
        const int vq = fr >> 2, vp = fr & 3, vS = (vq << 2) | (2 * (fq & 1) + (fq >> 1)), vx0 = ((vp >> 1) ^ vS) & 1, vS14 = vS & 14;
        const LAS unsigned char* vbase = st + AT_TILEB + 256 * (8 * (fq & 1) + 4 * (fq >> 1) + vq) + 8 * (vp & 1);
#pragma unroll
        for (int c = 0; c < 2; ++c) { const bf16x8 pf0 = pack8(s[0][2 * c], s[0][2 * c + 1]), pf1 = pack8(s[1][2 * c], s[1][2 * c + 1]);
#pragma unroll
            for (int db = 0; db < 8; ++db) { const int co = (((2 * db) ^ vS14) | vx0) << 4; const bf16x8 vf = tr_pair(vbase + c * 32 * 256 + co, vbase + (c * 32 + 16) * 256 + co);
                o[0][db] = __builtin_amdgcn_mfma_f32_16x16x32_bf16(vf, pf0, o[0][db], 0, 0, 0); o[1][db] = __builtin_amdgcn_mfma_f32_16x16x32_bf16(vf, pf1, o[1][db], 0, 0, 0); } }
    };
    u32x4 (&krA)[2] = P.kA; u32x4 (&vrA)[2] = P.vA; u32x4 (&krB)[2] = P.kB; u32x4 (&vrB)[2] = P.vB;
    int k0 = 31 - __builtin_clz(tm); tm &= ~(1u << k0);
    int k1 = -1; if (tm) { k1 = 31 - __builtin_clz(tm); tm &= ~(1u << k1); }
    at_lstore(lds, tid, krA, vrA); __syncthreads();
    for (;;) {
        int k2 = -1; if (tm) { k2 = 31 - __builtin_clz(tm); tm &= ~(1u << k2); }
        if (k2 >= 0) at_gload(A, k2, tid, krA, vrA);
        tile(k0, lds);
        if (k1 >= 0) at_lstore(lds + AT_STAGEB, tid, krB, vrB);
        __syncthreads();
        if (k1 < 0) break;
        int k3 = -1; if (tm) { k3 = 31 - __builtin_clz(tm); tm &= ~(1u << k3); }
        if (k3 >= 0) at_gload(A, k3, tid, krB, vrB);
        tile(k1, lds + AT_STAGEB);
        if (k2 >= 0) at_lstore(lds, tid, krA, vrA);
        __syncthreads();
        if (k2 < 0) break;
        k0 = k2; k1 = k3;
    }
#pragma unroll
    for (int rb = 0; rb < 2; ++rb) { l[rb] += __shfl_xor(l[rb], 16); l[rb] += __shfl_xor(l[rb], 32); }
}
template <bool USE_SEL>
__device__ __forceinline__ void attn_core(LAS unsigned char* lds, const AttnArgs& A, const unsigned (&selmask)[2], int tid, f32x4 (&o)[2][8], float (&m)[2], float (&l)[2]) {
    AttnPre P; attn_issue_q(A, tid, P); attn_issue_kv(A, tid, P); attn_run<USE_SEL>(lds, A, selmask, tid, P, o, m, l);
}
__device__ __forceinline__ void at_store_o(bf16_t* orow, const f32x4 (&o)[8], float inv, int fq) {
#pragma unroll
    for (int db = 0; db < 8; ++db) { u32x2 w; w.x = pg8::cvt_pk_bf16(o[db][0] * inv, o[db][1] * inv); w.y = pg8::cvt_pk_bf16(o[db][2] * inv, o[db][3] * inv); *(u32x2*)(orow + 16 * db + 4 * fq) = w; }
}
__device__ __forceinline__ void mem_args(AttnArgs& A, const bf16_t* proj, int nh, int mq0, const bf16_t* memkv, int l, int b, int h, int qb) {
    A.q = proj + ((size_t)(b * nh + mq0 + h) * SEQ + qb * 256) * HD; A.qstride = HD; A.k = memkv + (size_t)(b * 32 + l * 8 + h) * 256 * HD; A.v = A.k + (size_t)4 * 256 * HD; A.kvstride = HD;
    A.tilemask = 0xFu; A.nkeys = 256; A.qpos0 = 1 << 20; A.kmul = 0; A.maxdist = 0x7fffffff; A.slope2 = 0.f; A.nrows = 256;
}
__device__ __forceinline__ void mem_attn_wg(LAS unsigned char* lds, const bf16_t* proj, int nh, int mq0, const bf16_t* memkv, int l, bf16_t* cat, int ldc, int memoff, int b, int h, int qb, int tid_) {
    int tid = tid_; asm volatile("" : "+v"(tid));
    AttnArgs A; mem_args(A, proj, nh, mq0, memkv, l, b, h, qb);
    const unsigned nosel[2] = {0u, 0u};
    f32x4 o[2][8]; float m[2], lsum[2]; attn_core<false>(lds, A, nosel, tid, o, m, lsum);
    const int lane = tid & 63, t0 = b * SEQ + qb * 256;
#pragma unroll
    for (int rb = 0; rb < 2; ++rb) { const int row = (tid >> 6) * 32 + rb * 16 + (lane & 15);
        at_store_o(cat + (size_t)(t0 + row) * ldc + memoff + h * HD, o[rb], 1.0f / fmaxf(lsum[rb], 1e-30f), lane >> 4); }
}
__device__ __forceinline__ void dil_attn_wg(LAS unsigned char* lds, const bf16_t* proj, bf16_t* og, float* lse, int b, int hh, int x, int tid_) {
    int tid = tid_; asm volatile("" : "+v"(tid));
    const int gi = hh >> 3, j = hh & 7, d = gi == 0 ? 1 : (gi == 1 ? 4 : 16), L = SEQ / d, nqb = gi == 0 ? 8 : (gi == 1 ? 2 : 1), r = x / nqb, qb = x % nqb, c0 = qb * 256;
    const float slope = exp2f(-8.0f * (float)(hh + 1) / 24.0f);
    AttnArgs A; A.q = proj + ((size_t)(b * 76 + hh) * SEQ + c0 * d + r) * HD; A.qstride = (size_t)d * HD;
    A.k = proj + ((size_t)(b * 76 + 24 + hh) * SEQ + r) * HD; A.v = A.k + (size_t)24 * SEQ * HD; A.kvstride = (size_t)d * HD;
    { const int ktc = c0 >> 6, k0 = ktc - 2 < 0 ? 0 : ktc - 2, kend = (ktc + 4 < L / 64 ? ktc + 4 : L / 64) - 1; A.tilemask = (0xffffffffu >> (31 - kend)) & (0xffffffffu << k0); }
    A.nkeys = L; A.qpos0 = c0; A.kmul = 1; A.maxdist = 128; A.slope2 = slope * (float)d * LOG2E; A.nrows = L - c0 < 256 ? L - c0 : 256;
    const unsigned nosel[2] = {0u, 0u};
    f32x4 o[2][8]; float m[2], lsum[2]; attn_core<false>(lds, A, nosel, tid, o, m, lsum);
    const int lane = tid & 63, fr = lane & 15, fq = lane >> 4;
#pragma unroll
    for (int rb = 0; rb < 2; ++rb) { const int row = (tid >> 6) * 32 + rb * 16 + fr;
        if (row < A.nrows) { const size_t t = (size_t)b * SEQ + (size_t)(c0 + row) * d + r;
            at_store_o(og + ((size_t)gi * NTOK + t) * 1024 + j * HD, o[rb], 1.0f / fmaxf(lsum[rb], 1e-30f), fq);
            if (fq == 0) lse[((size_t)gi * NTOK + t) * 8 + j] = m[rb] * LN2 + __logf(fmaxf(lsum[rb], 1e-30f)); } }
}
__device__ __forceinline__ void cmp_sel_wg(LAS unsigned char* lds, const bf16_t* proj, const bf16_t* kc, const bf16_t* vc, bf16_t* ocmp, unsigned* sel, unsigned* umw, int b, int g, int qb, int tid_) {
    int tid = tid_; asm volatile("" : "+v"(tid));
    const int lane = tid & 63, wave = tid >> 6, fr = lane & 15, fq = lane >> 4, row = wave * 16 + fr, t0 = b * SEQ + qb * 128, spos_ = qb * 128 + row, cur = spos_ >> 6;
    bf16x8 qf3[3][4];
#pragma unroll
    for (int r = 0; r < 3; ++r) { const bf16_t* qp = proj + ((size_t)(b * 18 + 3 * g + r) * SEQ + qb * 128 + row) * HD + 8 * fq;
#pragma unroll
        for (int dc = 0; dc < 4; ++dc) qf3[r][dc] = *(const bf16x8*)(qp + 32 * dc); }
#pragma unroll
    for (int i = 0; i < 4; ++i) { const int id = tid + 512 * i, n = id >> 4, c16 = id & 15; const size_t off = ((size_t)(b * NCMP + n) * 4 + g) * 256 + 8 * c16;
        *(LAS u32x4*)(lds + n * AT_ROWB + c16 * 16) = *(const u32x4*)(kc + off); *(LAS u32x4*)(lds + 2 * AT_TILEB + n * AT_ROWB + c16 * 16) = *(const u32x4*)(vc + off); }
    __syncthreads();
    float imp[8];
#pragma unroll
    for (int kb = 0; kb < 8; ++kb) imp[kb] = 0.f;
#pragma unroll
    for (int r = 0; r < 3; ++r) {
        const int h = 3 * g + r; const float slope2 = exp2f(-8.0f * (float)(h + 1) / 12.0f) * LOG2E;
        int z = 0; asm volatile("" : "+v"(z));
        const int spos = spos_ + z;
        const bf16x8 (&qf)[4] = qf3[r];
        f32x4 s[8];
        { const LAS unsigned char* kbase = lds + fr * AT_ROWB + fq * 16 + z;
#pragma unroll
          for (int kb = 0; kb < 8; ++kb) { s[kb] = (f32x4){0.f, 0.f, 0.f, 0.f};
#pragma unroll
              for (int dc = 0; dc < 4; ++dc) { const bf16x8 kf = *(const LAS bf16x8*)(kbase + kb * 16 * AT_ROWB + dc * 64); s[kb] = __builtin_amdgcn_mfma_f32_16x16x32_bf16(kf, qf[dc], s[kb], 0, 0, 0); } } }
        float tmax = -INFINITY;
#pragma unroll
        for (int kb = 0; kb < 8; ++kb)
#pragma unroll
            for (int e = 0; e < 4; ++e) { const int n = 16 * kb + 4 * fq + e, dist = spos - (16 * n + 31); const bool valid = (dist >= 0) && (n < NCMP);
                const float x = valid ? (s[kb][e] * SCALE2 - slope2 * (float)dist) : -INFINITY; s[kb][e] = x; tmax = fmaxf(tmax, x); }
        tmax = fmaxf(tmax, __shfl_xor(tmax, 16)); tmax = fmaxf(tmax, __shfl_xor(tmax, 32));
        const float muse = (tmax == -INFINITY) ? 0.f : tmax;
        float lsum = 0.f;
#pragma unroll
        for (int kb = 0; kb < 8; ++kb)
#pragma unroll
            for (int e = 0; e < 4; ++e) { const float pv = __builtin_amdgcn_exp2f(s[kb][e] - muse); s[kb][e] = pv; lsum += pv; }
        lsum += __shfl_xor(lsum, 16); lsum += __shfl_xor(lsum, 32);
        const float inv = 1.0f / fmaxf(lsum, 1e-30f);
#pragma unroll
        for (int kb = 0; kb < 8; ++kb) s[kb] *= inv;
#pragma unroll
        for (int kb = 0; kb < 8; ++kb) { const float t1 = __shfl(s[kb][3], (lane - 16) & 63); const float t0v = kb > 0 ? __shfl(s[kb > 0 ? kb - 1 : 0][3], (lane - 16) & 63) : 0.f;
            imp[kb] += s[kb][0] + s[kb][1] + s[kb][2] + 0.5f * s[kb][3] + 0.5f * (fq == 0 ? t0v : t1); }
        f32x4 o[8];
#pragma unroll
        for (int db = 0; db < 8; ++db) o[db] = (f32x4){0.f, 0.f, 0.f, 0.f};
        { const LAS unsigned char* vbase = lds + 2 * AT_TILEB + (4 * fq + (fr >> 2)) * AT_ROWB + 8 * (fr & 3);
#pragma unroll
          for (int c = 0; c < 4; ++c) { const bf16x8 pf = pack8(s[2 * c], s[2 * c + 1]);
#pragma unroll
              for (int db = 0; db < 8; ++db) { const bf16x8 vf = tr_pair(vbase + c * 32 * AT_ROWB + db * 32, vbase + c * 32 * AT_ROWB + 16 * AT_ROWB + db * 32);
                  o[db] = __builtin_amdgcn_mfma_f32_16x16x32_bf16(vf, pf, o[db], 0, 0, 0); } } }
        at_store_o(ocmp + (size_t)(t0 + row) * 1536 + h * HD, o, 1.0f, fq);
    }
    LAS float* rk = (LAS float*)(lds + AT_AUX + wave * 2048) + fr * 32;
    float mine[8];
#pragma unroll
    for (int kb = 0; kb < 8; ++kb) { const int j = 4 * kb + fq; const bool forced = (j == 0) || (j == cur) || (j == cur - 1);
        mine[kb] = forced ? 1e4f : (j > cur ? -1e4f : imp[kb]); rk[j] = mine[kb]; }
    LDS_WAIT();
    int rank[8];
#pragma unroll
    for (int kb = 0; kb < 8; ++kb) rank[kb] = 0;
#pragma unroll
    for (int j4 = 0; j4 < 8; ++j4) { const f32x4 v = *(const LAS f32x4*)(rk + 4 * j4);
#pragma unroll
        for (int e = 0; e < 4; ++e) { const int jj = 4 * j4 + e;
#pragma unroll
            for (int kb = 0; kb < 8; ++kb) { const int j = 4 * kb + fq; rank[kb] += (v[e] > mine[kb] || (v[e] == mine[kb] && jj < j)) ? 1 : 0; } } }
    unsigned bits = 0u;
#pragma unroll
    for (int kb = 0; kb < 8; ++kb) { const int j = 4 * kb + fq; if (rank[kb] < 16 && j <= cur) bits |= 1u << j; }
    bits |= __shfl_xor(bits, 16); bits |= __shfl_xor(bits, 32);
    if (fq == 0) sel[(size_t)(t0 + row) * 4 + g] = bits;
    { unsigned wb = bits;
#pragma unroll
      for (int o_ = 1; o_ < 16; o_ <<= 1) wb |= __shfl_xor(wb, o_);
      LAS unsigned* wgw = (LAS unsigned*)(lds + AT_AUX + 8 * 2048);
      if (lane == 0) wgw[wave] = wb;
      __syncthreads();
      if (tid == 0) umw[(b * 4 + g) * 16 + qb] = wgw[0] | wgw[1] | wgw[2] | wgw[3] | wgw[4] | wgw[5] | wgw[6] | wgw[7]; }
}
__device__ __forceinline__ void nsa_window_wg(LAS unsigned char* lds, const bf16_t* proj, const bf16_t* kvs, bf16_t* cat, int b, int h, int qb, int tid_) {
    int tid = tid_; asm volatile("" : "+v"(tid));
    const int lane = tid & 63, wave = tid >> 6, fr = lane & 15, fq = lane >> 4, g = h / 3, t0 = b * SEQ + qb * 256;
    const bf16_t* kvb = kvs + (size_t)(b * 24 + g) * SEQ * HD;
    constexpr size_t KIND = (size_t)4 * SEQ * HD;
    AttnArgs Aw; Aw.q = proj + ((size_t)(b * 18 + h) * SEQ + qb * 256) * HD; Aw.qstride = HD; Aw.kvstride = HD; Aw.nkeys = SEQ; Aw.qpos0 = qb * 256; Aw.kmul = 1; Aw.nrows = 256;
    Aw.slope2 = exp2f(-8.0f * (float)(h + 1) / 12.0f) * LOG2E; Aw.k = kvb + 4 * KIND; Aw.v = kvb + 5 * KIND; Aw.maxdist = 511;
    { const int k0 = 4 * qb - 8 < 0 ? 0 : 4 * qb - 8, k1 = 4 * qb + 3; Aw.tilemask = (0xffffffffu >> (31 - k1)) & (0xffffffffu << k0); }
    const unsigned nosel[2] = {0u, 0u};
    f32x4 o[2][8]; float m[2], lsum[2]; attn_core<false>(lds, Aw, nosel, tid, o, m, lsum);
#pragma unroll
    for (int rb = 0; rb < 2; ++rb) at_store_o(cat + (size_t)(t0 + wave * 32 + rb * 16 + fr) * 2048 + h * HD, o[rb], 1.0f / fmaxf(lsum[rb], 1e-30f), fq);
}
__device__ __forceinline__ void nsa_select_wg(LAS unsigned char* lds, const bf16_t* proj, const bf16_t* kvs, const unsigned* sel, const unsigned* umw, const bf16_t* ocmp, bf16_t* cat, int b, int h, int qb, int tid_) {
    int tid = tid_; asm volatile("" : "+v"(tid));
    const int lane = tid & 63, wave = tid >> 6, fr = lane & 15, fq = lane >> 4, g = h / 3, t0 = b * SEQ + qb * 256;
    const unsigned umv = __hip_atomic_load(umw + (b * 4 + g) * 16 + 2 * qb, __ATOMIC_RELAXED, __HIP_MEMORY_SCOPE_AGENT) | __hip_atomic_load(umw + (b * 4 + g) * 16 + 2 * qb + 1, __ATOMIC_RELAXED, __HIP_MEMORY_SCOPE_AGENT);
    unsigned selmask[2];
#pragma unroll
    for (int rb = 0; rb < 2; ++rb) selmask[rb] = sel[(size_t)(t0 + wave * 32 + rb * 16 + fr) * 4 + g];
    const bf16_t* kvb = kvs + (size_t)(b * 24 + g) * SEQ * HD;
    constexpr size_t KIND = (size_t)4 * SEQ * HD;
    AttnArgs As; As.q = proj + ((size_t)(b * 18 + h) * SEQ + qb * 256) * HD; As.qstride = HD; As.kvstride = HD; As.nkeys = SEQ; As.qpos0 = qb * 256; As.kmul = 1; As.nrows = 256;
    As.slope2 = exp2f(-8.0f * (float)(h + 1) / 12.0f) * LOG2E; As.k = kvb + 2 * KIND; As.v = kvb + 3 * KIND; As.maxdist = 0x7fffffff;
    AttnPre Ps; attn_issue_q(As, tid, Ps);
    const unsigned um = (unsigned)__builtin_amdgcn_readfirstlane((int)umv);
    As.tilemask = um & (0xffffffffu >> (31 - (4 * qb + 3)));
    attn_issue_kv(As, tid, Ps);
    f32x4 o[2][8]; float m[2], lsum[2];
    attn_run<true>(lds, As, selmask, tid, Ps, o, m, lsum);
#pragma unroll
    for (int rb = 0; rb < 2; ++rb) { const int row = wave * 32 + rb * 16 + fr;
        const bf16_t* gp = proj + ((size_t)(b * 18 + 16) * SEQ + qb * 256 + row) * HD + h * 3;
        const float g0 = 1.0f / (1.0f + __expf(-bflo((unsigned)gp[0]))), g1 = 1.0f / (fmaxf(lsum[rb], 1e-30f) * (1.0f + __expf(-bflo((unsigned)gp[1])))), g2 = 1.0f / (1.0f + __expf(-bflo((unsigned)gp[2])));
        bf16_t* orow = cat + (size_t)(t0 + row) * 2048 + h * HD + 4 * fq; const bf16_t* crow = ocmp + (size_t)(t0 + row) * 1536 + h * HD + 4 * fq;
#pragma unroll
        for (int db = 0; db < 8; ++db) { const u32x2 c = *(const u32x2*)(crow + 16 * db), wv = *(const u32x2*)(orow + 16 * db);
            const float r0 = g0 * bflo(c.x) + g1 * o[rb][db][0] + g2 * bflo(wv.x), r1 = g0 * bfhi(c.x) + g1 * o[rb][db][1] + g2 * bfhi(wv.x);
            const float r2 = g0 * bflo(c.y) + g1 * o[rb][db][2] + g2 * bflo(wv.y), r3 = g0 * bfhi(c.y) + g1 * o[rb][db][3] + g2 * bfhi(wv.y);
            u32x2 w; w.x = pg8::cvt_pk_bf16(r0, r1); w.y = pg8::cvt_pk_bf16(r2, r3); *(u32x2*)(orow + 16 * db) = w; } }
}
__device__ __forceinline__ int opq_tid() { int t = threadIdx.x; asm volatile("" : "+v"(t)); return t; }
__global__ void __launch_bounds__(NTHREADS, 2) mega_fwd(Params p) {
    extern __shared__ __attribute__((aligned(16))) unsigned char lds_raw[];
    LAS unsigned char* lds = (LAS unsigned char*)lds_raw;
    cg::grid_group grid = cg::this_grid();
    const int tid = threadIdx.x, lane = tid & 63, wave = __builtin_amdgcn_readfirstlane(tid >> 6);
    const int G = gridDim.x, bid = blockIdx.x;
    volatile LAS unsigned* bst = (volatile LAS unsigned*)(lds + LDS_MAIN);
    if (tid < 2) bst[tid] = 0u;
    __syncthreads();
    const XcdBarrier gbar = xcd_barrier_post((unsigned*)(p.ws + WS_BAR), bst);
    grid.sync();
    const int gw = bid * NWAVES + wave, ngw = G * NWAVES;
    unsigned char* ws = p.ws;
    float* X = p.out;
    bf16_t* XH = (bf16_t*)(ws + WS_XH); bf16_t* PROJ = (bf16_t*)(ws + WS_PROJ); float* OBUF = (float*)(ws + WS_OBUF);
    bf16_t* CAT = (bf16_t*)(ws + WS_CAT); bf16_t* KVS = (bf16_t*)(ws + WS_KVS); bf16_t* MEMKV = (bf16_t*)(ws + WS_MEMKV); bf16_t* MEMHAT = (bf16_t*)(ws + WS_MEMHAT);
    bf16_t* OG = (bf16_t*)(ws + WS_KVS); float* LSE = (float*)(ws + WS_HID); unsigned* SEL = (unsigned*)(ws + WS_SEL); unsigned* UMW = (unsigned*)(ws + WS_UM); float* XS = (float*)(ws + WS_XS);
    bf16_t* OCMP = (bf16_t*)(ws + WS_OBUF);
    bf16_t* OBF = (bf16_t*)(ws + WS_OBUF + (size_t)NTOK * 2048 * 2);
    bf16_t* HID = (bf16_t*)(ws + WS_HID); bf16_t* KCV = (bf16_t*)(ws + WS_KCV); bf16_t* BLK = (bf16_t*)(ws + WS_OBUF);
    LAS float* wscr = (LAS float*)(lds + wave * 16384);

    unsigned long long tacc = 0, tst = 0;
#define TB(k) do { if (TPROBE == (k)) tst = __builtin_amdgcn_s_memrealtime(); } while (0)
#define TE(k) do { if (TPROBE == (k)) tacc += __builtin_amdgcn_s_memrealtime() - tst; } while (0)
    TB(1);
    for (int rep_ = 0; rep_ < REP_P0; ++rep_) {
        ConvJob J;
        for (int j = 0; conv_get(p, j, J); ++j) conv_run(J, wscr, gw, ngw, lane);
        for (int m = gw; m < 1024; m += ngw) rms_row(p.in[I_MEM] + (size_t)m * 2048, MEMHAT + (size_t)m * 2048, nullptr, lane);
        for (int m = gw; m < NTOK; m += ngw) rms_row(p.in[I_X] + (size_t)m * 2048, XH + (size_t)m * 2048, XS + m, lane);
    }
    for (int rs_ = 0; rs_ < REP_SYNC; ++rs_) xcd_barrier(gbar);
    TE(1);

    for (int l = 0; l < 4; ++l) {
        const bool isA = l < 2;
        for (int jb = 0; jb < 3; ++jb) {
            pg8::Gemm g; bf16_t* O; int ldc; int c = bid; int hm = 0, ssh = 11, spn = 1 << 20, hm2 = 0; bf16_t* O2 = nullptr;
            if (jb == 0) { g.A = XH; g.M = NTOK; g.K = 2048;
                if (isA) { g.Bt = (const bf16_t*)(ws + WS_WAIN + l * SZ_WAIN); g.N = A_COLS; O = PROJ; ldc = A_COLS; hm = 76; }
                else { g.Bt = (const bf16_t*)(ws + (l == 2 ? WS_WBIN : WS_WBIN1)); g.N = l == 2 ? B_COLS + 3072 : B_COLS; O = PROJ; ldc = B_COLS; hm = 18; if (l == 2) { spn = 9; O2 = KVS; hm2 = 24; } } }
            else if (jb == 1) { if (l != 0) continue; g.A = MEMHAT; g.Bt = (const bf16_t*)(ws + WS_WMEM); g.M = 1024; g.N = 4096; g.K = 2048; O = MEMKV; ldc = 4096; c = (bid + 64) % G; hm = 32; ssh = 8; }
            else continue;
            pg8::StaticOrder S; S.init(g.M, g.N, G, c);
            pg8::EpiBf16<0> E{O, ldc, hm, ssh, spn, O2, hm2};
            TB(2); for (int rep_ = 0; rep_ < REP_GEMM; ++rep_) pg8::gemm_phase(lds, g, S, E); TE(2);
        }
        for (int rs_ = 0; rs_ < REP_SYNC; ++rs_) xcd_barrier(gbar);
        auto b_queue = [&](const int ncs) {
            unsigned* qctr = (unsigned*)(p.ws + WS_BAR) + 3584 + 64 * l;
            LAS unsigned* qslot = (LAS unsigned*)(lds + AT_AUX + 8 * 2048 + 64);
            for (;;) {
                __syncthreads();
                if (opq_tid() == 0) qslot[0] = __hip_atomic_fetch_add(qctr, 1u, __ATOMIC_RELAXED, __HIP_MEMORY_SCOPE_AGENT);
                __syncthreads();
                int it = (int)qslot[0];
                if (it >= ncs + 512) break;
                if (it < ncs) { cmp_sel_wg(lds, PROJ, KCV, KCV + (size_t)2048 * 256, OCMP, SEL, UMW, it >> 6, (it >> 4) & 3, it & 15, opq_tid()); continue; }
                it -= ncs;
                if (it < 384) { const int qb = 7 - it / 48, j = it % 48; nsa_window_wg(lds, PROJ, KVS, CAT, j / 12, j % 12, qb, opq_tid()); }
                else { const int u = it - 384; mem_attn_wg(lds, PROJ, 18, 12, MEMKV, l, CAT, 2048, 1536, u >> 5, (u >> 3) & 3, u & 7, opq_tid()); }
            }
        };
        if (l == 2) {
            const int lane = opq_tid() & 63;
            for (int it = gw; it < 2 * 2048; it += ngw) {
                const int w = it >> 11, row = it & 2047; bf16_t* dst = BLK + ((size_t)w * 2048 + row) * 4096;
                if (row < NBATCH * NCMP * 4) { const int gg = row & 3, bn = row >> 2, bb = bn / NCMP, n = bn % NCMP;
                    const bf16_t* src = KVS + ((size_t)(bb * 24 + w * 4 + gg) * SEQ + 16 * n) * HD; const float* pe = p.in[I_PE] + w * 32 * HD;
                    for (int ll = 0; ll < 32; ++ll) { const unsigned v = *(const unsigned*)(src + (size_t)ll * HD + 2 * lane); const f32x2 e = *(const f32x2*)(pe + ll * HD + 2 * lane);
                        *(unsigned*)(dst + ll * HD + 2 * lane) = pk2(bflo(v) + e.x, bfhi(v) + e.y); } }
                else { for (int ll = 0; ll < 32; ++ll) *(unsigned*)(dst + ll * HD + 2 * lane) = 0u; }
            }
            for (int rs_ = 0; rs_ < REP_SYNC; ++rs_) xcd_barrier(gbar);
            for (int w = 0; w < 2; ++w) { pg8::Gemm g{BLK + (size_t)w * 2048 * 4096, (const bf16_t*)(ws + WS_WC1 + w * SZ_WC1), 2048, 512, 4096};
                pg8::StaticOrder S; S.init(2048, 512, G, (bid + 128 * w) % G); pg8::EpiBf16<1> E{HID + (size_t)w * 2048 * 512, 512, 0, 11, 1 << 20, nullptr, 0}; TB(2); for (int rep_ = 0; rep_ < REP_GEMM; ++rep_) pg8::gemm_phase(lds, g, S, E); TE(2); }
            b_queue(0);
            for (int rs_ = 0; rs_ < REP_SYNC; ++rs_) xcd_barrier(gbar);
            for (int w = 0; w < 2; ++w) { pg8::Gemm g{HID + (size_t)w * 2048 * 512, (const bf16_t*)(ws + WS_WC2 + w * SZ_WC2), 2048, 256, 512};
                pg8::StaticOrder S; S.init(2048, 256, G, (bid + 128 * w) % G); pg8::EpiBf16<0> E{KCV + (size_t)w * 2048 * 256, 256, 0, 11, 1 << 20, nullptr, 0}; TB(2); for (int rep_ = 0; rep_ < REP_GEMM; ++rep_) pg8::gemm_phase(lds, g, S, E); TE(2); }
            for (int rs_ = 0; rs_ < REP_SYNC; ++rs_) xcd_barrier(gbar);
        }
        if (isA) {
            {
                unsigned* qctr = (unsigned*)(p.ws + WS_BAR) + 3584 + 64 * l;
                LAS unsigned* qslot = (LAS unsigned*)(lds + AT_AUX + 8 * 2048 + 64);
                for (;;) {
                    __syncthreads();
                    if (opq_tid() == 0) qslot[0] = __hip_atomic_fetch_add(qctr, 1u, __ATOMIC_RELAXED, __HIP_MEMORY_SCOPE_AGENT);
                    __syncthreads();
                    const int it = (int)qslot[0];
                    if (it >= 1152) break;
                    if (it < 512) { const int gi = it >> 8, u = it & 255; dil_attn_wg(lds, PROJ, OG, LSE, u >> 6, gi * 8 + ((u >> 3) & 7), u & 7, opq_tid()); }
                    else if (it < 640) { const int u = it - 512; mem_attn_wg(lds, PROJ, 76, 72, MEMKV, l, CAT, 1536, 1024, u >> 5, (u >> 3) & 3, u & 7, opq_tid()); }
                    else { const int u = it - 640; dil_attn_wg(lds, PROJ, OG, LSE, u >> 7, 16 + ((u >> 4) & 7), u & 15, opq_tid()); }
                }
            }
            for (int rs_ = 0; rs_ < REP_SYNC; ++rs_) xcd_barrier(gbar);
            TE(3); TB(4);
            for (int rep_ = 0; rep_ < REP_ATT; ++rep_)
            for (int it = bid * NTHREADS + opq_tid(); it < NTOK * 8 * 16; it += G * NTHREADS) { const int c8 = it & 15, tj = it >> 4;
                const float l0 = LSE[tj], l1 = LSE[(size_t)NTOK * 8 + tj], l2 = LSE[(size_t)2 * NTOK * 8 + tj], mx = fmaxf(l0, fmaxf(l1, l2));
                float e0 = __expf(l0 - mx), e1 = __expf(l1 - mx), e2 = __expf(l2 - mx); const float inv = 1.0f / (e0 + e1 + e2); e0 *= inv; e1 *= inv; e2 *= inv;
                const u32x4 a = *(const u32x4*)(OG + (size_t)tj * 128 + 8 * c8), bq = *(const u32x4*)(OG + ((size_t)NTOK * 8 + tj) * 128 + 8 * c8), cq = *(const u32x4*)(OG + ((size_t)2 * NTOK * 8 + tj) * 128 + 8 * c8);
                u32x4 w;
                w.x = pk2(e0 * bflo(a.x) + e1 * bflo(bq.x) + e2 * bflo(cq.x), e0 * bfhi(a.x) + e1 * bfhi(bq.x) + e2 * bfhi(cq.x));
                w.y = pk2(e0 * bflo(a.y) + e1 * bflo(bq.y) + e2 * bflo(cq.y), e0 * bfhi(a.y) + e1 * bfhi(bq.y) + e2 * bfhi(cq.y));
                w.z = pk2(e0 * bflo(a.z) + e1 * bflo(bq.z) + e2 * bflo(cq.z), e0 * bfhi(a.z) + e1 * bfhi(bq.z) + e2 * bfhi(cq.z));
                w.w = pk2(e0 * bflo(a.w) + e1 * bflo(bq.w) + e2 * bflo(cq.w), e0 * bfhi(a.w) + e1 * bfhi(bq.w) + e2 * bfhi(cq.w));
                const int t = tj >> 3, j = tj & 7;
                *(u32x4*)(CAT + (size_t)t * 1536 + j * HD + 8 * c8) = w; }
        } else {
            TB(5);
            if (l == 2) { for (int it = bid; it < 256; it += G) cmp_sel_wg(lds, PROJ, KCV, KCV + (size_t)2048 * 256, OCMP, SEL, UMW, it >> 6, (it >> 4) & 3, it & 15, opq_tid()); }
            else b_queue(256);
            for (int rs_ = 0; rs_ < REP_SYNC; ++rs_) xcd_barrier(gbar);
            TE(5); TB(6);
            {
                unsigned* qctr = (unsigned*)(p.ws + WS_BAR) + 3840 + 64 * (l - 2);
                LAS unsigned* qslot = (LAS unsigned*)(lds + AT_AUX + 8 * 2048 + 64);
                for (;;) {
                    __syncthreads();
                    if (opq_tid() == 0) qslot[0] = __hip_atomic_fetch_add(qctr, 1u, __ATOMIC_RELAXED, __HIP_MEMORY_SCOPE_AGENT);
                    __syncthreads();
                    const int it = (int)qslot[0];
                    if (it >= 384) break;
                    const int qb = 7 - it / 48, j = it % 48; nsa_select_wg(lds, PROJ, KVS, SEL, UMW, OCMP, CAT, j / 12, j % 12, qb, opq_tid());
                }
            }
        }
        for (int rs_ = 0; rs_ < REP_SYNC; ++rs_) xcd_barrier(gbar);
        if (isA) TE(4); else TE(6);
        for (int hf = 0; hf < 2; ++hf) {
            if (hf == 1) { pg8::Gemm g{XH, (const bf16_t*)(ws + WS_WGU + l * SZ_WGU), NTOK, 11264, 2048}; pg8::StaticOrder S; S.init(NTOK, 11264, G, bid);
                pg8::EpiSwiGLU E{PROJ, DFF};
                if (STAGGER_US > 0 && bid >= 128) { const unsigned long long t0 = __builtin_amdgcn_s_memrealtime(); while (__builtin_amdgcn_s_memrealtime() - t0 < (unsigned long long)STAGGER_US * 100ull) __builtin_amdgcn_s_sleep(16); } TB(2); for (int rep_ = 0; rep_ < REP_GEMM; ++rep_) pg8::gemm_phase(lds, g, S, E); TE(2); for (int rs_ = 0; rs_ < REP_SYNC; ++rs_) xcd_barrier(gbar); }
            { pg8::Gemm g; g.M = NTOK; g.N = 2048;
              if (hf == 0) { g.A = CAT; g.K = isA ? 1536 : 2048; g.Bt = isA ? (const bf16_t*)(ws + WS_WAOUT + l * SZ_WAOUT) : (const bf16_t*)(ws + WS_WBOUT + (l - 2) * SZ_WBOUT); }
              else { g.A = PROJ; g.K = DFF; g.Bt = (const bf16_t*)(ws + WS_WDOWN + l * SZ_WDOWN); }
              pg8::StaticOrder S; S.init(NTOK, 2048, G, bid); pg8::EpiBf16<0> E{OBF, 2048, 0, 11, 1 << 20, nullptr, 0}; TB(2); for (int rep_ = 0; rep_ < REP_GEMM; ++rep_) pg8::gemm_phase(lds, g, S, E); TE(2); }
            for (int rs_ = 0; rs_ < REP_SYNC; ++rs_) xcd_barrier(gbar);
            const float* gain = p.in[I_NORMG] + (l * 5 + (hf == 0 ? 1 : 3)) * 2048;
            const bool fin = (l == 3 && hf == 1);
            for (int m = gw; m < NTOK; m += ngw) rowop_row(XH + (size_t)m * 2048, XS + m, OBF + (size_t)m * 2048, gain, fin ? X + (size_t)m * 2048 : nullptr, opq_tid() & 63);
            for (int rs_ = 0; rs_ < REP_SYNC; ++rs_) xcd_barrier(gbar);
        }
    }
    if (TPROBE && bid == 0) { const unsigned long long dt = tacc * 8ull, t0 = __builtin_amdgcn_s_memrealtime(); while (__builtin_amdgcn_s_memrealtime() - t0 < dt) __builtin_amdgcn_s_sleep(8); }
}

extern "C" void kernel_launch(void* const* d_in, const int* in_sizes, int n_in, void* d_out, int out_size, void* d_ws, size_t ws_size, hipStream_t stream) {
    static int grid_blocks = 0;
    if (grid_blocks == 0) {
        if (n_in != 17 || ws_size < WS_END) { fprintf(stderr, "kernel_launch: unexpected n_in %d or ws_size %zu (< %zu)\n", n_in, ws_size, (size_t)WS_END); grid_blocks = -1; return; }
        int dev = 0, cus = 0, per_cu = 0;
        hipGetDevice(&dev);
        hipDeviceGetAttribute(&cus, hipDeviceAttributeMultiprocessorCount, dev);
        hipFuncSetAttribute((const void*)mega_fwd, hipFuncAttributeMaxDynamicSharedMemorySize, LDS_BYTES);
        hipOccupancyMaxActiveBlocksPerMultiprocessor(&per_cu, (const void*)mega_fwd, NTHREADS, LDS_BYTES);
        if (per_cu < 1) per_cu = 1;
        if (per_cu > 1) per_cu = 1;
        grid_blocks = cus * per_cu;
        (void)hipGetLastError();
    }
    if (grid_blocks < 0) return;
    static Params p;
    memset(&p, 0, sizeof(p));
    for (int i = 0; i < 17; ++i) p.in[i] = (const float*)d_in[i];
    p.out = (float*)d_out; p.ws = (unsigned char*)d_ws;
    {
        int n = 0;
        auto add = [&](int in_idx, size_t in_off, int gain_idx, int gain_off, size_t dst_off, int ldw, int col0, int ncols, int K, int nrows, int mode) {
            JobDesc& d = p.jobs[n++]; d.in_idx = in_idx; d.in_off = in_off; d.gain_idx = gain_idx; d.gain_off = gain_off; d.dst_off = dst_off; d.ldw = ldw; d.col0 = col0; d.ncols = ncols; d.K = K; d.nrows = nrows; d.mode = mode; d.pad = 0; };
        for (int l = 0; l < 4; ++l) add(I_WGU, (size_t)l * 2048 * 11264, I_NORMG, (l * 5 + 2) * 2048, WS_WGU + l * SZ_WGU, 11264, 0, 11264, 2048, 11264, 1);
        for (int l = 0; l < 4; ++l) add(I_WDOWN, (size_t)l * 5632 * 2048, -1, 0, WS_WDOWN + l * SZ_WDOWN, 2048, 0, 2048, 5632, 2048, 0);
        for (int l = 0; l < 2; ++l) add(I_AWIN, (size_t)l * 2048 * A_COLS, I_NORMG, (l * 5 + 0) * 2048, WS_WAIN + l * SZ_WAIN, A_COLS, 0, A_COLS, 2048, A_COLS, 0);
        for (int l = 0; l < 2; ++l) add(I_AWOUT, (size_t)l * 1536 * 2048, -1, 0, WS_WAOUT + l * SZ_WAOUT, 2048, 0, 2048, 1536, 2048, 0);
        for (int lb = 0; lb < 2; ++lb) {
            const size_t src = (size_t)lb * 2048 * B_COLS_SRC, dst = lb == 0 ? WS_WBIN : WS_WBIN1; const int go = ((2 + lb) * 5 + 0) * 2048;
            add(I_BWIN, src, I_NORMG, go, dst, B_COLS_SRC, 0, 1536, 2048, 1536, 0);
            add(I_BWIN, src, I_NORMG, go, dst + (size_t)1536 * 2048 * 2, B_COLS_SRC, 1572, 512, 2048, 512, 0);
            add(I_BWIN, src, I_NORMG, go, dst + (size_t)2048 * 2048 * 2, B_COLS_SRC, 1536, 36, 2048, 256, 0);
        }
        for (int lb = 0; lb < 2; ++lb) add(I_BWOUT, (size_t)lb * 2048 * 2048, -1, 0, WS_WBOUT + lb * SZ_WBOUT, 2048, 0, 2048, 2048, 2048, 0);
        for (int l = 0; l < 4; ++l) add(I_MEMWKV, (size_t)l * 2048 * 1024, I_NORMG, (l * 5 + 4) * 2048, WS_WMEM + (size_t)l * 1024 * 2048 * 2, 1024, 0, 1024, 2048, 1024, 0);
        add(I_KVW, 0, I_KVNG, 0, WS_WKV, 3072, 0, 3072, 2048, 3072, 0);
        add(I_WK1, 0, -1, 0, WS_WC1, 512, 0, 512, 4096, 512, 0);
        add(I_WV1, 0, -1, 0, WS_WC1 + SZ_WC1, 512, 0, 512, 4096, 512, 0);
        add(I_WK2, 0, -1, 0, WS_WC2, 128, 0, 128, 512, 256, 0);
        add(I_WV2, 0, -1, 0, WS_WC2 + SZ_WC2, 128, 0, 128, 512, 256, 0);
        p.njobs = n;
    }
    (void)hipMemsetAsync((char*)d_ws + WS_BAR, 0, WS_BAR_BYTES, stream);
    void* args[] = {&p};
    hipError_t e = hipLaunchCooperativeKernel((const void*)mega_fwd, dim3(grid_blocks), dim3(NTHREADS), args, LDS_BYTES, stream);
    if (e != hipSuccess) fprintf(stderr, "cooperative launch failed: %s (grid %d)\n", hipGetErrorString(e), grid_blocks);
}
```

```cpp
#include <hip/hip_runtime.h>
#include <hip/hip_cooperative_groups.h>
#include <cstdio>
#include <cstring>
namespace cg = cooperative_groups;
#define REP_P0 1
#define REP_GEMM 1
#define REP_ATT 1
#define REP_ATTA 1
#define REP_B1 1
#define REP_B2 1
#define REP_SYNC 1
#define PROBE_ATT 0
#define TPROBE 0
#define STAGGER_US 0

#define LAS __attribute__((address_space(3)))
typedef unsigned short bf16_t;
typedef short bf16x8 __attribute__((ext_vector_type(8)));
typedef float f32x4 __attribute__((ext_vector_type(4)));
typedef float f32x2 __attribute__((ext_vector_type(2)));
typedef unsigned u32x4 __attribute__((ext_vector_type(4)));
typedef unsigned u32x2 __attribute__((ext_vector_type(2)));
typedef __bf16 bf16x2_t __attribute__((ext_vector_type(2)));

constexpr int D_MODEL = 2048, NTOK = 8192, SEQ = 2048, NBATCH = 4, DFF = 5632, HD = 128;
constexpr int A_COLS = 9728, B_COLS_SRC = 2084, B_COLS = 2304, NCMP = 127;
constexpr int NWAVES = 8, NTHREADS = 512;
constexpr int LDS_MAIN = 131072; constexpr int LDS_BYTES = LDS_MAIN + 64;

constexpr size_t SZ_WAIN = (size_t)A_COLS * 2048 * 2, SZ_WAOUT = (size_t)2048 * 1536 * 2, SZ_WBIN = (size_t)B_COLS * 2048 * 2, SZ_WBOUT = (size_t)2048 * 2048 * 2;
constexpr size_t SZ_WGU = (size_t)11264 * 2048 * 2, SZ_WDOWN = (size_t)2048 * 5632 * 2, SZ_WC1 = (size_t)512 * 4096 * 2, SZ_WC2 = (size_t)256 * 512 * 2;
constexpr size_t WS_WAIN = 0;
constexpr size_t WS_WAOUT = WS_WAIN + 2 * SZ_WAIN;
constexpr size_t WS_WBIN = WS_WAOUT + 2 * SZ_WAOUT;
constexpr size_t SZ_WKV = (size_t)3072 * 2048 * 2;
constexpr size_t WS_WKV = WS_WBIN + SZ_WBIN;
constexpr size_t WS_WBIN1 = WS_WKV + SZ_WKV;
constexpr size_t WS_WBOUT = WS_WBIN1 + SZ_WBIN;
constexpr size_t WS_WMEM = WS_WBOUT + 2 * SZ_WBOUT;
constexpr size_t WS_WGU = WS_WMEM + (size_t)4096 * 2048 * 2;
constexpr size_t WS_WDOWN = WS_WGU + 4 * SZ_WGU;
constexpr size_t WS_WC1 = WS_WDOWN + 4 * SZ_WDOWN;
constexpr size_t WS_WC2 = WS_WC1 + 2 * SZ_WC1;
constexpr size_t WS_PROJ = WS_WC2 + 2 * SZ_WC2;
constexpr size_t WS_OBUF = WS_PROJ + (size_t)NTOK * A_COLS * 2;
constexpr size_t WS_XH = WS_OBUF + (size_t)NTOK * 2048 * 4;
constexpr size_t WS_CAT = WS_XH + (size_t)NTOK * 2048 * 2;
constexpr size_t WS_KVS = WS_CAT + (size_t)NTOK * 2048 * 2;
constexpr size_t WS_MEMKV = WS_KVS + (size_t)NTOK * 3072 * 2;
constexpr size_t WS_MEMHAT = WS_MEMKV + (size_t)1024 * 4096 * 2;
constexpr size_t WS_HID = WS_MEMHAT + (size_t)1024 * 2048 * 2;
constexpr size_t WS_KCV = WS_HID + (size_t)2 * 2048 * 512 * 2;
constexpr size_t WS_SEL = WS_KCV + (size_t)2 * 2048 * 256 * 2;
constexpr size_t WS_XS = WS_SEL + (size_t)NTOK * 4 * 4;
constexpr size_t WS_UM = WS_XS + (size_t)NTOK * 4;
constexpr size_t WS_BAR = WS_UM + 4096;
constexpr size_t WS_BAR_BYTES = 16384;
constexpr size_t WS_END = WS_BAR + WS_BAR_BYTES;

#define LDS_WAIT() asm volatile("s_waitcnt lgkmcnt(0)" ::: "memory")
__device__ __forceinline__ unsigned f2bf(float f) { unsigned u = __builtin_bit_cast(unsigned, f); return (u + 0x7fffu + ((u >> 16) & 1u)) >> 16; }
__device__ __forceinline__ unsigned pk2(float lo, float hi) { const f32x2 v = {lo, hi}; return __builtin_bit_cast(unsigned, __builtin_convertvector(v, bf16x2_t)); }
__device__ __forceinline__ float bflo(unsigned w) { return __builtin_bit_cast(float, w << 16); }
__device__ __forceinline__ float bfhi(unsigned w) { return __builtin_bit_cast(float, w & 0xffff0000u); }
__device__ __forceinline__ float wave_sum(float v) {
#pragma unroll
    for (int o = 1; o < 64; o <<= 1) v += __shfl_xor(v, o);
    return v;
}
__device__ __forceinline__ float wave_max(float v) {
#pragma unroll
    for (int o = 1; o < 64; o <<= 1) v = fmaxf(v, __shfl_xor(v, o));
    return v;
}


#define XB_TMO      128
#define XB_XCNT(j)  (256  + 64 * (j))
#define XB_XSUB(j)  (1280 + 64 * (j))
#define XB_XGEN(j)  (2304 + 64 * (j))
#define XB_TOP      3328
#define XB_TOPGEN   3392
#define XCD_BAR_WORDS 3456
#define XB_SPIN_CAP (1u << 18)
__device__ __forceinline__ unsigned xb_ld(unsigned* p)              { return __hip_atomic_load(p, __ATOMIC_RELAXED, __HIP_MEMORY_SCOPE_AGENT); }
__device__ __forceinline__ unsigned xb_add(unsigned* p, unsigned v) { return __hip_atomic_fetch_add(p, v, __ATOMIC_RELAXED, __HIP_MEMORY_SCOPE_AGENT); }
__device__ __forceinline__ unsigned xb_xcc_id() { return (unsigned)__builtin_amdgcn_s_getreg((3 << 11) | 20) & 0xFu; }
#define XB_SPIN(cond, bar) do { unsigned _sp = 0; while (cond) { __builtin_amdgcn_s_sleep(1); \
    if ((++_sp & 255u) == 0u) { if (xb_ld(&(bar)[XB_TMO])) break; if (_sp > XB_SPIN_CAP) { atomicAdd(&(bar)[XB_TMO], 1u); break; } } } } while (0)
struct XcdBarrier { unsigned* bar; unsigned x; volatile LAS unsigned* st; };
__device__ __forceinline__ XcdBarrier xcd_barrier_post(unsigned* bar, volatile LAS unsigned* st) {
    XcdBarrier b; b.bar = bar; b.x = xb_xcc_id(); b.st = st;
    if (threadIdx.x == 0) (void)xb_add(&bar[XB_XCNT(b.x)], 1u);
    return b;
}
__device__ __forceinline__ void xcd_barrier_complete(unsigned* bar, unsigned x, unsigned& nloc, unsigned& nx) {
    const unsigned G = gridDim.x * gridDim.y * gridDim.z;
    unsigned sum, cnt, mine, sp = 0u;
    for (;;) {
        sum = 0u; cnt = 0u; mine = 0u;
#pragma unroll
        for (unsigned j = 0; j < 16; ++j) { const unsigned c = xb_ld(&bar[XB_XCNT(j)]); sum += c; cnt += (c > 0u) ? 1u : 0u; mine = (j == x) ? c : mine; }
        if (sum == G) break;
        __builtin_amdgcn_s_sleep(1);
        if ((++sp & 255u) == 0u) { if (xb_ld(&bar[XB_TMO])) break; if (sp > XB_SPIN_CAP) { atomicAdd(&bar[XB_TMO], 1u); break; } }
    }
    nloc = mine > 0u ? mine : 1u; nx = cnt > 0u ? cnt : 1u;
}
__device__ __forceinline__ void xcd_barrier(const XcdBarrier& b) {
    asm volatile("s_waitcnt vmcnt(0)" ::: "memory");
    __syncthreads();
    if (threadIdx.x == 0) {
        unsigned* bar = b.bar;
        __builtin_amdgcn_s_waitcnt(0);
        unsigned nloc = b.st[0], nx = b.st[1];
        if (nloc == 0u) { xcd_barrier_complete(bar, b.x, nloc, nx); b.st[0] = nloc; b.st[1] = nx; }
        const unsigned old = xb_add(&bar[XB_XSUB(b.x)], 1u);
        const unsigned gen = old / nloc;
        if (old + 1u == (gen + 1u) * nloc) {
            __builtin_amdgcn_fence(__ATOMIC_RELEASE, "agent");
            asm volatile("s_waitcnt vmcnt(0)" ::: "memory");
            const unsigned og = xb_add(&bar[XB_TOP], 1u);
            const unsigned tg = og / nx;
            if (og + 1u == (tg + 1u) * nx) xb_add(&bar[XB_TOPGEN], 1u);
            else XB_SPIN(xb_ld(&bar[XB_TOPGEN]) == tg, bar);
            __builtin_amdgcn_fence(__ATOMIC_ACQUIRE, "agent");
            xb_add(&bar[XB_XGEN(b.x)], 1u);
            asm volatile("s_waitcnt vmcnt(0)" ::: "memory");
        } else {
            XB_SPIN(xb_ld(&bar[XB_XGEN(b.x)]) == gen, bar);
            __builtin_amdgcn_fence(__ATOMIC_ACQUIRE, "agent");
            asm volatile("s_waitcnt vmcnt(0)" ::: "memory");
        }
    }
    __syncthreads();
}

namespace pg8 {
constexpr int BM = 256, BK = 64, HALF = 128, HTB = HALF * BK * 2, STAGE_BYTES = 8 * HTB, NXCD = 8, WGM = 8;
__device__ __forceinline__ int lds_byte(int r, int c) { const int st = (r >> 4) * 2 + (c >> 5), rr = r & 15, cc = c & 31, ob = rr * 64 + cc * 2; return st * 1024 + (ob ^ (((ob >> 9) & 1) << 5)); }
__device__ __forceinline__ void stage_rc(int b, int& R, int& C) { const int st = b / 1024, sb = b % 1024, swz = sb ^ (((sb >> 9) & 1) << 5); R = (st >> 1) * 16 + swz / 64; C = (st & 1) * 32 + (swz % 64) / 2; }
__device__ __forceinline__ int perm32(int rho) { const int n = rho >> 4, i = rho & 15; return 8 * (i >> 2) + 4 * n + (i & 3); }
struct Unit { int pm, pn; };
struct Gemm { const bf16_t* A; const bf16_t* Bt; int M, N, K; };
struct StaticOrder {
    int nM, nN, nwg, G, c;
    __device__ void init(int M, int N, int G_, int c_) { nM = M / BM; nN = N / BM; nwg = nM * nN; G = G_; c = c_; }
    __device__ bool next(int i, Unit& u) const {
        const long L = (long)i * G + c; if (L >= nwg) return false;
        int wgid = (int)L; { const int q = nwg / NXCD, r = nwg % NXCD, xcd = wgid % NXCD, off = wgid / NXCD; wgid = (xcd < r ? xcd * (q + 1) : r * (q + 1) + (xcd - r) * q) + off; }
        const int nig = WGM * nN, gid = wgid / nig, fm = gid * WGM, gsz = (nM - fm) < WGM ? (nM - fm) : WGM;
        u.pm = fm + ((wgid % nig) % gsz); u.pn = (wgid % nig) / gsz; return true;
    }
    __device__ __forceinline__ void a_ready(const Unit&) const {}
    __device__ __forceinline__ void done(const Unit&) const {}
};
__device__ __forceinline__ unsigned cvt_pk_bf16(float lo, float hi) { const f32x2 v = {lo, hi}; return __builtin_bit_cast(unsigned, __builtin_convertvector(v, bf16x2_t)); }

struct EpiF32 {
    static constexpr bool PERM = false;
    float* C; int ldc;
    __device__ __forceinline__ void operator()(const f32x4 (&acc)[2][2][4][2], const Unit& u, int wr, int wc, int fr, int fq) const {
        const int row0 = u.pm * BM + wr * 64 + fr, col0 = u.pn * BM + wc * 32 + 4 * fq;
#pragma unroll
        for (int ai = 0; ai < 2; ++ai)
#pragma unroll
            for (int m = 0; m < 4; ++m) { float* rowp = C + (size_t)(row0 + ai * HALF + m * 16) * ldc + col0;
#pragma unroll
                for (int bj = 0; bj < 2; ++bj)
#pragma unroll
                    for (int n = 0; n < 2; ++n) *(f32x4*)(rowp + bj * HALF + n * 16) = acc[ai][bj][m][n]; }
    }
};
__device__ __forceinline__ float gelu_tanh(float x) { const float t = 1.5957691216f * (x + 0.044715f * x * x * x); return x / (1.0f + __expf(-t)); }
template <int ACT  > struct EpiBf16 {
    static constexpr bool PERM = true;
    bf16_t* O; int ldc;
    int hm_heads, seq_shift; int split_pn; bf16_t* O2; int hm2;
    __device__ __forceinline__ void operator()(const f32x4 (&acc)[2][2][4][2], const Unit& u, int wr, int wc, int fr, int fq) const {
        const int row0 = u.pm * BM + wr * 64 + fr, col0 = u.pn * BM + wc * 32 + 8 * fq;
#pragma unroll
        for (int ai = 0; ai < 2; ++ai)
#pragma unroll
            for (int m = 0; m < 4; ++m) { const int row = row0 + ai * HALF + m * 16;
#pragma unroll
                for (int bj = 0; bj < 2; ++bj) { f32x4 v0 = acc[ai][bj][m][0], v1 = acc[ai][bj][m][1];
                    if (ACT == 1) {
#pragma unroll
                        for (int j = 0; j < 4; ++j) { v0[j] = gelu_tanh(v0[j]); v1[j] = gelu_tanh(v1[j]); } }
                    u32x4 w; w.x = cvt_pk_bf16(v0[0], v0[1]); w.y = cvt_pk_bf16(v0[2], v0[3]); w.z = cvt_pk_bf16(v1[0], v1[1]); w.w = cvt_pk_bf16(v1[2], v1[3]);
                    bf16_t* dst;
                    if (hm_heads > 0) { const bool second = u.pn >= split_pn; bf16_t* base = second ? O2 : O; const int nh = second ? hm2 : hm_heads;
                        const int col = col0 + bj * HALF - (second ? split_pn * BM : 0), b = row >> seq_shift, sq = row & ((1 << seq_shift) - 1);
                        dst = base + ((((size_t)(b * nh + (col >> 7))) << seq_shift) + sq) * 128 + (col & 127); }
                    else dst = O + (size_t)row * ldc + col0 + bj * HALF;
                    *(u32x4*)dst = w; } }
    }
};
struct EpiSwiGLU {
    static constexpr bool PERM = true;
    bf16_t* O; int ldc;
    __device__ __forceinline__ void operator()(const f32x4 (&acc)[2][2][4][2], const Unit& u, int wr, int wc, int fr, int fq) const {
        const int row0 = u.pm * BM + wr * 64 + fr, col0 = u.pn * HALF + wc * 32 + 8 * fq;
#pragma unroll
        for (int ai = 0; ai < 2; ++ai)
#pragma unroll
            for (int m = 0; m < 4; ++m) { bf16_t* rowp = O + (size_t)(row0 + ai * HALF + m * 16) * ldc + col0;
                f32x4 v0, v1;
#pragma unroll
                for (int j = 0; j < 4; ++j) { const float g0 = acc[ai][0][m][0][j], g1 = acc[ai][0][m][1][j];
                    v0[j] = g0 / (1.0f + __expf(-g0)) * acc[ai][1][m][0][j]; v1[j] = g1 / (1.0f + __expf(-g1)) * acc[ai][1][m][1][j]; }
                u32x4 w; w.x = cvt_pk_bf16(v0[0], v0[1]); w.y = cvt_pk_bf16(v0[2], v0[3]); w.z = cvt_pk_bf16(v1[0], v1[1]); w.w = cvt_pk_bf16(v1[2], v1[3]);
                *(u32x4*)rowp = w; }
    }
};

template <class Epi, class Sched>
__device__ __forceinline__ void gemm_phase(LAS unsigned char* lds, const Gemm g, const Sched& S, const Epi& E) {
    int tid_ = threadIdx.x; asm volatile("" : "+v"(tid_));
    const int tid = tid_, wid = __builtin_amdgcn_readfirstlane(tid >> 6), lane = tid & 63, wr = wid >> 2, wc = wid & 3, fr = lane & 15, fq = lane >> 4;
    const int K = g.K, nt = K / BK;
    unsigned voffA[2], voffB[2];
#pragma unroll
    for (int i = 0; i < 2; ++i) { int R, C; stage_rc(tid * 16 + i * 8192, R, C); const int Rb = Epi::PERM ? ((R & ~31) + perm32(R & 31)) : R;
        voffA[i] = (unsigned)(R * K + C) * 2u; voffB[i] = (unsigned)(Rb * K + C) * 2u; }
    const size_t kstep = (size_t)(BK * 2);
    const size_t hstep = (size_t)HALF * K * 2;
    const size_t tstep = 2 * hstep;
    const unsigned ldsw = (unsigned)wid * 1024u;
    const int aoff = lds_byte(wr * 64 + fr, fq * 8), boff = lds_byte(wc * 32 + fr, fq * 8);
#define PG8_SA(b, h) (((b) * 2 + (h)) * HTB)
#define PG8_SB(b, h) ((4 + (b) * 2 + (h)) * HTB)
#define PG8_STAGE(bufoff, gbase, voff) do { _Pragma("unroll") for (int _i = 0; _i < 2; ++_i) \
        __builtin_amdgcn_global_load_lds((const unsigned*)((const char*)(gbase) + (voff)[_i]), (LAS unsigned*)(lds + (bufoff) + ldsw + _i * 8192), 16, 0, 0); } while (0)
#define PG8_LDA(dst, b, h) do { _Pragma("unroll") for (int m = 0; m < 4; ++m) _Pragma("unroll") for (int k = 0; k < 2; ++k) dst[m][k] = *(const LAS bf16x8*)(lds + PG8_SA(b, h) + aoff + m * 2048 + k * 1024); } while (0)
#define PG8_LDB(dst, b, h) do { _Pragma("unroll") for (int n = 0; n < 2; ++n) _Pragma("unroll") for (int k = 0; k < 2; ++k) dst[n][k] = *(const LAS bf16x8*)(lds + PG8_SB(b, h) + boff + n * 2048 + k * 1024); } while (0)
#define PG8_MMA(ai, bj, At, Bt) do { __builtin_amdgcn_s_setprio(1); _Pragma("unroll") for (int m = 0; m < 4; ++m) _Pragma("unroll") for (int n = 0; n < 2; ++n) _Pragma("unroll") for (int k = 0; k < 2; ++k) \
        acc[ai][bj][m][n] = __builtin_amdgcn_mfma_f32_16x16x32_bf16(Bt[n][k], At[m][k], acc[ai][bj][m][n], 0, 0, 0); __builtin_amdgcn_s_setprio(0); } while (0)
#define PG8_WAIT_V(n) asm volatile("s_waitcnt vmcnt(" #n ")" ::: "memory")
#define PG8_WAIT_L(n) asm volatile("s_waitcnt lgkmcnt(" #n ")" ::: "memory")
#define PG8_BAR __builtin_amdgcn_s_barrier()
#define PG8_SCHED __builtin_amdgcn_sched_barrier(0)
    Unit cur, nxt; int ui = 0;
    if (!S.next(0, cur)) return;
    f32x4 acc[2][2][4][2];
#pragma unroll
    for (int a = 0; a < 2; ++a)
#pragma unroll
        for (int b = 0; b < 2; ++b)
#pragma unroll
            for (int m = 0; m < 4; ++m)
#pragma unroll
                for (int n = 0; n < 2; ++n) acc[a][b][m][n] = (f32x4){0.f, 0.f, 0.f, 0.f};
    bf16x8 At[4][2], B0[2][2], B1[2][2];
    const char* cA = (const char*)g.A + (size_t)cur.pm * tstep; const char* cB = (const char*)g.Bt + (size_t)cur.pn * tstep;
    S.a_ready(cur);
    PG8_STAGE(PG8_SB(0, 0), cB, voffB); PG8_STAGE(PG8_SA(0, 0), cA, voffA); PG8_STAGE(PG8_SB(0, 1), cB + hstep, voffB); PG8_STAGE(PG8_SA(0, 1), cA + hstep, voffA);
    if (wr == 1) PG8_BAR;
    PG8_WAIT_V(4); PG8_BAR;
    PG8_STAGE(PG8_SB(1, 0), cB + kstep, voffB); PG8_STAGE(PG8_SA(1, 0), cA + kstep, voffA); PG8_STAGE(PG8_SB(1, 1), cB + hstep + kstep, voffB);
    PG8_WAIT_V(6); PG8_BAR;
    for (;;) {
        const bool has_next = S.next(ui + 1, nxt);
        const char* nA = has_next ? (const char*)g.A + (size_t)nxt.pm * tstep : cA; const char* nB = has_next ? (const char*)g.Bt + (size_t)nxt.pn * tstep : cB;
        for (int t = 0; t < nt; t += 2) {
            const bool last = (t == nt - 2);
            const char* a1 = cA + (size_t)(t + 1) * kstep;
            const char* a2 = last ? nA : cA + (size_t)(t + 2) * kstep; const char* b2 = last ? nB : cB + (size_t)(t + 2) * kstep;
            const char* a3 = a2 + kstep; const char* b3 = b2 + kstep;
            if (last && has_next) S.a_ready(nxt);
            PG8_LDB(B0, 0, 0); PG8_SCHED; PG8_LDA(At, 0, 0); PG8_STAGE(PG8_SA(1, 1), a1 + hstep, voffA);
            PG8_WAIT_L(8); PG8_BAR; PG8_WAIT_L(0); PG8_MMA(0, 0, At, B0); PG8_BAR; PG8_SCHED;
            PG8_LDB(B1, 0, 1); PG8_STAGE(PG8_SB(0, 0), b2, voffB);
            PG8_BAR; PG8_WAIT_L(0); PG8_MMA(0, 1, At, B1); PG8_BAR;
            PG8_LDA(At, 0, 1); PG8_STAGE(PG8_SA(0, 0), a2, voffA);
            PG8_BAR; PG8_WAIT_L(0); PG8_MMA(1, 0, At, B0); PG8_BAR; PG8_SCHED;
            PG8_STAGE(PG8_SB(0, 1), b2 + hstep, voffB);
            PG8_WAIT_V(6); PG8_BAR; PG8_MMA(1, 1, At, B1); PG8_BAR;
            PG8_LDB(B0, 1, 0); PG8_SCHED; PG8_LDA(At, 1, 0); PG8_STAGE(PG8_SA(0, 1), a2 + hstep, voffA);
            PG8_WAIT_L(8); PG8_BAR; PG8_WAIT_L(0); PG8_MMA(0, 0, At, B0); PG8_BAR; PG8_SCHED;
            PG8_LDB(B1, 1, 1); PG8_STAGE(PG8_SB(1, 0), b3, voffB);
            PG8_BAR; PG8_WAIT_L(0); PG8_MMA(0, 1, At, B1); PG8_BAR;
            PG8_LDA(At, 1, 1); PG8_STAGE(PG8_SA(1, 0), a3, voffA);
            PG8_BAR; PG8_WAIT_L(0); PG8_MMA(1, 0, At, B0); PG8_BAR; PG8_SCHED;
            PG8_STAGE(PG8_SB(1, 1), b3 + hstep, voffB);
            PG8_WAIT_V(6); PG8_BAR; PG8_MMA(1, 1, At, B1); PG8_BAR;
        }
        E(acc, cur, wr, wc, fr, fq); S.done(cur);
        if (!has_next) break;
#pragma unroll
        for (int a = 0; a < 2; ++a)
#pragma unroll
            for (int b = 0; b < 2; ++b)
#pragma unroll
                for (int m = 0; m < 4; ++m)
#pragma unroll
                    for (int n = 0; n < 2; ++n) acc[a][b][m][n] = (f32x4){0.f, 0.f, 0.f, 0.f};
        cur = nxt; cA = nA; cB = nB; ++ui;
    }
    PG8_WAIT_V(0);
    if (wr == 0) PG8_BAR;
    PG8_BAR;
#undef PG8_SA
#undef PG8_SB
#undef PG8_STAGE
#undef PG8_LDA
#undef PG8_LDB
#undef PG8_MMA
#undef PG8_WAIT_V
#undef PG8_WAIT_L
#undef PG8_BAR
#undef PG8_SCHED
}
}

struct JobDesc { unsigned long long in_off, dst_off; int in_idx, gain_idx, gain_off, ldw, col0, ncols, K, nrows, mode, pad; };
constexpr int MAXJOBS = 32;
struct Params { const float* in[17]; float* out; unsigned char* ws; JobDesc jobs[MAXJOBS]; int njobs, pad; };
enum { I_X = 0, I_MEM, I_NORMG, I_AWIN, I_AWOUT, I_BWIN, I_BWOUT, I_MEMWKV, I_WGU, I_WDOWN, I_KVNG, I_KVW, I_PE, I_WK1, I_WK2, I_WV1, I_WV2 };

struct ConvJob { const float* W; const float* gain; bf16_t* dst; int ldw, col0, ncols, K, nrows, mode, tag; };
__device__ __forceinline__ bool conv_get(const Params& p, int j, ConvJob& J) {
    if (j >= p.njobs) return false;
    const JobDesc& d = p.jobs[j];
    J.W = p.in[d.in_idx] + d.in_off; J.gain = d.gain_idx >= 0 ? p.in[d.gain_idx] + d.gain_off : nullptr; J.dst = (bf16_t*)(p.ws + d.dst_off);
    J.ldw = d.ldw; J.col0 = d.col0; J.ncols = d.ncols; J.K = d.K; J.nrows = d.nrows; J.mode = d.mode; J.tag = d.pad;
    return true;
}
__device__ __forceinline__ void conv_load(const ConvJob& J, int it, int nblk, int lane, f32x4 (&v)[16]) {
    const int kb = it / nblk, nb = it - kb * nblk, k0 = 64 * kb, n = 64 * nb + 4 * (lane & 15), kr = lane >> 4;
    const bool ok = n < J.ncols;
    const int sc = J.mode == 1 ? (((n >> 7) & 1) * 5632 + (n >> 8) * 128 + (n & 127)) : (J.col0 + n);
    const float* src = J.W + (size_t)(k0 + kr) * J.ldw + sc;
#pragma unroll
    for (int i = 0; i < 16; ++i) v[i] = ok ? __builtin_nontemporal_load((const f32x4*)(src + (size_t)(4 * i) * J.ldw)) : (f32x4){0.f, 0.f, 0.f, 0.f};
}
__device__ __forceinline__ void conv_emit(const ConvJob& J, LAS float* scr, int it, int nblk, int lane, const f32x4 (&cur)[16]) {
    const int c4 = lane & 15, kr = lane >> 4, nb8 = lane >> 3, c = lane & 7;
    const int kb = it / nblk, nb = it - kb * nblk, k0 = 64 * kb, n0 = 64 * nb;
#pragma unroll
    for (int i = 0; i < 16; ++i) *(LAS f32x4*)(scr + (kr + 4 * i) * 64 + ((c4 ^ (i >> 1)) << 2)) = cur[i];
    LDS_WAIT();
    f32x4 g0 = {1.f, 1.f, 1.f, 1.f}, g1 = {1.f, 1.f, 1.f, 1.f};
    if (J.gain) { g0 = *(const f32x4*)(J.gain + k0 + 8 * c); g1 = *(const f32x4*)(J.gain + k0 + 8 * c + 4); }
#pragma unroll
    for (int j = 0; j < 8; ++j) { const int n = nb8 + 8 * j; const LAS float* t = scr + (8 * c) * 64 + ((((n >> 2) ^ c) << 2) | (n & 3));
        u32x4 o; o.x = pk2(t[0 * 64] * g0[0], t[1 * 64] * g0[1]); o.y = pk2(t[2 * 64] * g0[2], t[3 * 64] * g0[3]); o.z = pk2(t[4 * 64] * g1[0], t[5 * 64] * g1[1]); o.w = pk2(t[6 * 64] * g1[2], t[7 * 64] * g1[3]);
        *(u32x4*)(J.dst + (size_t)(n0 + n) * J.K + k0 + 8 * c) = o; }
    LDS_WAIT();
}
__device__ __forceinline__ void conv_run(const ConvJob& J, LAS float* scr, int gw, int ngw, int lane) {
    const int nblk = J.nrows / 64, kblk = J.K / 64, items = nblk * kblk;
    f32x4 bufA[16], bufB[16];
    int it = gw;
    if (it < items) conv_load(J, it, nblk, lane, bufA);
    while (it < items) {
        if (it + ngw < items) conv_load(J, it + ngw, nblk, lane, bufB);
        conv_emit(J, scr, it, nblk, lane, bufA);
        it += ngw; if (it >= items) break;
        if (it + ngw < items) conv_load(J, it + ngw, nblk, lane, bufA);
        conv_emit(J, scr, it, nblk, lane, bufB);
        it += ngw;
    }
}

__device__ __forceinline__ void rms_row(const float* xrow, bf16_t* orow, float* scale_out, int lane) {
    const f32x4* xr = (const f32x4*)xrow + lane;
    f32x4 v[8]; float s = 0.f;
#pragma unroll
    for (int j = 0; j < 8; ++j) { v[j] = xr[64 * j]; s += (v[j].x * v[j].x + v[j].y * v[j].y) + (v[j].z * v[j].z + v[j].w * v[j].w); }
    const float ms = wave_sum(s) * (1.f / 2048.f) + 1e-6f, rs = rsqrtf(ms);
    u32x2* o8 = (u32x2*)orow + lane;
#pragma unroll
    for (int j = 0; j < 8; ++j) { u32x2 w; w.x = pk2(v[j].x * rs, v[j].y * rs); w.y = pk2(v[j].z * rs, v[j].w * rs); o8[64 * j] = w; }
    if (scale_out && lane == 0) *scale_out = sqrtf(ms);
}
__device__ __forceinline__ void rowop_row(bf16_t* hrow, float* scale, const bf16_t* orow, const float* gain, float* outrow, int lane) {
    const u32x2* o2 = (const u32x2*)orow + lane; u32x2* h2 = (u32x2*)hrow + lane; const f32x4* g4 = (const f32x4*)gain + lane;
    const float sc = *scale;
    f32x4 o[8]; float s = 0.f;
#pragma unroll
    for (int j = 0; j < 8; ++j) { const u32x2 w = o2[64 * j]; o[j] = (f32x4){bflo(w.x), bfhi(w.x), bflo(w.y), bfhi(w.y)}; s += (o[j].x * o[j].x + o[j].y * o[j].y) + (o[j].z * o[j].z + o[j].w * o[j].w); }
    const float rs = rsqrtf(wave_sum(s) * (1.f / 2048.f) + 1e-6f);
    float s2 = 0.f;
#pragma unroll
    for (int j = 0; j < 8; ++j) { const f32x4 g = g4[64 * j]; const u32x2 w = h2[64 * j]; f32x4 x = (f32x4){bflo(w.x), bfhi(w.x), bflo(w.y), bfhi(w.y)} * sc; x = x + o[j] * rs * g; o[j] = x; s2 += (x.x * x.x + x.y * x.y) + (x.z * x.z + x.w * x.w); }
    if (outrow) { f32x4* x4 = (f32x4*)outrow + lane;
#pragma unroll
        for (int j = 0; j < 8; ++j) x4[64 * j] = o[j];
        return; }
    const float ms2 = wave_sum(s2) * (1.f / 2048.f) + 1e-6f, rs2 = rsqrtf(ms2);
#pragma unroll
    for (int j = 0; j < 8; ++j) { u32x2 w; w.x = pk2(o[j].x * rs2, o[j].y * rs2); w.y = pk2(o[j].z * rs2, o[j].w * rs2); h2[64 * j] = w; }
    if (lane == 0) *scale = sqrtf(ms2);
}

typedef short s16x4 __attribute__((ext_vector_type(4)));
constexpr int AT_ROWB = 272, AT_TILEB = 64 * AT_ROWB, AT_STAGEB = 2 * AT_TILEB;
constexpr int AT_AUX = 2 * AT_STAGEB;
constexpr float SCALE2 = 0.12751743f;
constexpr float LOG2E = 1.4426950408889634f, LN2 = 0.6931471805599453f;
struct AttnArgs {
    const bf16_t* q; size_t qstride;
    const bf16_t* k; const bf16_t* v; size_t kvstride;
    unsigned tilemask;
    int nkeys, qpos0, kmul, maxdist;
    float slope2;
    int nrows;
};
__device__ __forceinline__ void at_gload(const AttnArgs& A, int kt, int tid, u32x4 (&kr)[2], u32x4 (&vr)[2]) {
#pragma unroll
    for (int i = 0; i < 2; ++i) { const int id = tid + 512 * i, row = id >> 4, c16 = id & 15; const size_t off = (size_t)(64 * kt + row) * A.kvstride + 8 * c16;
        kr[i] = *(const u32x4*)(A.k + off); vr[i] = *(const u32x4*)(A.v + off); }
}
__device__ __forceinline__ void at_lstore(LAS unsigned char* st, int tid, const u32x4 (&kr)[2], const u32x4 (&vr)[2]) {
#pragma unroll
    for (int i = 0; i < 2; ++i) { const int id = tid + 512 * i, row = id >> 4, c16 = id & 15;
        *(LAS u32x4*)(st + row * AT_ROWB + c16 * 16) = kr[i];
        const int prow = (row & ~12) | (((row >> 2) & 1) << 3) | (((row >> 3) & 1) << 2), swz = ((prow & 3) << 2) | ((prow >> 2) & 3);
        *(LAS u32x4*)(st + AT_TILEB + prow * 256 + ((c16 ^ swz) << 4)) = vr[i]; }
}
__device__ __forceinline__ bf16x8 pack8(const f32x4& a, const f32x4& b) {
    u32x4 w; w.x = pg8::cvt_pk_bf16(a[0], a[1]); w.y = pg8::cvt_pk_bf16(a[2], a[3]); w.z = pg8::cvt_pk_bf16(b[0], b[1]); w.w = pg8::cvt_pk_bf16(b[2], b[3]);
    return __builtin_bit_cast(bf16x8, w);
}
__device__ __forceinline__ bf16x8 tr_pair(const LAS unsigned char* p0, const LAS unsigned char* p1) {
    const s16x4 lo = __builtin_amdgcn_ds_read_tr16_b64_v4i16((LAS s16x4*)p0), hi = __builtin_amdgcn_ds_read_tr16_b64_v4i16((LAS s16x4*)p1);
    return __builtin_shufflevector(lo, hi, 0, 1, 2, 3, 4, 5, 6, 7);
}
struct AttnPre { bf16x8 qf[2][4]; u32x4 kA[2], vA[2], kB[2], vB[2]; };
__device__ __forceinline__ void attn_issue_q(const AttnArgs& A, int tid, AttnPre& P) {
    const int lane = tid & 63, wave = tid >> 6, fr = lane & 15, fq = lane >> 4;
#pragma unroll
    for (int rb = 0; rb < 2; ++rb) { const bf16_t* qp = A.q + (size_t)(wave * 32 + rb * 16 + fr) * A.qstride + 8 * fq;
#pragma unroll
        for (int dc = 0; dc < 4; ++dc) P.qf[rb][dc] = *(const bf16x8*)(qp + 32 * dc); }
}
__device__ __forceinline__ void attn_issue_kv(const AttnArgs& A, int tid, AttnPre& P) {
    unsigned tm = A.tilemask;
    if (tm == 0u) return;
    const int k0 = 31 - __builtin_clz(tm); tm &= ~(1u << k0);
    at_gload(A, k0, tid, P.kA, P.vA);
    if (tm) { const int k1 = 31 - __builtin_clz(tm); at_gload(A, k1, tid, P.kB, P.vB); }
}
template <bool USE_SEL>
__device__ __forceinline__ void attn_run(LAS unsigned char* lds, const AttnArgs& A, const unsigned (&selmask)[2], int tid, AttnPre& P, f32x4 (&o)[2][8], float (&m)[2], float (&l)[2]) {
    const int lane = tid & 63, wave = __builtin_amdgcn_readfirstlane(tid >> 6), fr = lane & 15, fq = lane >> 4;
    bf16x8 (&qf)[2][4] = P.qf;
#pragma unroll
    for (int rb = 0; rb < 2; ++rb) { m[rb] = -INFINITY; l[rb] = 0.f;
#pragma unroll
        for (int db = 0; db < 8; ++db) o[rb][db] = (f32x4){0.f, 0.f, 0.f, 0.f}; }
    unsigned tm = A.tilemask;
    if (tm == 0u) return;
    const int wr0 = 32 * wave, wq0 = A.qpos0 + wr0;
    const int qp0 = A.qpos0 + wr0 + fr;
    const bool nomask = A.kmul == 0;
    auto tile = [&](const int kt, const LAS unsigned char* st) {
        if (wr0 >= A.nrows) return;
        const int dlo = wq0 - 64 * kt - 63, dhi = wq0 + 31 - 64 * kt;
        bool tsel[2]; tsel[0] = USE_SEL ? (((selmask[0] >> kt) & 1u) != 0u) : true; tsel[1] = USE_SEL ? (((selmask[1] >> kt) & 1u) != 0u) : true;
        if (!nomask && (dhi < 0 || dlo > A.maxdist || (USE_SEL && !__any(tsel[0] || tsel[1])))) return;
        const bool interior = nomask || (dlo >= 0 && dhi <= A.maxdist && (!USE_SEL || __all(tsel[0] && tsel[1])));
        f32x4 s[2][4];
        { const LAS unsigned char* kbase = st + fr * AT_ROWB + fq * 16;
#pragma unroll
          for (int kb = 0; kb < 4; ++kb) { s[0][kb] = (f32x4){0.f, 0.f, 0.f, 0.f}; s[1][kb] = (f32x4){0.f, 0.f, 0.f, 0.f};
#pragma unroll
              for (int dc = 0; dc < 4; ++dc) { const bf16x8 kf = *(const LAS bf16x8*)(kbase + kb * 16 * AT_ROWB + dc * 64);
                  s[0][kb] = __builtin_amdgcn_mfma_f32_16x16x32_bf16(kf, qf[0][dc], s[0][kb], 0, 0, 0); s[1][kb] = __builtin_amdgcn_mfma_f32_16x16x32_bf16(kf, qf[1][dc], s[1][kb], 0, 0, 0); } } }
        float muse[2];
        bool moved = false;
#pragma unroll
        for (int rb = 0; rb < 2; ++rb) {
            const int D0r = qp0 + 16 * rb - 64 * kt - 4 * fq, D0 = (USE_SEL && !tsel[rb]) ? -(1 << 30) : D0r;
            const float B0 = nomask ? 0.f : -A.slope2 * (float)D0r;
            float tmax = -INFINITY;
            if (interior) {
#pragma unroll
                for (int kb = 0; kb < 4; ++kb)
#pragma unroll
                    for (int e = 0; e < 4; ++e) { const float x = fmaf(s[rb][kb][e], SCALE2, fmaf(A.slope2, (float)(16 * kb + e), B0)); s[rb][kb][e] = x; tmax = fmaxf(tmax, x); }
            } else {
#pragma unroll
                for (int kb = 0; kb < 4; ++kb)
#pragma unroll
                    for (int e = 0; e < 4; ++e) { const bool valid = (unsigned)(D0 - (16 * kb + e)) <= (unsigned)A.maxdist;
                        const float x = valid ? fmaf(s[rb][kb][e], SCALE2, fmaf(A.slope2, (float)(16 * kb + e), B0)) : -INFINITY; s[rb][kb][e] = x; tmax = fmaxf(tmax, x); }
            }
            tmax = fmaxf(tmax, __shfl_xor(tmax, 16)); tmax = fmaxf(tmax, __shfl_xor(tmax, 32));
            const float mnew = fmaxf(m[rb], tmax); muse[rb] = (mnew == -INFINITY) ? 0.f : mnew;
            moved = moved || (mnew != m[rb]);
            if (!__all(mnew == m[rb])) {
                const float alpha = __builtin_amdgcn_exp2f(m[rb] - muse[rb]);
                l[rb] *= alpha;
#pragma unroll
                for (int db = 0; db < 8; ++db) o[rb][db] *= alpha;
            }
            m[rb] = mnew;
#pragma unroll
            for (int kb = 0; kb < 4; ++kb)
#pragma unroll
                for (int e = 0; e < 4; ++e) { const float pv = __builtin_amdgcn_exp2f(s[rb][kb][e] - muse[rb]); s[rb][kb][e] = pv; l[rb] += pv; }
        }
        (void)moved;
        const int vq = fr >> 2, vp = fr & 3, vS = (vq << 2) | (2 * (fq & 1) + (fq >> 1)), vx0 = ((vp >> 1) ^ vS) & 1, vS14 = vS & 14;
        const LAS unsigned char* vbase = st + AT_TILEB + 256 * (8 * (fq & 1) + 4 * (fq >> 1) + vq) + 8 * (vp & 1);
#pragma unroll
        for (int c = 0; c < 2; ++c) { const bf16x8 pf0 = pack8(s[0][2 * c], s[0][2 * c + 1]), pf1 = pack8(s[1][2 * c], s[1][2 * c + 1]);
#pragma unroll
            for (int db = 0; db < 8; ++db) { const int co = (((2 * db) ^ vS14) | vx0) << 4; const bf16x8 vf = tr_pair(vbase + c * 32 * 256 + co, vbase + (c * 32 + 16) * 256 + co);
                o[0][db] = __builtin_amdgcn_mfma_f32_16x16x32_bf16(vf, pf0, o[0][db], 0, 0, 0); o[1][db] = __builtin_amdgcn_mfma_f32_16x16x32_bf16(vf, pf1, o[1][db], 0, 0, 0); } }
    };
    u32x4 (&krA)[2] = P.kA; u32x4 (&vrA)[2] = P.vA; u32x4 (&krB)[2] = P.kB; u32x4 (&vrB)[2] = P.vB;
    int k0 = 31 - __builtin_clz(tm); tm &= ~(1u << k0);
    int k1 = -1; if (tm) { k1 = 31 - __builtin_clz(tm); tm &= ~(1u << k1); }
    at_lstore(lds, tid, krA, vrA); __syncthreads();
    for (;;) {
        int k2 = -1; if (tm) { k2 = 31 - __builtin_clz(tm); tm &= ~(1u << k2); }
        if (k2 >= 0) at_gload(A, k2, tid, krA, vrA);
        tile(k0, lds);
        if (k1 >= 0) at_lstore(lds + AT_STAGEB, tid, krB, vrB);
        __syncthreads();
        if (k1 < 0) break;
        int k3 = -1; if (tm) { k3 = 31 - __builtin_clz(tm); tm &= ~(1u << k3); }
        if (k3 >= 0) at_gload(A, k3, tid, krB, vrB);
        tile(k1, lds + AT_STAGEB);
        if (k2 >= 0) at_lstore(lds, tid, krA, vrA);
        __syncthreads();
        if (k2 < 0) break;
        k0 = k2; k1 = k3;
    }
#pragma unroll
    for (int rb = 0; rb < 2; ++rb) { l[rb] += __shfl_xor(l[rb], 16); l[rb] += __shfl_xor(l[rb], 32); }
}
template <bool USE_SEL>
__device__ __forceinline__ void attn_core(LAS unsigned char* lds, const AttnArgs& A, const unsigned (&selmask)[2], int tid, f32x4 (&o)[2][8], float (&m)[2], float (&l)[2]) {
    AttnPre P; attn_issue_q(A, tid, P); attn_issue_kv(A, tid, P); attn_run<USE_SEL>(lds, A, selmask, tid, P, o, m, l);
}
__device__ __forceinline__ void at_store_o(bf16_t* orow, const f32x4 (&o)[8], float inv, int fq) {
#pragma unroll
    for (int db = 0; db < 8; ++db) { u32x2 w; w.x = pg8::cvt_pk_bf16(o[db][0] * inv, o[db][1] * inv); w.y = pg8::cvt_pk_bf16(o[db][2] * inv, o[db][3] * inv); *(u32x2*)(orow + 16 * db + 4 * fq) = w; }
}
__device__ __forceinline__ void mem_args(AttnArgs& A, const bf16_t* proj, int nh, int mq0, const bf16_t* memkv, int l, int b, int h, int qb) {
    A.q = proj + ((size_t)(b * nh + mq0 + h) * SEQ + qb * 256) * HD; A.qstride = HD; A.k = memkv + (size_t)(b * 32 + l * 8 + h) * 256 * HD; A.v = A.k + (size_t)4 * 256 * HD; A.kvstride = HD;
    A.tilemask = 0xFu; A.nkeys = 256; A.qpos0 = 1 << 20; A.kmul = 0; A.maxdist = 0x7fffffff; A.slope2 = 0.f; A.nrows = 256;
}
__device__ __forceinline__ void mem_attn_wg(LAS unsigned char* lds, const bf16_t* proj, int nh, int mq0, const bf16_t* memkv, int l, bf16_t* cat, int ldc, int memoff, int b, int h, int qb, int tid_) {
    int tid = tid_; asm volatile("" : "+v"(tid));
    AttnArgs A; mem_args(A, proj, nh, mq0, memkv, l, b, h, qb);
    const unsigned nosel[2] = {0u, 0u};
    f32x4 o[2][8]; float m[2], lsum[2]; attn_core<false>(lds, A, nosel, tid, o, m, lsum);
    const int lane = tid & 63, t0 = b * SEQ + qb * 256;
#pragma unroll
    for (int rb = 0; rb < 2; ++rb) { const int row = (tid >> 6) * 32 + rb * 16 + (lane & 15);
        at_store_o(cat + (size_t)(t0 + row) * ldc + memoff + h * HD, o[rb], 1.0f / fmaxf(lsum[rb], 1e-30f), lane >> 4); }
}
__device__ __forceinline__ void dil_attn_wg(LAS unsigned char* lds, const bf16_t* proj, bf16_t* og, float* lse, int b, int hh, int x, int tid_) {
    int tid = tid_; asm volatile("" : "+v"(tid));
    const int gi = hh >> 3, j = hh & 7, d = gi == 0 ? 1 : (gi == 1 ? 4 : 16), L = SEQ / d, nqb = gi == 0 ? 8 : (gi == 1 ? 2 : 1), r = x / nqb, qb = x % nqb, c0 = qb * 256;
    const float slope = exp2f(-8.0f * (float)(hh + 1) / 24.0f);
    AttnArgs A; A.q = proj + ((size_t)(b * 76 + hh) * SEQ + c0 * d + r) * HD; A.qstride = (size_t)d * HD;
    A.k = proj + ((size_t)(b * 76 + 24 + hh) * SEQ + r) * HD; A.v = A.k + (size_t)24 * SEQ * HD; A.kvstride = (size_t)d * HD;
    { const int ktc = c0 >> 6, k0 = ktc - 2 < 0 ? 0 : ktc - 2, kend = (ktc + 4 < L / 64 ? ktc + 4 : L / 64) - 1; A.tilemask = (0xffffffffu >> (31 - kend)) & (0xffffffffu << k0); }
    A.nkeys = L; A.qpos0 = c0; A.kmul = 1; A.maxdist = 128; A.slope2 = slope * (float)d * LOG2E; A.nrows = L - c0 < 256 ? L - c0 : 256;
    const unsigned nosel[2] = {0u, 0u};
    f32x4 o[2][8]; float m[2], lsum[2]; attn_core<false>(lds, A, nosel, tid, o, m, lsum);
    const int lane = tid & 63, fr = lane & 15, fq = lane >> 4;
#pragma unroll
    for (int rb = 0; rb < 2; ++rb) { const int row = (tid >> 6) * 32 + rb * 16 + fr;
        if (row < A.nrows) { const size_t t = (size_t)b * SEQ + (size_t)(c0 + row) * d + r;
            at_store_o(og + ((size_t)gi * NTOK + t) * 1024 + j * HD, o[rb], 1.0f / fmaxf(lsum[rb], 1e-30f), fq);
            if (fq == 0) lse[((size_t)gi * NTOK + t) * 8 + j] = m[rb] * LN2 + __logf(fmaxf(lsum[rb], 1e-30f)); } }
}
__device__ __forceinline__ void cmp_sel_wg(LAS unsigned char* lds, const bf16_t* proj, const bf16_t* kc, const bf16_t* vc, bf16_t* ocmp, unsigned* sel, unsigned* umw, int b, int g, int qb, int tid_) {
    int tid = tid_; asm volatile("" : "+v"(tid));
    const int lane = tid & 63, wave = tid >> 6, fr = lane & 15, fq = lane >> 4, row = wave * 16 + fr, t0 = b * SEQ + qb * 128, spos_ = qb * 128 + row, cur = spos_ >> 6;
    bf16x8 qf3[3][4];
#pragma unroll
    for (int r = 0; r < 3; ++r) { const bf16_t* qp = proj + ((size_t)(b * 18 + 3 * g + r) * SEQ + qb * 128 + row) * HD + 8 * fq;
#pragma unroll
        for (int dc = 0; dc < 4; ++dc) qf3[r][dc] = *(const bf16x8*)(qp + 32 * dc); }
#pragma unroll
    for (int i = 0; i < 4; ++i) { const int id = tid + 512 * i, n = id >> 4, c16 = id & 15; const size_t off = ((size_t)(b * NCMP + n) * 4 + g) * 256 + 8 * c16;
        *(LAS u32x4*)(lds + n * AT_ROWB + c16 * 16) = *(const u32x4*)(kc + off); *(LAS u32x4*)(lds + 2 * AT_TILEB + n * AT_ROWB + c16 * 16) = *(const u32x4*)(vc + off); }
    __syncthreads();
    float imp[8];
#pragma unroll
    for (int kb = 0; kb < 8; ++kb) imp[kb] = 0.f;
#pragma unroll
    for (int r = 0; r < 3; ++r) {
        const int h = 3 * g + r; const float slope2 = exp2f(-8.0f * (float)(h + 1) / 12.0f) * LOG2E;
        int z = 0; asm volatile("" : "+v"(z));
        const int spos = spos_ + z;
        const bf16x8 (&qf)[4] = qf3[r];
        f32x4 s[8];
        { const LAS unsigned char* kbase = lds + fr * AT_ROWB + fq * 16 + z;
#pragma unroll
          for (int kb = 0; kb < 8; ++kb) { s[kb] = (f32x4){0.f, 0.f, 0.f, 0.f};
#pragma unroll
              for (int dc = 0; dc < 4; ++dc) { const bf16x8 kf = *(const LAS bf16x8*)(kbase + kb * 16 * AT_ROWB + dc * 64); s[kb] = __builtin_amdgcn_mfma_f32_16x16x32_bf16(kf, qf[dc], s[kb], 0, 0, 0); } } }
        float tmax = -INFINITY;
#pragma unroll
        for (int kb = 0; kb < 8; ++kb)
#pragma unroll
            for (int e = 0; e < 4; ++e) { const int n = 16 * kb + 4 * fq + e, dist = spos - (16 * n + 31); const bool valid = (dist >= 0) && (n < NCMP);
                const float x = valid ? (s[kb][e] * SCALE2 - slope2 * (float)dist) : -INFINITY; s[kb][e] = x; tmax = fmaxf(tmax, x); }
        tmax = fmaxf(tmax, __shfl_xor(tmax, 16)); tmax = fmaxf(tmax, __shfl_xor(tmax, 32));
        const float muse = (tmax == -INFINITY) ? 0.f : tmax;
        float lsum = 0.f;
#pragma unroll
        for (int kb = 0; kb < 8; ++kb)
#pragma unroll
            for (int e = 0; e < 4; ++e) { const float pv = __builtin_amdgcn_exp2f(s[kb][e] - muse); s[kb][e] = pv; lsum += pv; }
        lsum += __shfl_xor(lsum, 16); lsum += __shfl_xor(lsum, 32);
        const float inv = 1.0f / fmaxf(lsum, 1e-30f);
#pragma unroll
        for (int kb = 0; kb < 8; ++kb) s[kb] *= inv;
#pragma unroll
        for (int kb = 0; kb < 8; ++kb) { const float t1 = __shfl(s[kb][3], (lane - 16) & 63); const float t0v = kb > 0 ? __shfl(s[kb > 0 ? kb - 1 : 0][3], (lane - 16) & 63) : 0.f;
            imp[kb] += s[kb][0] + s[kb][1] + s[kb][2] + 0.5f * s[kb][3] + 0.5f * (fq == 0 ? t0v : t1); }
        f32x4 o[8];
#pragma unroll
        for (int db = 0; db < 8; ++db) o[db] = (f32x4){0.f, 0.f, 0.f, 0.f};
        { const LAS unsigned char* vbase = lds + 2 * AT_TILEB + (4 * fq + (fr >> 2)) * AT_ROWB + 8 * (fr & 3);
#pragma unroll
          for (int c = 0; c < 4; ++c) { const bf16x8 pf = pack8(s[2 * c], s[2 * c + 1]);
#pragma unroll
              for (int db = 0; db < 8; ++db) { const bf16x8 vf = tr_pair(vbase + c * 32 * AT_ROWB + db * 32, vbase + c * 32 * AT_ROWB + 16 * AT_ROWB + db * 32);
                  o[db] = __builtin_amdgcn_mfma_f32_16x16x32_bf16(vf, pf, o[db], 0, 0, 0); } } }
        at_store_o(ocmp + (size_t)(t0 + row) * 1536 + h * HD, o, 1.0f, fq);
    }
    LAS float* rk = (LAS float*)(lds + AT_AUX + wave * 2048) + fr * 32;
    float mine[8];
#pragma unroll
    for (int kb = 0; kb < 8; ++kb) { const int j = 4 * kb + fq; const bool forced = (j == 0) || (j == cur) || (j == cur - 1);
        mine[kb] = forced ? 1e4f : (j > cur ? -1e4f : imp[kb]); rk[j] = mine[kb]; }
    LDS_WAIT();
    int rank[8];
#pragma unroll
    for (int kb = 0; kb < 8; ++kb) rank[kb] = 0;
#pragma unroll
    for (int j4 = 0; j4 < 8; ++j4) { const f32x4 v = *(const LAS f32x4*)(rk + 4 * j4);
#pragma unroll
        for (int e = 0; e < 4; ++e) { const int jj = 4 * j4 + e;
#pragma unroll
            for (int kb = 0; kb < 8; ++kb) { const int j = 4 * kb + fq; rank[kb] += (v[e] > mine[kb] || (v[e] == mine[kb] && jj < j)) ? 1 : 0; } } }
    unsigned bits = 0u;
#pragma unroll
    for (int kb = 0; kb < 8; ++kb) { const int j = 4 * kb + fq; if (rank[kb] < 16 && j <= cur) bits |= 1u << j; }
    bits |= __shfl_xor(bits, 16); bits |= __shfl_xor(bits, 32);
    if (fq == 0) sel[(size_t)(t0 + row) * 4 + g] = bits;
    { unsigned wb = bits;
#pragma unroll
      for (int o_ = 1; o_ < 16; o_ <<= 1) wb |= __shfl_xor(wb, o_);
      LAS unsigned* wgw = (LAS unsigned*)(lds + AT_AUX + 8 * 2048);
      if (lane == 0) wgw[wave] = wb;
      __syncthreads();
      if (tid == 0) umw[(b * 4 + g) * 16 + qb] = wgw[0] | wgw[1] | wgw[2] | wgw[3] | wgw[4] | wgw[5] | wgw[6] | wgw[7]; }
}
__device__ __forceinline__ void nsa_window_wg(LAS unsigned char* lds, const bf16_t* proj, const bf16_t* kvs, bf16_t* cat, int b, int h, int qb, int tid_) {
    int tid = tid_; asm volatile("" : "+v"(tid));
    const int lane = tid & 63, wave = tid >> 6, fr = lane & 15, fq = lane >> 4, g = h / 3, t0 = b * SEQ + qb * 256;
    const bf16_t* kvb = kvs + (size_t)(b * 24 + g) * SEQ * HD;
    constexpr size_t KIND = (size_t)4 * SEQ * HD;
    AttnArgs Aw; Aw.q = proj + ((size_t)(b * 18 + h) * SEQ + qb * 256) * HD; Aw.qstride = HD; Aw.kvstride = HD; Aw.nkeys = SEQ; Aw.qpos0 = qb * 256; Aw.kmul = 1; Aw.nrows = 256;
    Aw.slope2 = exp2f(-8.0f * (float)(h + 1) / 12.0f) * LOG2E; Aw.k = kvb + 4 * KIND; Aw.v = kvb + 5 * KIND; Aw.maxdist = 511;
    { const int k0 = 4 * qb - 8 < 0 ? 0 : 4 * qb - 8, k1 = 4 * qb + 3; Aw.tilemask = (0xffffffffu >> (31 - k1)) & (0xffffffffu << k0); }
    const unsigned nosel[2] = {0u, 0u};
    f32x4 o[2][8]; float m[2], lsum[2]; attn_core<false>(lds, Aw, nosel, tid, o, m, lsum);
#pragma unroll
    for (int rb = 0; rb < 2; ++rb) at_store_o(cat + (size_t)(t0 + wave * 32 + rb * 16 + fr) * 2048 + h * HD, o[rb], 1.0f / fmaxf(lsum[rb], 1e-30f), fq);
}
__device__ __forceinline__ void nsa_select_wg(LAS unsigned char* lds, const bf16_t* proj, const bf16_t* kvs, const unsigned* sel, const unsigned* umw, const bf16_t* ocmp, bf16_t* cat, int b, int h, int qb, int tid_) {
    int tid = tid_; asm volatile("" : "+v"(tid));
    const int lane = tid & 63, wave = tid >> 6, fr = lane & 15, fq = lane >> 4, g = h / 3, t0 = b * SEQ + qb * 256;
    const unsigned umv = __hip_atomic_load(umw + (b * 4 + g) * 16 + 2 * qb, __ATOMIC_RELAXED, __HIP_MEMORY_SCOPE_AGENT) | __hip_atomic_load(umw + (b * 4 + g) * 16 + 2 * qb + 1, __ATOMIC_RELAXED, __HIP_MEMORY_SCOPE_AGENT);
    unsigned selmask[2];
#pragma unroll
    for (int rb = 0; rb < 2; ++rb) selmask[rb] = sel[(size_t)(t0 + wave * 32 + rb * 16 + fr) * 4 + g];
    const bf16_t* kvb = kvs + (size_t)(b * 24 + g) * SEQ * HD;
    constexpr size_t KIND = (size_t)4 * SEQ * HD;
    AttnArgs As; As.q = proj + ((size_t)(b * 18 + h) * SEQ + qb * 256) * HD; As.qstride = HD; As.kvstride = HD; As.nkeys = SEQ; As.qpos0 = qb * 256; As.kmul = 1; As.nrows = 256;
    As.slope2 = exp2f(-8.0f * (float)(h + 1) / 12.0f) * LOG2E; As.k = kvb + 2 * KIND; As.v = kvb + 3 * KIND; As.maxdist = 0x7fffffff;
    AttnPre Ps; attn_issue_q(As, tid, Ps);
    const unsigned um = (unsigned)__builtin_amdgcn_readfirstlane((int)umv);
    As.tilemask = um & (0xffffffffu >> (31 - (4 * qb + 3)));
    attn_issue_kv(As, tid, Ps);
    f32x4 o[2][8]; float m[2], lsum[2];
    attn_run<true>(lds, As, selmask, tid, Ps, o, m, lsum);
#pragma unroll
    for (int rb = 0; rb < 2; ++rb) { const int row = wave * 32 + rb * 16 + fr;
        const bf16_t* gp = proj + ((size_t)(b * 18 + 16) * SEQ + qb * 256 + row) * HD + h * 3;
        const float g0 = 1.0f / (1.0f + __expf(-bflo((unsigned)gp[0]))), g1 = 1.0f / (fmaxf(lsum[rb], 1e-30f) * (1.0f + __expf(-bflo((unsigned)gp[1])))), g2 = 1.0f / (1.0f + __expf(-bflo((unsigned)gp[2])));
        bf16_t* orow = cat + (size_t)(t0 + row) * 2048 + h * HD + 4 * fq; const bf16_t* crow = ocmp + (size_t)(t0 + row) * 1536 + h * HD + 4 * fq;
#pragma unroll
        for (int db = 0; db < 8; ++db) { const u32x2 c = *(const u32x2*)(crow + 16 * db), wv = *(const u32x2*)(orow + 16 * db);
            const float r0 = g0 * bflo(c.x) + g1 * o[rb][db][0] + g2 * bflo(wv.x), r1 = g0 * bfhi(c.x) + g1 * o[rb][db][1] + g2 * bfhi(wv.x);
            const float r2 = g0 * bflo(c.y) + g1 * o[rb][db][2] + g2 * bflo(wv.y), r3 = g0 * bfhi(c.y) + g1 * o[rb][db][3] + g2 * bfhi(wv.y);
            u32x2 w; w.x = pg8::cvt_pk_bf16(r0, r1); w.y = pg8::cvt_pk_bf16(r2, r3); *(u32x2*)(orow + 16 * db) = w; } }
}
__device__ __forceinline__ int opq_tid() { int t = threadIdx.x; asm volatile("" : "+v"(t)); return t; }
__global__ void __launch_bounds__(NTHREADS, 2) mega_fwd(Params p) {
    extern __shared__ __attribute__((aligned(16))) unsigned char lds_raw[];
    LAS unsigned char* lds = (LAS unsigned char*)lds_raw;
    cg::grid_group grid = cg::this_grid();
    const int tid = threadIdx.x, lane = tid & 63, wave = __builtin_amdgcn_readfirstlane(tid >> 6);
    const int G = gridDim.x, bid = blockIdx.x;
    volatile LAS unsigned* bst = (volatile LAS unsigned*)(lds + LDS_MAIN);
    if (tid < 2) bst[tid] = 0u;
    __syncthreads();
    const XcdBarrier gbar = xcd_barrier_post((unsigned*)(p.ws + WS_BAR), bst);
    grid.sync();
    const int gw = bid * NWAVES + wave, ngw = G * NWAVES;
    unsigned char* ws = p.ws;
    float* X = p.out;
    bf16_t* XH = (bf16_t*)(ws + WS_XH); bf16_t* PROJ = (bf16_t*)(ws + WS_PROJ); float* OBUF = (float*)(ws + WS_OBUF);
    bf16_t* CAT = (bf16_t*)(ws + WS_CAT); bf16_t* KVS = (bf16_t*)(ws + WS_KVS); bf16_t* MEMKV = (bf16_t*)(ws + WS_MEMKV); bf16_t* MEMHAT = (bf16_t*)(ws + WS_MEMHAT);
    bf16_t* OG = (bf16_t*)(ws + WS_KVS); float* LSE = (float*)(ws + WS_HID); unsigned* SEL = (unsigned*)(ws + WS_SEL); unsigned* UMW = (unsigned*)(ws + WS_UM); float* XS = (float*)(ws + WS_XS);
    bf16_t* OCMP = (bf16_t*)(ws + WS_OBUF);
    bf16_t* OBF = (bf16_t*)(ws + WS_OBUF + (size_t)NTOK * 2048 * 2);
    bf16_t* HID = (bf16_t*)(ws + WS_HID); bf16_t* KCV = (bf16_t*)(ws + WS_KCV); bf16_t* BLK = (bf16_t*)(ws + WS_OBUF);
    LAS float* wscr = (LAS float*)(lds + wave * 16384);

    unsigned long long tacc = 0, tst = 0;
#define TB(k) do { if (TPROBE == (k)) tst = __builtin_amdgcn_s_memrealtime(); } while (0)
#define TE(k) do { if (TPROBE == (k)) tacc += __builtin_amdgcn_s_memrealtime() - tst; } while (0)
    TB(1);
    for (int rep_ = 0; rep_ < REP_P0; ++rep_) {
        ConvJob J;
        for (int j = 0; conv_get(p, j, J); ++j) if (J.tag == 0 || G != 256) conv_run(J, wscr, gw, ngw, lane);
        for (int m = gw; m < 1024; m += ngw) rms_row(p.in[I_MEM] + (size_t)m * 2048, MEMHAT + (size_t)m * 2048, nullptr, lane);
        for (int m = gw; m < NTOK; m += ngw) rms_row(p.in[I_X] + (size_t)m * 2048, XH + (size_t)m * 2048, XS + m, lane);
    }
    for (int rs_ = 0; rs_ < REP_SYNC; ++rs_) xcd_barrier(gbar);
    TE(1);

    for (int l = 0; l < 4; ++l) {
        const bool isA = l < 2;
        for (int jb = 0; jb < 3; ++jb) {
            pg8::Gemm g; bf16_t* O; int ldc; int c = bid; int hm = 0, ssh = 11, spn = 1 << 20, hm2 = 0; bf16_t* O2 = nullptr;
            if (jb == 0) { g.A = XH; g.M = NTOK; g.K = 2048;
                if (isA) { g.Bt = (const bf16_t*)(ws + WS_WAIN + l * SZ_WAIN); g.N = A_COLS; O = PROJ; ldc = A_COLS; hm = 76; }
                else { g.Bt = (const bf16_t*)(ws + (l == 2 ? WS_WBIN : WS_WBIN1)); g.N = l == 2 ? B_COLS + 3072 : 2048; O = PROJ; ldc = B_COLS; hm = 18; if (l == 2) { spn = 9; O2 = KVS; hm2 = 24; } } }
            else if (jb == 1) { if (l != 0) continue; g.A = MEMHAT; g.Bt = (const bf16_t*)(ws + WS_WMEM); g.M = 1024; g.N = 4096; g.K = 2048; O = MEMKV; ldc = 4096; c = (bid + 64) % G; hm = 32; ssh = 8; }
            else continue;
            pg8::StaticOrder S; S.init(g.M, g.N, G, c);
            pg8::EpiBf16<0> E{O, ldc, hm, ssh, spn, O2, hm2};
            TB(2); for (int rep_ = 0; rep_ < REP_GEMM; ++rep_) pg8::gemm_phase(lds, g, S, E); TE(2);
        }
        for (int rs_ = 0; rs_ < REP_SYNC; ++rs_) xcd_barrier(gbar);
        auto b_queue = [&](const int ncs) {
            unsigned* qctr = (unsigned*)(p.ws + WS_BAR) + 3584 + 64 * l;
            LAS unsigned* qslot = (LAS unsigned*)(lds + AT_AUX + 8 * 2048 + 64);
            for (;;) {
                __syncthreads();
                if (opq_tid() == 0) qslot[0] = __hip_atomic_fetch_add(qctr, 1u, __ATOMIC_RELAXED, __HIP_MEMORY_SCOPE_AGENT);
                __syncthreads();
                int it = (int)qslot[0];
                if (it >= ncs + 512) break;
                if (it < ncs) { cmp_sel_wg(lds, PROJ, KCV, KCV + (size_t)2048 * 256, OCMP, SEL, UMW, it >> 6, (it >> 4) & 3, it & 15, opq_tid()); continue; }
                it -= ncs;
                if (it < 384) { const int qb = 7 - it / 48, j = it % 48; nsa_window_wg(lds, PROJ, KVS, CAT, j / 12, j % 12, qb, opq_tid()); }
                else { const int u = it - 384; mem_attn_wg(lds, PROJ, 18, 12, MEMKV, l, CAT, 2048, 1536, u >> 5, (u >> 3) & 3, u & 7, opq_tid()); }
            }
        };
        if (l == 2) {
            const int lane = opq_tid() & 63;
            for (int it = gw; it < 2 * 2048; it += ngw) {
                const int w = it >> 11, row = it & 2047; bf16_t* dst = BLK + ((size_t)w * 2048 + row) * 4096;
                if (row < NBATCH * NCMP * 4) { const int gg = row & 3, bn = row >> 2, bb = bn / NCMP, n = bn % NCMP;
                    const bf16_t* src = KVS + ((size_t)(bb * 24 + w * 4 + gg) * SEQ + 16 * n) * HD; const float* pe = p.in[I_PE] + w * 32 * HD;
                    for (int ll = 0; ll < 32; ++ll) { const unsigned v = *(const unsigned*)(src + (size_t)ll * HD + 2 * lane); const f32x2 e = *(const f32x2*)(pe + ll * HD + 2 * lane);
                        *(unsigned*)(dst + ll * HD + 2 * lane) = pk2(bflo(v) + e.x, bfhi(v) + e.y); } }
                else { for (int ll = 0; ll < 32; ++ll) *(unsigned*)(dst + ll * HD + 2 * lane) = 0u; }
            }
            for (int rs_ = 0; rs_ < REP_SYNC; ++rs_) xcd_barrier(gbar);
            for (int w = 0; w < 2; ++w) { pg8::Gemm g{BLK + (size_t)w * 2048 * 4096, (const bf16_t*)(ws + WS_WC1 + w * SZ_WC1), 2048, 512, 4096};
                pg8::StaticOrder S; S.init(2048, 512, G, (bid + 128 * w) % G); pg8::EpiBf16<1> E{HID + (size_t)w * 2048 * 512, 512, 0, 11, 1 << 20, nullptr, 0}; TB(2); for (int rep_ = 0; rep_ < REP_GEMM; ++rep_) pg8::gemm_phase(lds, g, S, E); TE(2); }
            b_queue(0);
            for (int rs_ = 0; rs_ < REP_SYNC; ++rs_) xcd_barrier(gbar);
            for (int w = 0; w < 2; ++w) { pg8::Gemm g{HID + (size_t)w * 2048 * 512, (const bf16_t*)(ws + WS_WC2 + w * SZ_WC2), 2048, 256, 512};
                pg8::StaticOrder S; S.init(2048, 256, G, (bid + 128 * w) % G); pg8::EpiBf16<0> E{KCV + (size_t)w * 2048 * 256, 256, 0, 11, 1 << 20, nullptr, 0}; TB(2); for (int rep_ = 0; rep_ < REP_GEMM; ++rep_) pg8::gemm_phase(lds, g, S, E); TE(2); }
            for (int rs_ = 0; rs_ < REP_SYNC; ++rs_) xcd_barrier(gbar);
        }
        if (isA) {
            {
                unsigned* qctr = (unsigned*)(p.ws + WS_BAR) + 3584 + 64 * l;
                LAS unsigned* qslot = (LAS unsigned*)(lds + AT_AUX + 8 * 2048 + 64);
                for (;;) {
                    __syncthreads();
                    if (opq_tid() == 0) qslot[0] = __hip_atomic_fetch_add(qctr, 1u, __ATOMIC_RELAXED, __HIP_MEMORY_SCOPE_AGENT);
                    __syncthreads();
                    const int it = (int)qslot[0];
                    if (it >= 1152) break;
                    if (it < 512) { const int gi = it >> 8, u = it & 255; dil_attn_wg(lds, PROJ, OG, LSE, u >> 6, gi * 8 + ((u >> 3) & 7), u & 7, opq_tid()); }
                    else if (it < 640) { const int u = it - 512; mem_attn_wg(lds, PROJ, 76, 72, MEMKV, l, CAT, 1536, 1024, u >> 5, (u >> 3) & 3, u & 7, opq_tid()); }
                    else { const int u = it - 640; dil_attn_wg(lds, PROJ, OG, LSE, u >> 7, 16 + ((u >> 4) & 7), u & 15, opq_tid()); }
                }
            }
            for (int rs_ = 0; rs_ < REP_SYNC; ++rs_) xcd_barrier(gbar);
            TE(3); TB(4);
            for (int rep_ = 0; rep_ < REP_ATT; ++rep_)
            for (int it = bid * NTHREADS + opq_tid(); it < NTOK * 8 * 16; it += G * NTHREADS) { const int c8 = it & 15, tj = it >> 4;
                const float l0 = LSE[tj], l1 = LSE[(size_t)NTOK * 8 + tj], l2 = LSE[(size_t)2 * NTOK * 8 + tj], mx = fmaxf(l0, fmaxf(l1, l2));
                float e0 = __expf(l0 - mx), e1 = __expf(l1 - mx), e2 = __expf(l2 - mx); const float inv = 1.0f / (e0 + e1 + e2); e0 *= inv; e1 *= inv; e2 *= inv;
                const u32x4 a = *(const u32x4*)(OG + (size_t)tj * 128 + 8 * c8), bq = *(const u32x4*)(OG + ((size_t)NTOK * 8 + tj) * 128 + 8 * c8), cq = *(const u32x4*)(OG + ((size_t)2 * NTOK * 8 + tj) * 128 + 8 * c8);
                u32x4 w;
                w.x = pk2(e0 * bflo(a.x) + e1 * bflo(bq.x) + e2 * bflo(cq.x), e0 * bfhi(a.x) + e1 * bfhi(bq.x) + e2 * bfhi(cq.x));
                w.y = pk2(e0 * bflo(a.y) + e1 * bflo(bq.y) + e2 * bflo(cq.y), e0 * bfhi(a.y) + e1 * bfhi(bq.y) + e2 * bfhi(cq.y));
                w.z = pk2(e0 * bflo(a.z) + e1 * bflo(bq.z) + e2 * bflo(cq.z), e0 * bfhi(a.z) + e1 * bfhi(bq.z) + e2 * bfhi(cq.z));
                w.w = pk2(e0 * bflo(a.w) + e1 * bflo(bq.w) + e2 * bflo(cq.w), e0 * bfhi(a.w) + e1 * bfhi(bq.w) + e2 * bfhi(cq.w));
                const int t = tj >> 3, j = tj & 7;
                *(u32x4*)(CAT + (size_t)t * 1536 + j * HD + 8 * c8) = w; }
        } else {
            TB(5);
            if (l == 2) { for (int it = bid; it < 256; it += G) cmp_sel_wg(lds, PROJ, KCV, KCV + (size_t)2048 * 256, OCMP, SEL, UMW, it >> 6, (it >> 4) & 3, it & 15, opq_tid()); }
            else {
                { pg8::Gemm g{XH, (const bf16_t*)(ws + WS_WBIN1) + (size_t)2048 * 2048, NTOK, 256, 2048}; pg8::StaticOrder S; S.init(NTOK, 256, G, bid);
                  pg8::EpiBf16<0> E{PROJ, B_COLS, 18, 11, -8, PROJ, 18}; pg8::gemm_phase(lds, g, S, E); }
                b_queue(256);
            }
            for (int rs_ = 0; rs_ < REP_SYNC; ++rs_) xcd_barrier(gbar);
            TE(5); TB(6);
            {
                unsigned* qctr = (unsigned*)(p.ws + WS_BAR) + 3840 + 64 * (l - 2);
                LAS unsigned* qslot = (LAS unsigned*)(lds + AT_AUX + 8 * 2048 + 64);
                for (;;) {
                    __syncthreads();
                    if (opq_tid() == 0) qslot[0] = __hip_atomic_fetch_add(qctr, 1u, __ATOMIC_RELAXED, __HIP_MEMORY_SCOPE_AGENT);
                    __syncthreads();
                    const int it = (int)qslot[0];
                    if (it >= 384) break;
                    const int qb = 7 - it / 48, j = it % 48; nsa_select_wg(lds, PROJ, KVS, SEL, UMW, OCMP, CAT, j / 12, j % 12, qb, opq_tid());
                }
            }
        }
        for (int rs_ = 0; rs_ < REP_SYNC; ++rs_) xcd_barrier(gbar);
        if (isA) TE(4); else TE(6);
        for (int hf = 0; hf < 2; ++hf) {
            if (hf == 1) { pg8::Gemm g{XH, (const bf16_t*)(ws + WS_WGU + l * SZ_WGU), NTOK, 11264, 2048}; pg8::StaticOrder S; S.init(NTOK, 11264, G, bid);
                pg8::EpiSwiGLU E{PROJ, DFF};
                if (STAGGER_US > 0 && bid >= 128) { const unsigned long long t0 = __builtin_amdgcn_s_memrealtime(); while (__builtin_amdgcn_s_memrealtime() - t0 < (unsigned long long)STAGGER_US * 100ull) __builtin_amdgcn_s_sleep(16); } TB(2); for (int rep_ = 0; rep_ < REP_GEMM; ++rep_) pg8::gemm_phase(lds, g, S, E); TE(2);
                if (bid >= 128 && G == 256) { ConvJob J; for (int j = 0; conv_get(p, j, J); ++j) if (J.tag == l + 1) conv_run(J, wscr, (bid - 128) * NWAVES + wave, 128 * NWAVES, opq_tid() & 63); }
                for (int rs_ = 0; rs_ < REP_SYNC; ++rs_) xcd_barrier(gbar); }
            { pg8::Gemm g; g.M = NTOK; g.N = 2048;
              if (hf == 0) { g.A = CAT; g.K = isA ? 1536 : 2048; g.Bt = isA ? (const bf16_t*)(ws + WS_WAOUT + l * SZ_WAOUT) : (const bf16_t*)(ws + WS_WBOUT + (l - 2) * SZ_WBOUT); }
              else { g.A = PROJ; g.K = DFF; g.Bt = (const bf16_t*)(ws + WS_WDOWN + l * SZ_WDOWN); }
              pg8::StaticOrder S; S.init(NTOK, 2048, G, bid); pg8::EpiBf16<0> E{OBF, 2048, 0, 11, 1 << 20, nullptr, 0}; TB(2); for (int rep_ = 0; rep_ < REP_GEMM; ++rep_) pg8::gemm_phase(lds, g, S, E); TE(2); }
            for (int rs_ = 0; rs_ < REP_SYNC; ++rs_) xcd_barrier(gbar);
            const float* gain = p.in[I_NORMG] + (l * 5 + (hf == 0 ? 1 : 3)) * 2048;
            const bool fin = (l == 3 && hf == 1);
            for (int m = gw; m < NTOK; m += ngw) rowop_row(XH + (size_t)m * 2048, XS + m, OBF + (size_t)m * 2048, gain, fin ? X + (size_t)m * 2048 : nullptr, opq_tid() & 63);
            for (int rs_ = 0; rs_ < REP_SYNC; ++rs_) xcd_barrier(gbar);
        }
    }
    if (TPROBE && bid == 0) { const unsigned long long dt = tacc * 8ull, t0 = __builtin_amdgcn_s_memrealtime(); while (__builtin_amdgcn_s_memrealtime() - t0 < dt) __builtin_amdgcn_s_sleep(8); }
}

extern "C" void kernel_launch(void* const* d_in, const int* in_sizes, int n_in, void* d_out, int out_size, void* d_ws, size_t ws_size, hipStream_t stream) {
    static int grid_blocks = 0;
    if (grid_blocks == 0) {
        if (n_in != 17 || ws_size < WS_END) { fprintf(stderr, "kernel_launch: unexpected n_in %d or ws_size %zu (< %zu)\n", n_in, ws_size, (size_t)WS_END); grid_blocks = -1; return; }
        int dev = 0, cus = 0, per_cu = 0;
        hipGetDevice(&dev);
        hipDeviceGetAttribute(&cus, hipDeviceAttributeMultiprocessorCount, dev);
        hipFuncSetAttribute((const void*)mega_fwd, hipFuncAttributeMaxDynamicSharedMemorySize, LDS_BYTES);
        hipOccupancyMaxActiveBlocksPerMultiprocessor(&per_cu, (const void*)mega_fwd, NTHREADS, LDS_BYTES);
        if (per_cu < 1) per_cu = 1;
        if (per_cu > 1) per_cu = 1;
        grid_blocks = cus * per_cu;
        (void)hipGetLastError();
    }
    if (grid_blocks < 0) return;
    static Params p;
    memset(&p, 0, sizeof(p));
    for (int i = 0; i < 17; ++i) p.in[i] = (const float*)d_in[i];
    p.out = (float*)d_out; p.ws = (unsigned char*)d_ws;
    {
        int n = 0;
        auto add = [&](int in_idx, size_t in_off, int gain_idx, int gain_off, size_t dst_off, int ldw, int col0, int ncols, int K, int nrows, int mode) {
            JobDesc& d = p.jobs[n++]; d.in_idx = in_idx; d.in_off = in_off; d.gain_idx = gain_idx; d.gain_off = gain_off; d.dst_off = dst_off; d.ldw = ldw; d.col0 = col0; d.ncols = ncols; d.K = K; d.nrows = nrows; d.mode = mode; d.pad = 0; };
        for (int l = 0; l < 4; ++l) add(I_WGU, (size_t)l * 2048 * 11264, I_NORMG, (l * 5 + 2) * 2048, WS_WGU + l * SZ_WGU, 11264, 0, 11264, 2048, 11264, 1);
        for (int l = 0; l < 4; ++l) { add(I_WDOWN, (size_t)l * 5632 * 2048, -1, 0, WS_WDOWN + l * SZ_WDOWN, 2048, 0, 2048, 5632, 2048, 0); p.jobs[n - 1].pad = l; }
        for (int l = 0; l < 2; ++l) add(I_AWIN, (size_t)l * 2048 * A_COLS, I_NORMG, (l * 5 + 0) * 2048, WS_WAIN + l * SZ_WAIN, A_COLS, 0, A_COLS, 2048, A_COLS, 0);
        for (int l = 0; l < 2; ++l) add(I_AWOUT, (size_t)l * 1536 * 2048, -1, 0, WS_WAOUT + l * SZ_WAOUT, 2048, 0, 2048, 1536, 2048, 0);
        for (int lb = 0; lb < 2; ++lb) {
            const size_t src = (size_t)lb * 2048 * B_COLS_SRC, dst = lb == 0 ? WS_WBIN : WS_WBIN1; const int go = ((2 + lb) * 5 + 0) * 2048;
            add(I_BWIN, src, I_NORMG, go, dst, B_COLS_SRC, 0, 1536, 2048, 1536, 0);
            add(I_BWIN, src, I_NORMG, go, dst + (size_t)1536 * 2048 * 2, B_COLS_SRC, 1572, 512, 2048, 512, 0);
            add(I_BWIN, src, I_NORMG, go, dst + (size_t)2048 * 2048 * 2, B_COLS_SRC, 1536, 36, 2048, 256, 0);
        }
        for (int lb = 0; lb < 2; ++lb) add(I_BWOUT, (size_t)lb * 2048 * 2048, -1, 0, WS_WBOUT + lb * SZ_WBOUT, 2048, 0, 2048, 2048, 2048, 0);
        for (int l = 0; l < 4; ++l) add(I_MEMWKV, (size_t)l * 2048 * 1024, I_NORMG, (l * 5 + 4) * 2048, WS_WMEM + (size_t)l * 1024 * 2048 * 2, 1024, 0, 1024, 2048, 1024, 0);
        add(I_KVW, 0, I_KVNG, 0, WS_WKV, 3072, 0, 3072, 2048, 3072, 0);
        add(I_WK1, 0, -1, 0, WS_WC1, 512, 0, 512, 4096, 512, 0);
        add(I_WV1, 0, -1, 0, WS_WC1 + SZ_WC1, 512, 0, 512, 4096, 512, 0);
        add(I_WK2, 0, -1, 0, WS_WC2, 128, 0, 128, 512, 256, 0);
        add(I_WV2, 0, -1, 0, WS_WC2 + SZ_WC2, 128, 0, 128, 512, 256, 0);
        p.njobs = n;
    }
    (void)hipMemsetAsync((char*)d_ws + WS_BAR, 0, WS_BAR_BYTES, stream);
    void* args[] = {&p};
    hipError_t e = hipLaunchCooperativeKernel((const void*)mega_fwd, dim3(grid_blocks), dim3(NTHREADS), args, LDS_BYTES, stream);
    if (e != hipSuccess) fprintf(stderr, "cooperative launch failed: %s (grid %d)\n", hipGetErrorString(e), grid_blocks);
}
```
